# Optimizing an MI355X kernel written in HIP

```python
import jax, jax.numpy as jnp
from jax import lax
import numpy as np

D_MODEL = 1024
BATCH = 16
SEQ = 2048
DEPTH = 4

CTX_LEN = 256
GRID_W = 64
HEAD_DIM = 64
ATTN_Q_HEADS = D_MODEL // 128
ATTN_KV_HEADS = ATTN_Q_HEADS // 4
ATTN_GROUP = ATTN_Q_HEADS // ATTN_KV_HEADS
MLSTM_HEADS = D_MODEL // 256
MLSTM_DIM = 64
CMLP_GROUPS = D_MODEL // 256
CMLP_DIM = 64
CMLP_CHUNK = 128
Q_BLOCK = 128
MLSTM_CHUNK = 64
D_FF = 2816
CONV_W = 3
ROPE_THETA = 10000.0
EPS = 1e-6
ATTN_W = ATTN_Q_HEADS * HEAD_DIM
KV_W = ATTN_KV_HEADS * HEAD_DIM
MLSTM_W = MLSTM_HEADS * MLSTM_DIM
CMLP_W = CMLP_GROUPS * CMLP_DIM
D_MIX = ATTN_W + MLSTM_W + CMLP_W
N_GATES = 4 * MLSTM_HEADS
IN_SPLITS = (ATTN_W, KV_W, KV_W, MLSTM_W, MLSTM_W, MLSTM_W, MLSTM_W, N_GATES, CMLP_W, CMLP_W)
D_IN = ATTN_W + 2 * KV_W + 4 * MLSTM_W + N_GATES + 2 * CMLP_W
GATE_OFF = ATTN_W + 2 * KV_W + 4 * MLSTM_W

kernel_name = "hybrid_attn_mlstm_gmlp_dit_block"


def rmsnorm(x, g):
    xf = x.astype(jnp.float32)
    y = xf * lax.rsqrt(jnp.mean(xf * xf, axis=-1, keepdims=True) + EPS)
    return (y * g.astype(jnp.float32)).astype(x.dtype)


def axial_rope_tables(n):
    rows = n // GRID_W
    t = jnp.arange(n)
    row = jnp.repeat(jnp.arange(rows), GRID_W).astype(jnp.float32)
    col = (t % GRID_W).astype(jnp.float32)
    nf = HEAD_DIM // 4
    inv = ROPE_THETA ** (-jnp.arange(nf, dtype=jnp.float32) / nf)
    ang = jnp.concatenate([row[:, None] * inv[None], col[:, None] * inv[None]], axis=-1)
    return jnp.cos(ang), jnp.sin(ang)


def apply_rope(x, cos, sin):
    n = x.shape[1]
    nf = HEAD_DIM // 4
    xf = x.astype(jnp.float32)
    xr = xf.reshape(*xf.shape[:-1], 2, 2, nf)
    x1, x2 = xr[..., 0, :], xr[..., 1, :]
    c = cos.reshape(n, 2, nf)[None, :, None]
    s = sin.reshape(n, 2, nf)[None, :, None]
    out = jnp.stack([x1 * c - x2 * s, x2 * c + x1 * s], axis=-2)
    return out.reshape(xf.shape).astype(x.dtype)


def gqa_attend(q, k, v):
    s = jnp.einsum('bqkgd,bskd->bkgqs', q, k, preferred_element_type=jnp.float32) * (HEAD_DIM ** -0.5)
    p = jax.nn.softmax(s, axis=-1).astype(v.dtype)
    return jnp.einsum('bkgqs,bskd->bqkgd', p, v)


def latent_attention(q, k_all, v_all):
    B, S = q.shape[0], q.shape[1]
    nb = S // Q_BLOCK
    qb = jnp.moveaxis(q.reshape(B, nb, Q_BLOCK, *q.shape[2:]), 1, 0)
    ob = lax.map(lambda blk: gqa_attend(blk, k_all, v_all), qb)
    return jnp.moveaxis(ob, 0, 1).reshape(B, S, -1)


def mlstm_scan(q, k, v, ig, fg, state):
    B, H, N, d = q.shape
    L = MLSTM_CHUNK
    nc = N // L
    chunk = lambda t: jnp.moveaxis(t.reshape(B, H, nc, L, *t.shape[3:]), 2, 0)
    tril = jnp.tril(jnp.ones((L, L), dtype=bool))

    def body(carry, inp):
        C, n, m = carry
        qc, kc, vc, ic, fc = inp
        b = jnp.cumsum(jax.nn.log_sigmoid(fc), axis=-1)
        Dm = jnp.where(tril, b[..., :, None] - b[..., None, :] + ic[..., None, :], -jnp.inf)
        m_inter = b + m[..., None]
        m_t = jnp.maximum(m_inter, jnp.max(Dm, axis=-1))
        w_inter = jnp.exp(m_inter - m_t)
        A = jnp.exp(Dm - m_t[..., None]) * jnp.einsum('bhtd,bhsd->bhts', qc, kc)
        num = w_inter[..., None] * jnp.einsum('bhtd,bhde->bhte', qc, C) + jnp.einsum('bhts,bhse->bhte', A, vc)
        den = w_inter * jnp.einsum('bhtd,bhd->bht', qc, n) + jnp.sum(A, axis=-1)
        h = num / jnp.maximum(jnp.abs(den), jnp.exp(-m_t))[..., None]
        m_new = m_t[..., -1]
        g_s = jnp.exp(b[..., -1:] - b + ic - m_new[..., None])
        w_c = jnp.exp(b[..., -1] + m - m_new)
        C_new = w_c[..., None, None] * C + jnp.einsum('bhs,bhsd,bhse->bhde', g_s, kc, vc)
        n_new = w_c[..., None] * n + jnp.einsum('bhs,bhsd->bhd', g_s, kc)
        return (C_new, n_new, m_new), h

    state_out, hs = lax.scan(body, state, (chunk(q), chunk(k), chunk(v), chunk(ig), chunk(fg)))
    return jnp.moveaxis(hs, 0, 2).reshape(B, H, N, d), state_out


def mlstm_dir(q, k, v, ig, fg, state, reverse):
    if reverse:
        h, st = mlstm_scan(jnp.flip(q, 2), jnp.flip(k, 2), jnp.flip(v, 2),
                           jnp.flip(ig, -1), jnp.flip(fg, -1), state)
        return jnp.flip(h, 2), st
    return mlstm_scan(q, k, v, ig, fg, state)


def mlstm_merge(h_f, h_b, o, g_mh):
    B, H, N, d = h_f.shape
    hs = jnp.transpose(h_f + h_b, (0, 2, 1, 3))
    hs = rmsnorm(hs, g_mh.reshape(H, d)).reshape(B, N, H * d)
    return (jax.nn.sigmoid(o.astype(jnp.float32)) * hs).astype(o.dtype)


def chunk_mlp(u, v, g_v, w_sp, b_sp):
    B, N, _ = u.shape
    nc = N // CMLP_CHUNK
    u = jax.nn.gelu(u)
    v = rmsnorm(jax.nn.gelu(v).reshape(B, N, CMLP_GROUPS, CMLP_DIM), g_v.reshape(CMLP_GROUPS, CMLP_DIM))
    vb = v.reshape(B, nc, CMLP_CHUNK, CMLP_GROUPS, CMLP_DIM)
    z = jnp.einsum('gpq,bcqgd->bcpgd', w_sp, vb) + jnp.transpose(b_sp)[None, None, :, :, None]
    return u * z.reshape(B, N, CMLP_W)


def conv_ffn(h, w_up, conv_w, conv_b, w_down):
    a = h @ w_up
    n = a.shape[1]
    ap = jnp.pad(a, ((0, 0), (1, 1), (0, 0)))
    a = ap[:, 0:n] * conv_w[0] + ap[:, 1:n + 1] * conv_w[1] + ap[:, 2:n + 2] * conv_w[2] + conv_b
    gate, val = jnp.split(a, 2, axis=-1)
    return (jax.nn.silu(gate) * val) @ w_down


def token_mixers(h, hc, w_in, b_in, g_q, g_k, g_mh, g_v, w_sp, b_sp, need_ctx):
    B, S, _ = h.shape
    T = hc.shape[1]
    split_at = [int(s) for s in np.cumsum(IN_SPLITS)[:-1]]
    qa, ka, va, qm, km, vm, om, gt, uc, vc = jnp.split(h @ w_in + b_in, split_at, axis=-1)
    qa_c, ka_c, va_c, qm_c, km_c, vm_c, om_c, gt_c, uc_c, vc_c = jnp.split(hc @ w_in + b_in, split_at, axis=-1)

    cos, sin = axial_rope_tables(S)
    q_l = apply_rope(rmsnorm(qa.reshape(B, S, ATTN_Q_HEADS, HEAD_DIM), g_q), cos, sin)
    k_l = apply_rope(rmsnorm(ka.reshape(B, S, ATTN_KV_HEADS, HEAD_DIM), g_k), cos, sin)
    k_c = rmsnorm(ka_c.reshape(B, T, ATTN_KV_HEADS, HEAD_DIM), g_k)
    v_l = va.reshape(B, S, ATTN_KV_HEADS, HEAD_DIM)
    v_c = va_c.reshape(B, T, ATTN_KV_HEADS, HEAD_DIM)
    k_all = jnp.concatenate([k_c, k_l], axis=1)
    v_all = jnp.concatenate([v_c, v_l], axis=1)
    attn_l = latent_attention(q_l.reshape(B, S, ATTN_KV_HEADS, ATTN_GROUP, HEAD_DIM), k_all, v_all)

    def heads(t, n):
        return jnp.transpose(t.reshape(B, n, MLSTM_HEADS, MLSTM_DIM), (0, 2, 1, 3)).astype(jnp.float32)

    def gates(t, n):
        return jnp.transpose(t.reshape(B, n, 4, MLSTM_HEADS), (2, 0, 3, 1)).astype(jnp.float32)

    kscale = MLSTM_DIM ** -0.5
    q_mc, k_mc, v_mc, g_c = heads(qm_c, T), heads(km_c, T) * kscale, heads(vm_c, T), gates(gt_c, T)
    q_ml, k_ml, v_ml, g_l = heads(qm, S), heads(km, S) * kscale, heads(vm, S), gates(gt, S)
    zero = (jnp.zeros((B, MLSTM_HEADS, MLSTM_DIM, MLSTM_DIM), jnp.float32),
            jnp.zeros((B, MLSTM_HEADS, MLSTM_DIM), jnp.float32),
            jnp.zeros((B, MLSTM_HEADS), jnp.float32))
    hf_c, st_f = mlstm_dir(q_mc, k_mc, v_mc, g_c[0], g_c[1], zero, False)
    hb_c, st_b = mlstm_dir(q_mc, k_mc, v_mc, g_c[2], g_c[3], zero, True)
    hf_l, _ = mlstm_dir(q_ml, k_ml, v_ml, g_l[0], g_l[1], st_f, False)
    hb_l, _ = mlstm_dir(q_ml, k_ml, v_ml, g_l[2], g_l[3], st_b, True)
    mlstm_l = mlstm_merge(hf_l, hb_l, om, g_mh)

    cmlp_l = chunk_mlp(uc, vc, g_v, w_sp, b_sp)

    mix_l = jnp.concatenate([attn_l, mlstm_l, cmlp_l], axis=-1)
    if not need_ctx:
        return mix_l, None
    q_c = rmsnorm(qa_c.reshape(B, T, ATTN_Q_HEADS, HEAD_DIM), g_q)
    attn_c = gqa_attend(q_c.reshape(B, T, ATTN_KV_HEADS, ATTN_GROUP, HEAD_DIM), k_c, v_c).reshape(B, T, ATTN_W)
    mlstm_c = mlstm_merge(hf_c, hb_c, om_c, g_mh)
    cmlp_c = chunk_mlp(uc_c, vc_c, g_v, w_sp, b_sp)
    mix_c = jnp.concatenate([attn_c, mlstm_c, cmlp_c], axis=-1)
    return mix_l, mix_c


def setup_inputs(seed: int = 0) -> dict:
    key = jax.random.key(seed)
    ks = jax.random.split(key, 24)
    nrm = lambda k, shape, s: jax.random.normal(k, shape, jnp.float32) * s
    forget_off = jnp.zeros((D_IN,), jnp.float32)
    fbias = jnp.linspace(3.0, 6.0, MLSTM_HEADS)
    forget_off = forget_off.at[GATE_OFF + MLSTM_HEADS:GATE_OFF + 2 * MLSTM_HEADS].set(fbias)
    forget_off = forget_off.at[GATE_OFF + 3 * MLSTM_HEADS:GATE_OFF + 4 * MLSTM_HEADS].set(fbias)
    return {
        "x": nrm(ks[0], (BATCH, SEQ, D_MODEL), 1.0),
        "c": nrm(ks[1], (BATCH, D_MODEL), 1.0),
        "ctx": nrm(ks[2], (BATCH, CTX_LEN, D_MODEL), 1.0),
        "c_ctx": nrm(ks[3], (D_MODEL,), 1.0),
        "w_ada": nrm(ks[4], (DEPTH, D_MODEL, 6 * D_MODEL), 0.5 * D_MODEL ** -0.5),
        "b_ada": nrm(ks[5], (DEPTH, 6 * D_MODEL), 0.02),
        "g_norm1": 1.0 + nrm(ks[6], (DEPTH, D_MODEL), 0.02),
        "w_in": nrm(ks[7], (DEPTH, D_MODEL, D_IN), D_MODEL ** -0.5),
        "b_in": nrm(ks[8], (DEPTH, D_IN), 0.02) + forget_off[None],
        "g_q": 1.0 + nrm(ks[9], (DEPTH, HEAD_DIM), 0.02),
        "g_k": 1.0 + nrm(ks[10], (DEPTH, HEAD_DIM), 0.02),
        "g_mh": 1.0 + nrm(ks[11], (DEPTH, MLSTM_W), 0.02),
        "g_v": 1.0 + nrm(ks[12], (DEPTH, CMLP_W), 0.02),
        "w_sp": nrm(ks[13], (DEPTH, CMLP_GROUPS, CMLP_CHUNK, CMLP_CHUNK), 0.5 * CMLP_CHUNK ** -0.5),
        "b_sp": 1.0 + nrm(ks[14], (DEPTH, CMLP_GROUPS, CMLP_CHUNK), 0.02),
        "w_out": nrm(ks[15], (DEPTH, D_MIX, D_MODEL), D_MIX ** -0.5),
        "g_norm2": 1.0 + nrm(ks[16], (DEPTH, D_MODEL), 0.02),
        "w_up": nrm(ks[17], (DEPTH, D_MODEL, 2 * D_FF), D_MODEL ** -0.5),
        "conv_w": nrm(ks[18], (DEPTH, CONV_W, 2 * D_FF), CONV_W ** -0.5),
        "conv_b": nrm(ks[19], (DEPTH, 2 * D_FF), 0.02),
        "w_down": nrm(ks[20], (DEPTH, D_FF, D_MODEL), D_FF ** -0.5),
    }


def reference(x, c, ctx, c_ctx, w_ada, b_ada, g_norm1, w_in, b_in, g_q, g_k, g_mh, g_v,
              w_sp, b_sp, w_out, g_norm2, w_up, conv_w, conv_b, w_down):
    sc = jax.nn.silu(c)
    scc = jax.nn.silu(c_ctx)
    xc = ctx
    for l in range(DEPTH):
        last = l == DEPTH - 1
        mod = (sc @ w_ada[l] + b_ada[l])[:, None, :]
        mod_c = (scc @ w_ada[l] + b_ada[l])[None, None, :]
        sh1, s1, g1, sh2, s2, g2 = jnp.split(mod, 6, axis=-1)
        sh1c, s1c, g1c, sh2c, s2c, g2c = jnp.split(mod_c, 6, axis=-1)
        h = rmsnorm(x, g_norm1[l]) * (1 + s1) + sh1
        hc = rmsnorm(xc, g_norm1[l]) * (1 + s1c) + sh1c
        mix, mix_c = token_mixers(h, hc, w_in[l], b_in[l], g_q[l], g_k[l], g_mh[l], g_v[l],
                                  w_sp[l], b_sp[l], not last)
        x = x + g1 * (mix @ w_out[l])
        h2 = rmsnorm(x, g_norm2[l]) * (1 + s2) + sh2
        x = x + g2 * conv_ffn(h2, w_up[l], conv_w[l], conv_b[l], w_down[l])
        if not last:
            xc = xc + g1c * (mix_c @ w_out[l])
            h2c = rmsnorm(xc, g_norm2[l]) * (1 + s2c) + sh2c
            xc = xc + g2c * conv_ffn(h2c, w_up[l], conv_w[l], conv_b[l], w_down[l])
    return x
```

```cpp
#include <hip/hip_runtime.h>
#include <hip/hip_cooperative_groups.h>
#include <hip/hip_bf16.h>
#include <cstdio>
#include <cstdint>
#include <cmath>
namespace cg = cooperative_groups;
namespace pg8 {
#define PG8_LAS __attribute__((address_space(3)))
typedef unsigned short bf16_t;
typedef short bf16x8 __attribute__((ext_vector_type(8)));
typedef float f32x4 __attribute__((ext_vector_type(4)));
typedef unsigned u32x4 __attribute__((ext_vector_type(4)));
constexpr int BM = 256, BK = 64, HALF = 128, HTB = HALF * BK * 2  , STAGE_BYTES = 8 * HTB, NXCD = 8, WGM = 8;

__host__ __device__ __forceinline__ int lds_byte(int r, int c) { const int st = (r >> 4) * 2 + (c >> 5), rr = r & 15, cc = c & 31, ob = rr * 64 + cc * 2; return st * 1024 + (ob ^ (((ob >> 9) & 1) << 5)); }
__host__ __device__ __forceinline__ void stage_rc(int b, int& R, int& C) { const int st = b / 1024, sb = b % 1024, swz = sb ^ (((sb >> 9) & 1) << 5); R = (st >> 1) * 16 + swz / 64; C = (st & 1) * 32 + (swz % 64) / 2; }
__host__ __device__ __forceinline__ int perm32(int rho) { const int n = rho >> 4, i = rho & 15; return 8 * (i >> 2) + 4 * n + (i & 3); }

struct Unit { int pm, pn; };
struct Gemm { const bf16_t* A; const bf16_t* Bt; int M, N, K; };

struct StaticOrder {
    int nM, nN, nwg, G, c;
    __host__ __device__ void init(int M, int N, int G_, int c_) { nM = M / BM; nN = N / BM; nwg = nM * nN; G = G_; c = c_; }
    __host__ __device__ bool next(int i, Unit& u) const {
        const long L = (long)i * G + c; if (L >= nwg) return false;
        int wgid = (int)L; { const int q = nwg / NXCD, r = nwg % NXCD, xcd = wgid % NXCD, off = wgid / NXCD; wgid = (xcd < r ? xcd * (q + 1) : r * (q + 1) + (xcd - r) * q) + off; }
        const int nig = WGM * nN, gid = wgid / nig, fm = gid * WGM, gsz = (nM - fm) < WGM ? (nM - fm) : WGM;
        u.pm = fm + ((wgid % nig) % gsz); u.pn = (wgid % nig) / gsz; return true;
    }
    __device__ __forceinline__ void a_ready(const Unit&) const {}
    __device__ __forceinline__ void done(const Unit&) const {}
};

__device__ __forceinline__ unsigned cvt_pk_bf16(float lo, float hi) { unsigned r; asm volatile("v_cvt_pk_bf16_f32 %0, %1, %2" : "=v"(r) : "v"(lo), "v"(hi)); return r; }
typedef float f32x2 __attribute__((ext_vector_type(2)));
__device__ __forceinline__ f32x2 gelu_pk(f32x2 v) {
    const f32x2 av = __builtin_elementwise_abs(v), d = av * 0.2316418882f + 1.0f;
    f32x2 t; t.x = __builtin_amdgcn_rcpf(d.x); t.y = __builtin_amdgcn_rcpf(d.y);
    f32x2 q = t * 0.5307027145f + (-0.7265760135f); q = q * t + 0.7107068705f; q = q * t + (-0.142248368f); q = q * t + 0.127414796f; q = q * t;
    const f32x2 s = (v * v) * (-0.72134752044f);
    f32x2 e; e.x = __builtin_amdgcn_exp2f(s.x); e.y = __builtin_amdgcn_exp2f(s.y);
    const f32x2 m = v * (q * e), r = v - m;
    f32x2 o; o.x = v.x < 0.f ? m.x : r.x; o.y = v.y < 0.f ? m.y : r.y; return o;
}

template <int ACT  > struct EpiBf16 {
    static constexpr bool PERM = true, AFTER_DRAIN = false; static_assert(ACT == 0 || ACT == 1, "EpiBf16: ACT is 0 (none) or 1 (gelu_pk)");
    bf16_t* O; int ldc; const float* bias; int split_cols; size_t split_stride; float scale0;
    __device__ __forceinline__ void operator()(const f32x4 (&acc)[2][2][4][2], const Unit& u, int wr, int wc, int fr, int fq) const {
        const int row0 = u.pm * BM + wr * 64 + fr; int colt = u.pn * BM; bf16_t* base = O;
        float sc = 1.f; if (split_cols) { const int t = colt / split_cols; base += (size_t)t * split_stride; colt -= t * split_cols; if (t == 0) sc = scale0; }
        const int col0 = colt + wc * 32 + 8 * fq, bcol0 = u.pn * BM + wc * 32 + 8 * fq;
        f32x4 bv[2][2];
#pragma unroll
        for (int bj = 0; bj < 2; ++bj)
#pragma unroll
            for (int n = 0; n < 2; ++n) bv[bj][n] = bias ? *(const f32x4*)(bias + bcol0 + bj * HALF + 4 * n) : (f32x4){0.f, 0.f, 0.f, 0.f};
#pragma unroll
        for (int ai = 0; ai < 2; ++ai)
#pragma unroll
            for (int m = 0; m < 4; ++m) { bf16_t* rowp = base + (size_t)(row0 + ai * HALF + m * 16) * ldc + col0;
#pragma unroll
                for (int bj = 0; bj < 2; ++bj) { f32x4 v0 = acc[ai][bj][m][0] + bv[bj][0], v1 = acc[ai][bj][m][1] + bv[bj][1];
                    if (ACT == 1) { f32x2 a = gelu_pk((f32x2){v0[0], v0[1]}), b = gelu_pk((f32x2){v0[2], v0[3]}), c = gelu_pk((f32x2){v1[0], v1[1]}), d = gelu_pk((f32x2){v1[2], v1[3]});
                        v0 = (f32x4){a.x, a.y, b.x, b.y}; v1 = (f32x4){c.x, c.y, d.x, d.y}; }
                    v0 = v0 * sc; v1 = v1 * sc; u32x4 w; w.x = cvt_pk_bf16(v0[0], v0[1]); w.y = cvt_pk_bf16(v0[2], v0[3]); w.z = cvt_pk_bf16(v1[0], v1[1]); w.w = cvt_pk_bf16(v1[2], v1[3]);
                    *(u32x4*)(rowp + bj * HALF) = w; } }
    }
};

struct EpiRes {
    static constexpr bool PERM = false, AFTER_DRAIN = false;
    const float* base_lat; const float* base_ctx; float* out_lat; float* out_ctx; const float* gvec; int row_off;
    __device__ __forceinline__ void operator()(const f32x4 (&acc)[2][2][4][2], const Unit& u, int wr, int wc, int fr, int fq) const {
        const int grow0 = row_off + u.pm * BM;
        const bool isctx = grow0 >= 32768;
        const int bi = isctx ? 16 : (grow0 >> 11);
        const float* base = isctx ? base_ctx + (size_t)(grow0 - 32768) * 1024 : base_lat + (size_t)grow0 * 1024;
        float* out = isctx ? out_ctx + (size_t)(grow0 - 32768) * 1024 : out_lat + (size_t)grow0 * 1024;
        const int col0 = u.pn * BM + wc * 32 + 4 * fq;
        const float* gv = gvec + bi * 6144 + col0;
        f32x4 g[2][2];
#pragma unroll
        for (int bj = 0; bj < 2; ++bj)
#pragma unroll
            for (int n = 0; n < 2; ++n) g[bj][n] = *(const f32x4*)(gv + bj * HALF + n * 16);
#pragma unroll
        for (int ai = 0; ai < 2; ++ai)
#pragma unroll
            for (int m = 0; m < 4; ++m) { const size_t off = (size_t)(ai * HALF + wr * 64 + m * 16 + fr) * 1024 + col0;
#pragma unroll
                for (int bj = 0; bj < 2; ++bj)
#pragma unroll
                    for (int n = 0; n < 2; ++n) { const f32x4 bs = *(const f32x4*)(base + off + bj * HALF + n * 16);
                        *(f32x4*)(out + off + bj * HALF + n * 16) = bs + g[bj][n] * acc[ai][bj][m][n]; }
                if (m & 1) asm volatile("" ::: "memory"); }
    }
};

template <class Epi, class Sched, bool ALIGN_EPI = false, bool SP2 = false>
__device__ __forceinline__ void gemm_phase(PG8_LAS unsigned char* lds, const Gemm g, const Sched& S, const Epi& E) {
    int tid_l_ = threadIdx.x; asm volatile("" : "+v"(tid_l_)); const int tid = tid_l_, wid = __builtin_amdgcn_readfirstlane(tid >> 6), lane = tid & 63, wr = wid >> 2, wc = wid & 3, fr = lane & 15, fq = lane >> 4;
    const int K = g.K, nt = K / BK;
    unsigned voffA[2], voffB[2];
#pragma unroll
    for (int i = 0; i < 2; ++i) { int R, C; stage_rc(tid * 16 + i * 8192, R, C); const int Rb = Epi::PERM ? ((R & ~31) + perm32(R & 31)) : R;
        voffA[i] = (unsigned)(R * K + C) * 2u; voffB[i] = (unsigned)(Rb * K + C) * 2u; }
    const size_t kstep = (size_t)(BK * 2);
    const size_t hstep = (size_t)HALF * K * 2;
    const size_t tstep = 2 * hstep;
    const unsigned ldsw = (unsigned)wid * 1024u;
    const int aoff = lds_byte(wr * 64 + fr, fq * 8), boff = lds_byte(wc * 32 + fr, fq * 8);
#define PG8_SA(b, h) (((b) * 2 + (h)) * HTB)
#define PG8_SB(b, h) ((4 + (b) * 2 + (h)) * HTB)
#define PG8_STAGE(bufoff, gbase, voff) do { _Pragma("unroll") for (int _i = 0; _i < 2; ++_i) \
        __builtin_amdgcn_global_load_lds((const unsigned*)((const char*)(gbase) + (voff)[_i]), (PG8_LAS unsigned*)(lds + (bufoff) + ldsw + _i * 8192), 16, 0, 0); } while (0)
#define PG8_LDA(dst, b, h) do { _Pragma("unroll") for (int m = 0; m < 4; ++m) _Pragma("unroll") for (int k = 0; k < 2; ++k) dst[m][k] = *(const PG8_LAS bf16x8*)(lds + PG8_SA(b, h) + aoff + m * 2048 + k * 1024); } while (0)
#define PG8_LDB(dst, b, h) do { _Pragma("unroll") for (int n = 0; n < 2; ++n) _Pragma("unroll") for (int k = 0; k < 2; ++k) dst[n][k] = *(const PG8_LAS bf16x8*)(lds + PG8_SB(b, h) + boff + n * 2048 + k * 1024); } while (0)
#define PG8_MMA(ai, bj, At, Bt) do { __builtin_amdgcn_s_setprio(1); _Pragma("unroll") for (int m = 0; m < 4; ++m) _Pragma("unroll") for (int n = 0; n < 2; ++n) _Pragma("unroll") for (int k = 0; k < 2; ++k) \
        acc[ai][bj][m][n] = __builtin_amdgcn_mfma_f32_16x16x32_bf16(Bt[n][k], At[m][k], acc[ai][bj][m][n], 0, 0, 0); __builtin_amdgcn_s_setprio(0); } while (0)
#define PG8_WAIT_V(n) asm volatile("s_waitcnt vmcnt(" #n ")" ::: "memory")
#define PG8_WAIT_L(n) asm volatile("s_waitcnt lgkmcnt(" #n ")" ::: "memory")
#define PG8_BAR __builtin_amdgcn_s_barrier()
#define PG8_SCHED __builtin_amdgcn_sched_barrier(0)
    Unit cur, nxt; int ui = 0;
    if (!S.next(0, cur)) return;
    f32x4 acc[2][2][4][2];
#pragma unroll
    for (int a = 0; a < 2; ++a)
#pragma unroll
        for (int b = 0; b < 2; ++b)
#pragma unroll
            for (int m = 0; m < 4; ++m)
#pragma unroll
                for (int n = 0; n < 2; ++n) acc[a][b][m][n] = (f32x4){0.f, 0.f, 0.f, 0.f};
    bf16x8 At[4][2], B0[2][2], B1[2][2];
    const char* cA = (const char*)g.A + (size_t)cur.pm * tstep; const char* cB = (const char*)g.Bt + (size_t)cur.pn * tstep;
    S.a_ready(cur);
    if constexpr (SP2) {
        PG8_STAGE(PG8_SB(0, 0), cB, voffB); PG8_STAGE(PG8_SB(0, 1), cB + hstep, voffB); PG8_STAGE(PG8_SA(0, 0), cA, voffA); PG8_STAGE(PG8_SA(0, 1), cA + hstep, voffA);
        if (wr == 1) PG8_BAR;
        PG8_WAIT_V(2); PG8_BAR;
        PG8_STAGE(PG8_SB(1, 0), cB + kstep, voffB); PG8_STAGE(PG8_SA(1, 0), cA + kstep, voffA); PG8_STAGE(PG8_SB(1, 1), cB + hstep + kstep, voffB);
        PG8_WAIT_V(6); PG8_BAR;
    } else {
        PG8_STAGE(PG8_SB(0, 0), cB, voffB); PG8_STAGE(PG8_SA(0, 0), cA, voffA); PG8_STAGE(PG8_SB(0, 1), cB + hstep, voffB); PG8_STAGE(PG8_SA(0, 1), cA + hstep, voffA);
        if (wr == 1) PG8_BAR;
        PG8_WAIT_V(4); PG8_BAR;
        PG8_STAGE(PG8_SB(1, 0), cB + kstep, voffB); PG8_STAGE(PG8_SA(1, 0), cA + kstep, voffA); PG8_STAGE(PG8_SB(1, 1), cB + hstep + kstep, voffB);
        PG8_WAIT_V(6); PG8_BAR;
    }
    for (;;) {
        const bool has_next = S.next(ui + 1, nxt);
        const char* nA = has_next ? (const char*)g.A + (size_t)nxt.pm * tstep : cA; const char* nB = has_next ? (const char*)g.Bt + (size_t)nxt.pn * tstep : cB;
        for (int t = 0; t < nt; t += 2) {
            const bool last = (t == nt - 2);
            const char* a1 = cA + (size_t)(t + 1) * kstep;
            const char* a2 = last ? nA : cA + (size_t)(t + 2) * kstep; const char* b2 = last ? nB : cB + (size_t)(t + 2) * kstep;
            const char* a3 = a2 + kstep; const char* b3 = b2 + kstep;
            if (last && has_next) S.a_ready(nxt);
            if constexpr (SP2) {
            PG8_LDB(B0, 0, 0); PG8_LDB(B1, 0, 1); PG8_SCHED; PG8_LDA(At, 0, 0); PG8_STAGE(PG8_SA(1, 1), a1 + hstep, voffA);
            PG8_WAIT_V(8); PG8_WAIT_L(0); PG8_BAR; PG8_MMA(0, 0, At, B0); PG8_MMA(0, 1, At, B1); PG8_BAR; PG8_SCHED;
            PG8_LDA(At, 0, 1); PG8_STAGE(PG8_SB(0, 0), b2, voffB); PG8_STAGE(PG8_SB(0, 1), b2 + hstep, voffB); PG8_STAGE(PG8_SA(0, 0), a2, voffA);
            PG8_WAIT_V(8); PG8_WAIT_L(0); PG8_BAR; PG8_MMA(1, 0, At, B0); PG8_MMA(1, 1, At, B1); PG8_BAR; PG8_SCHED;
            PG8_LDB(B0, 1, 0); PG8_LDB(B1, 1, 1); PG8_SCHED; PG8_LDA(At, 1, 0); PG8_STAGE(PG8_SA(0, 1), a2 + hstep, voffA);
            PG8_WAIT_V(8); PG8_WAIT_L(0); PG8_BAR; PG8_MMA(0, 0, At, B0); PG8_MMA(0, 1, At, B1); PG8_BAR; PG8_SCHED;
            PG8_LDA(At, 1, 1); PG8_STAGE(PG8_SB(1, 0), b3, voffB); PG8_STAGE(PG8_SB(1, 1), b3 + hstep, voffB); PG8_STAGE(PG8_SA(1, 0), a3, voffA);
            PG8_WAIT_V(8); PG8_WAIT_L(0); PG8_BAR; PG8_MMA(1, 0, At, B0); PG8_MMA(1, 1, At, B1); PG8_BAR; PG8_SCHED;
            } else {
            PG8_LDB(B0, 0, 0); PG8_SCHED; PG8_LDA(At, 0, 0); PG8_STAGE(PG8_SA(1, 1), a1 + hstep, voffA);
            PG8_WAIT_L(8); PG8_BAR; PG8_WAIT_L(0); PG8_MMA(0, 0, At, B0); PG8_BAR; PG8_SCHED;
            PG8_LDB(B1, 0, 1); PG8_STAGE(PG8_SB(0, 0), b2, voffB);
            PG8_BAR; PG8_WAIT_L(0); PG8_MMA(0, 1, At, B1); PG8_BAR;
            PG8_LDA(At, 0, 1); PG8_STAGE(PG8_SA(0, 0), a2, voffA);
            PG8_BAR; PG8_WAIT_L(0); PG8_MMA(1, 0, At, B0); PG8_BAR; PG8_SCHED;
            PG8_STAGE(PG8_SB(0, 1), b2 + hstep, voffB);
            PG8_WAIT_V(6); PG8_BAR; PG8_MMA(1, 1, At, B1); PG8_BAR;
            PG8_LDB(B0, 1, 0); PG8_SCHED; PG8_LDA(At, 1, 0); PG8_STAGE(PG8_SA(0, 1), a2 + hstep, voffA);
            PG8_WAIT_L(8); PG8_BAR; PG8_WAIT_L(0); PG8_MMA(0, 0, At, B0); PG8_BAR; PG8_SCHED;
            PG8_LDB(B1, 1, 1); PG8_STAGE(PG8_SB(1, 0), b3, voffB);
            PG8_BAR; PG8_WAIT_L(0); PG8_MMA(0, 1, At, B1); PG8_BAR;
            PG8_LDA(At, 1, 1); PG8_STAGE(PG8_SA(1, 0), a3, voffA);
            PG8_BAR; PG8_WAIT_L(0); PG8_MMA(1, 0, At, B0); PG8_BAR; PG8_SCHED;
            PG8_STAGE(PG8_SB(1, 1), b3 + hstep, voffB);
            PG8_WAIT_V(6); PG8_BAR; PG8_MMA(1, 1, At, B1); PG8_BAR;
            }
        }
        if constexpr (ALIGN_EPI) { if (wr == 0) PG8_BAR; }
        if constexpr (!Epi::AFTER_DRAIN) { E(acc, cur, wr, wc, fr, fq); S.done(cur); }
        if (!has_next) break;
#pragma unroll
        for (int a = 0; a < 2; ++a)
#pragma unroll
            for (int b = 0; b < 2; ++b)
#pragma unroll
                for (int m = 0; m < 4; ++m)
#pragma unroll
                    for (int n = 0; n < 2; ++n) acc[a][b][m][n] = (f32x4){0.f, 0.f, 0.f, 0.f};
        cur = nxt; cA = nA; cB = nB; ++ui;
        if constexpr (ALIGN_EPI) { if (wr == 1) PG8_BAR; }
    }
    PG8_WAIT_V(0);
    if constexpr (!ALIGN_EPI) { if (wr == 0) PG8_BAR; }
    PG8_BAR;
    if constexpr (Epi::AFTER_DRAIN) { E.fused(acc, cur, wr, wc, fr, fq, lds, wid, lane); S.done(cur); }
#undef PG8_SA
#undef PG8_SB
#undef PG8_STAGE
#undef PG8_LDA
#undef PG8_LDB
#undef PG8_MMA
#undef PG8_WAIT_V
#undef PG8_WAIT_L
#undef PG8_BAR
#undef PG8_SCHED
}
}
namespace attn_body {
using bf16=__hip_bfloat16;
using bf16x8=__attribute__((ext_vector_type(8)))short;
using s16x4=__attribute__((ext_vector_type(4)))short;
using f32x16=__attribute__((ext_vector_type(16)))float;
using u32x4=__attribute__((ext_vector_type(4)))unsigned;
constexpr int D=64,QP=2304,KP=2304,OP=1024;
constexpr int NW=8,QBLK=32,QB=QBLK*NW,KVBLK=64;
__device__ __forceinline__ int crow(int r,int hi){return (r&3)+8*(r>>2)+4*hi;}
#define SBAR() __builtin_amdgcn_sched_barrier(0)
__device__ __forceinline__ void cmask(f32x16&p0,f32x16&p1,int jb,int qrel,int hi){
  const float NEG=-INFINITY; int kb=64*jb+4*hi;
  #pragma unroll
  for(int r=0;r<16;++r){int kv=kb+(r&3)+8*(r>>2); if(kv>qrel)p0[r]=NEG; if(kv+32>qrel)p1[r]=NEG;}
}

constexpr int NSLOT=3, SLOTB=8192;
constexpr int LDS_K=0, LDS_V=NSLOT*SLOTB, LDS_WS=2*NSLOT*SLOTB, LDS_OST=LDS_WS+NW*64*4, LDS_BYTES=LDS_OST+NW*4096;
constexpr float C2=0.125f*1.4426950408889634f;
__device__ __forceinline__ void glds16(const void*gsrc,unsigned lds_dst){unsigned keep;
  asm volatile("s_mov_b32 %0, m0\n\ts_mov_b32 m0, %2\n\ts_nop 0\n\tglobal_load_lds_dwordx4 %1, off\n\ts_mov_b32 m0, %0":"=&s"(keep):"v"(gsrc),"s"(lds_dst):"memory");}
__device__ __forceinline__ float max3f(float a,float b,float c){float r;asm("v_max3_f32 %0, %1, %2, %3":"=v"(r):"v"(a),"v"(b),"v"(c));return r;}
__device__ __forceinline__ float max2f(float a,float b){float r;asm("v_max_f32_e32 %0, %1, %2":"=v"(r):"v"(a),"v"(b));return r;}
__device__ __forceinline__ float fadd_s(float a,float b){float r;asm("v_add_f32_e32 %0, %1, %2":"=v"(r):"v"(a),"v"(b));return r;}
__device__ __forceinline__ float fsub_s(float a,float b){float r;asm("v_sub_f32_e32 %0, %1, %2":"=v"(r):"v"(a),"v"(b));return r;}
typedef float f32x2_t __attribute__((ext_vector_type(2))); typedef __bf16 bf16x2_t __attribute__((ext_vector_type(2)));
__device__ __forceinline__ unsigned cvtpk_s(float lo,float hi){f32x2_t v={lo,hi};bf16x2_t b=__builtin_convertvector(v,bf16x2_t);return __builtin_bit_cast(unsigned,b);}
#define WAIT_BAR(N) asm volatile("s_waitcnt vmcnt(" #N ") lgkmcnt(0)\n\ts_barrier":::"memory")

__device__ __forceinline__ void qkt(f32x16&p0,f32x16&p1,const char*Kslot,const bf16x8*qr,const f32x16&negm,int r32,int hi){
  const char*kb=Kslot+hi*1024+r32*16;
  #pragma unroll
  for(int d0=0;d0<4;++d0){
    const bf16x8 b0=*reinterpret_cast<const bf16x8*>(kb+d0*2048);
    const bf16x8 b1=*reinterpret_cast<const bf16x8*>(kb+d0*2048+512);
    if(d0==0){p0=__builtin_amdgcn_mfma_f32_32x32x16_bf16(b0,qr[0],negm,0,0,0);p1=__builtin_amdgcn_mfma_f32_32x32x16_bf16(b1,qr[0],negm,0,0,0);}
    else{p0=__builtin_amdgcn_mfma_f32_32x32x16_bf16(b0,qr[d0],p0,0,0,0);p1=__builtin_amdgcn_mfma_f32_32x32x16_bf16(b1,qr[d0],p1,0,0,0);}}
}
typedef __attribute__((address_space(3))) const char* lds_cptr;
typedef short v4i16_t __attribute__((ext_vector_type(4)));
__device__ __forceinline__ void kload8(bf16x8*kf,lds_cptr kp){
  kf[0]=*(const __attribute__((address_space(3))) bf16x8*)(kp);      kf[1]=*(const __attribute__((address_space(3))) bf16x8*)(kp+512);
  kf[2]=*(const __attribute__((address_space(3))) bf16x8*)(kp+2048); kf[3]=*(const __attribute__((address_space(3))) bf16x8*)(kp+2560);
  kf[4]=*(const __attribute__((address_space(3))) bf16x8*)(kp+4096); kf[5]=*(const __attribute__((address_space(3))) bf16x8*)(kp+4608);
  kf[6]=*(const __attribute__((address_space(3))) bf16x8*)(kp+6144); kf[7]=*(const __attribute__((address_space(3))) bf16x8*)(kp+6656);
}
__device__ __forceinline__ void kload2(bf16x8*kf,lds_cptr kp,int j){ kf[2*j]=*(const __attribute__((address_space(3))) bf16x8*)(kp+j*2048); kf[2*j+1]=*(const __attribute__((address_space(3))) bf16x8*)(kp+j*2048+512); }
__device__ __forceinline__ s16x4 vtr(lds_cptr p){ return __builtin_bit_cast(s16x4,__builtin_amdgcn_ds_read_tr16_b64_v4i16((__attribute__((address_space(3))) v4i16_t*)p)); }
__device__ __forceinline__ float rowmax(const f32x16&p0,const f32x16&p1){
  float a=max3f(p0[0],p0[1],p1[0]),b=max3f(p0[2],p0[3],p1[1]);a=max3f(a,p1[2],p1[3]);
  #pragma unroll
  for(int r=4;r<16;r+=4){a=max3f(a,p0[r],p0[r+1]);b=max3f(b,p0[r+2],p0[r+3]);a=max3f(a,p1[r],p1[r+1]);b=max3f(b,p1[r+2],p1[r+3]);}
  const float m=max2f(a,b);
  auto rr=__builtin_amdgcn_permlane32_swap(__float_as_uint(m),__float_as_uint(m),false,false);
  return max2f(__uint_as_float(rr[0]),__uint_as_float(rr[1]));
}
__device__ __forceinline__ void pv(f32x16*o,int vb,bf16x8 pa0,bf16x8 pa1,bf16x8 pa2,bf16x8 pa3){
  #pragma unroll
  for(int d0=0;d0<2;++d0){s16x4 lo[4],hi[4];
    #pragma unroll
    for(int ks=0;ks<4;++ks){
      asm volatile("ds_read_b64_tr_b16 %0,%1 offset:%c2":"=&v"(lo[ks]):"v"(vb),"i"(d0*4096+ks*1024):"memory");
      asm volatile("ds_read_b64_tr_b16 %0,%1 offset:%c2":"=&v"(hi[ks]):"v"(vb),"i"(d0*4096+ks*1024+512):"memory");}
    asm volatile("s_waitcnt lgkmcnt(0)":::"memory");SBAR();
    #define PK(k) (bf16x8){lo[k][0],lo[k][1],lo[k][2],lo[k][3],hi[k][0],hi[k][1],hi[k][2],hi[k][3]}
    o[d0]=__builtin_amdgcn_mfma_f32_32x32x16_bf16(pa0,PK(0),o[d0],0,0,0);
    o[d0]=__builtin_amdgcn_mfma_f32_32x32x16_bf16(pa1,PK(1),o[d0],0,0,0);
    o[d0]=__builtin_amdgcn_mfma_f32_32x32x16_bf16(pa2,PK(2),o[d0],0,0,0);
    o[d0]=__builtin_amdgcn_mfma_f32_32x32x16_bf16(pa3,PK(3),o[d0],0,0,0);
    #undef PK
  }
}

#ifndef ATTN_STORE16
#define ATTN_STORE16(p,v) (*(u32x4*)(p)=(v))
#endif
template<int THRL> __device__ __forceinline__ void attn_unit(const bf16*Qu,const bf16*__restrict__ Kc,const bf16*__restrict__ Vc,const bf16*__restrict__ Kl,const bf16*__restrict__ Vl,const int NT,bf16*Ou,char*shm){
  int tid_l_=threadIdx.x; asm volatile("":"+v"(tid_l_)); const int tid=tid_l_,lane=tid&63,r32=lane&31,hi=lane>>5; const int wid=__builtin_amdgcn_readfirstlane(tid>>6);
  const bf16*Qw=Qu+(long)(wid*QBLK)*QP;
  const unsigned lds0=(unsigned)(uintptr_t)shm;
  float*wsf=(float*)(shm+LDS_WS)+wid*64;
  const long koff=(long)lane*KP+wid*8;
  const long voff=(long)(16*(wid&3)+(lane>>2))*KP+(wid>>2)*32+(lane&3)*8;
  const unsigned kdst=lds0+LDS_K+wid*1024, vdst=lds0+LDS_V+wid*1024;
  #define DMA_K(t,slot) glds16((((t)<4)?(Kc+(long)(t)*KVBLK*KP):(Kl+(long)((t)-4)*KVBLK*KP))+koff,(unsigned)__builtin_amdgcn_readfirstlane(kdst+(slot)))
  #define DMA_V(t,slot) glds16((((t)<4)?(Vc+(long)(t)*KVBLK*KP):(Vl+(long)((t)-4)*KVBLK*KP))+voff,(unsigned)__builtin_amdgcn_readfirstlane(vdst+(slot)))
  const int vb0=(int)(lds0+LDS_V)+((lane>>4)&1)*32+(lane&3)*8+(4*hi+((lane&15)>>2))*64;
  const char*Kbase=shm+LDS_K; bf16x8 kf[8];
  const lds_cptr shm3=(lds_cptr)shm; const lds_cptr kp0=shm3+LDS_K+hi*1024+r32*16; const lds_cptr vp0=shm3+LDS_V+((lane>>4)&1)*32+(lane&3)*8+(4*hi+((lane&15)>>2))*64;
  DMA_K(0,0);DMA_V(0,0);DMA_K(1,SLOTB);
  bf16x8 qr[4];
  #pragma unroll
  for(int d0=0;d0<4;++d0)qr[d0]=*reinterpret_cast<const bf16x8*>(&Qw[(long)r32*QP+d0*16+hi*8]);
  float mhat=0.f,l_reg=0.f;f32x16 o[2];o[0]=f32x16{};o[1]=f32x16{};f32x16 negm=f32x16{};asm volatile("":"+v"(negm));
  #define CMASK(P0,P1,t) do{}while(0)
  bool resc=false;
  #define START(P0,P1) do{ const float rm=rowmax(P0,P1); resc=false; \
    { const float dl=rm; mhat=fadd_s(mhat,dl); \
      _Pragma("unroll") for(int r=0;r<16;++r){P0[r]=fsub_s(P0[r],dl);P1[r]=fsub_s(P1[r],dl);} \
      _Pragma("unroll") for(int r=0;r<16;++r)negm[r]=-mhat; asm volatile("":"+v"(negm)); } \
    _Pragma("unroll") for(int r=0;r<16;++r)P0[r]=__builtin_amdgcn_exp2f(P0[r]); }while(0)
  #define RESC() do{ if(resc){ asm volatile("s_waitcnt lgkmcnt(0)":::"memory"); \
      _Pragma("unroll") for(int d_=0;d_<2;++d_) _Pragma("unroll") for(int r=0;r<16;++r)o[d_][r]*=wsf[crow(r,hi)]; } }while(0)
  f32x16 pA0,pA1,pB0,pB1;
  int sl_prev=0,sl_cur=0,sl_next=SLOTB;
  #define ROT() do{sl_prev=sl_cur;sl_cur=sl_next;sl_next=(sl_next==(NSLOT-1)*SLOTB)?0:sl_next+SLOTB;}while(0)
  DMA_K(2,2*SLOTB);
  WAIT_BAR(3);
  qkt(pA0,pA1,Kbase,qr,negm,r32,hi);asm volatile("s_nop 15\n\ts_nop 7":"+v"(pA0),"+v"(pA1));CMASK(pA0,pA1,0);
  START(pA0,pA1);
  _Pragma("unroll") for(int r=0;r<16;++r)pA1[r]=__builtin_amdgcn_exp2f(pA1[r]);
  WAIT_BAR(0);
  DMA_K(3,0);DMA_V(1,SLOTB);
  ROT();
  kload8(kf,kp0+sl_cur);
  WAIT_BAR(2);
  s16x4 vlo[8],vhi[8]; u32x4 pw0,pw1,pw2,pw3;
  #define PKW(P,B) cvtpk_s(P[B],P[B+1])
  #define PAF(k) __builtin_bit_cast(bf16x8,pw##k)
  #define VFR(i) (bf16x8){vlo[i][0],vlo[i][1],vlo[i][2],vlo[i][3],vhi[i][0],vhi[i][1],vhi[i][2],vhi[i][3]}
  #define PIN(x) asm volatile("":"+v"(x))
  #define MX3(a,b,c) __builtin_fmaxf(__builtin_fmaxf((a),(b)),(c))
  #define GAPA(MF,A0,A1,A2,A3,W0,W1,PW) do{ MF; sacc+=A0; sacc+=A1; sacc+=A2; sacc+=A3; PIN(sacc); W0; W1; PIN(PW); SBAR(); }while(0)
  #define EX(v) __builtin_amdgcn_exp2f(v)
  #define GAPB(MF,X,B) do{ MF; X[B]=EX(X[B]); X[B+1]=EX(X[B+1]); X[B+2]=EX(X[B+2]); X[B+3]=EX(X[B+3]); PIN(X); SBAR(); }while(0)
  #define VRD(i) do{ vlo[i]=vtr(vp_+(((i)>>2)*4096+((i)&3)*1024)); vhi[i]=vtr(vp_+(((i)>>2)*4096+((i)&3)*1024+512)); }while(0)
  #define KRD(G,j) do{ if(G){ kload2(kf,kp0+sl_next,j); SBAR(); } }while(0)
  #define STEP(C0,C1,P0,P1,t,GK,GV,GL) do{ SBAR(); \
    const lds_cptr vp_=vp0+sl_prev; \
    VRD(0); SBAR(); float sacc=(P0[0]+P0[1]); \
    GAPA(C0=__builtin_amdgcn_mfma_f32_32x32x16_bf16(kf[0],qr[0],negm,0,0,0), P0[2],P0[3],P0[4],P0[5],     pw0[0]=PKW(P0,0), pw0[1]=PKW(P0,2), pw0); \
    VRD(4); SBAR(); GAPA(C1=__builtin_amdgcn_mfma_f32_32x32x16_bf16(kf[1],qr[0],negm,0,0,0), P0[6],P0[7],P0[8],P0[9],     pw0[2]=PKW(P0,4), pw0[3]=PKW(P0,6), pw0); \
    VRD(1); SBAR(); GAPA(C0=__builtin_amdgcn_mfma_f32_32x32x16_bf16(kf[2],qr[1],C0,0,0,0),   P0[10],P0[11],P0[12],P0[13], pw1[0]=PKW(P0,8), pw1[1]=PKW(P0,10), pw1); \
    VRD(5); SBAR(); GAPA(C1=__builtin_amdgcn_mfma_f32_32x32x16_bf16(kf[3],qr[1],C1,0,0,0),   P0[14],P0[15],P1[0],P1[1],   pw1[2]=PKW(P0,12),pw1[3]=PKW(P0,14), pw1); \
    VRD(2); SBAR(); GAPA(C0=__builtin_amdgcn_mfma_f32_32x32x16_bf16(kf[4],qr[2],C0,0,0,0),   P1[2],P1[3],P1[4],P1[5],     pw2[0]=PKW(P1,0), pw2[1]=PKW(P1,2), pw2); \
    VRD(6); SBAR(); GAPA(C1=__builtin_amdgcn_mfma_f32_32x32x16_bf16(kf[5],qr[2],C1,0,0,0),   P1[6],P1[7],P1[8],P1[9],     pw2[2]=PKW(P1,4), pw2[3]=PKW(P1,6), pw2); \
    VRD(3); SBAR(); GAPA(C0=__builtin_amdgcn_mfma_f32_32x32x16_bf16(kf[6],qr[3],C0,0,0,0),   P1[10],P1[11],P1[12],P1[13], pw3[0]=PKW(P1,8), pw3[1]=PKW(P1,10), pw3); \
    VRD(7); SBAR(); GAPA(C1=__builtin_amdgcn_mfma_f32_32x32x16_bf16(kf[7],qr[3],C1,0,0,0),   P1[14],P1[15],0.f,0.f,       pw3[2]=PKW(P1,12),pw3[3]=PKW(P1,14), pw3); \
    l_reg+=sacc; \
    if(GK){DMA_K((t)+3,sl_cur);} if(GV){DMA_V((t)+1,sl_next);} \
    CMASK(C0,C1,t); \
    { float a=MX3(C0[0],C0[1],C1[0]),b=MX3(C0[2],C0[3],C1[1]); a=MX3(a,C1[2],C1[3]); \
      _Pragma("unroll") for(int r=4;r<16;r+=4){a=MX3(a,C0[r],C0[r+1]);b=MX3(b,C0[r+2],C0[r+3]);a=MX3(a,C1[r],C1[r+1]);b=MX3(b,C1[r+2],C1[r+3]);} \
      float rm=__builtin_fmaxf(a,b); { auto rr=__builtin_amdgcn_permlane32_swap(__float_as_uint(rm),__float_as_uint(rm),false,false); rm=__builtin_fmaxf(__uint_as_float(rr[0]),__uint_as_float(rr[1])); } \
      resc=false; \
      if(__builtin_expect(__any(rm>(float)THRL),0)){ const float dl=__builtin_fmaxf(rm,0.f); mhat+=dl; \
        _Pragma("unroll") for(int r=0;r<16;++r){C0[r]-=dl;C1[r]-=dl;} \
        _Pragma("unroll") for(int r=0;r<16;++r)negm[r]=-mhat; asm volatile("":"+v"(negm)); \
        const float f=__builtin_amdgcn_exp2f(-dl); l_reg*=f; if(hi==0)wsf[r32]=f; resc=true; } } \
    SBAR(); \
    GAPB(o[0]=__builtin_amdgcn_mfma_f32_32x32x16_bf16(PAF(0),VFR(0),o[0],0,0,0), C0,0); \
    GAPB(o[1]=__builtin_amdgcn_mfma_f32_32x32x16_bf16(PAF(0),VFR(4),o[1],0,0,0), C0,4); \
    KRD(GL,0); GAPB(o[0]=__builtin_amdgcn_mfma_f32_32x32x16_bf16(PAF(1),VFR(1),o[0],0,0,0), C0,8); \
    KRD(GL,1); GAPB(o[1]=__builtin_amdgcn_mfma_f32_32x32x16_bf16(PAF(1),VFR(5),o[1],0,0,0), C0,12); \
    KRD(GL,2); GAPB(o[0]=__builtin_amdgcn_mfma_f32_32x32x16_bf16(PAF(2),VFR(2),o[0],0,0,0), C1,0); \
    KRD(GL,3); GAPB(o[1]=__builtin_amdgcn_mfma_f32_32x32x16_bf16(PAF(2),VFR(6),o[1],0,0,0), C1,4); \
    GAPB(o[0]=__builtin_amdgcn_mfma_f32_32x32x16_bf16(PAF(3),VFR(3),o[0],0,0,0), C1,8); \
    GAPB(o[1]=__builtin_amdgcn_mfma_f32_32x32x16_bf16(PAF(3),VFR(7),o[1],0,0,0), C1,12); \
    }while(0)
  int t=1;
  #undef CMASK
  #define CMASK(P0,P1,t) do{}while(0)
  for(;t+5<NT;t+=2){
    STEP(pB0,pB1,pA0,pA1,t,true,true,true);     WAIT_BAR(2); RESC(); ROT();
    STEP(pA0,pA1,pB0,pB1,t+1,true,true,true);   WAIT_BAR(2); RESC(); ROT();
  }
  #undef CMASK
  #define CMASK(P0,P1,t) do{}while(0)
  #define ENDW(tt) do{ if((tt)+3<NT){WAIT_BAR(2);} else if((tt)+2<NT){WAIT_BAR(1);} else {WAIT_BAR(0);} }while(0)
  for(;t+1<NT;t+=2){
    STEP(pB0,pB1,pA0,pA1,t,(t+3<NT),(t+1<NT),(t+1<NT));       ENDW(t);   RESC(); ROT();
    STEP(pA0,pA1,pB0,pB1,t+1,(t+4<NT),(t+2<NT),(t+2<NT));     ENDW(t+1); RESC(); ROT();
  }
  STEP(pB0,pB1,pA0,pA1,NT-1,false,false,false); RESC();
  { float sacc=pB0[0]+pB0[1]; _Pragma("unroll") for(int r=2;r<16;++r)sacc+=pB0[r]; _Pragma("unroll") for(int r=0;r<16;++r)sacc+=pB1[r]; l_reg+=sacc;
    pw0=(u32x4){PKW(pB0,0),PKW(pB0,2),PKW(pB0,4),PKW(pB0,6)};pw1=(u32x4){PKW(pB0,8),PKW(pB0,10),PKW(pB0,12),PKW(pB0,14)};pw2=(u32x4){PKW(pB1,0),PKW(pB1,2),PKW(pB1,4),PKW(pB1,6)};pw3=(u32x4){PKW(pB1,8),PKW(pB1,10),PKW(pB1,12),PKW(pB1,14)};
    SBAR(); pv(o,vb0+sl_cur,PAF(0),PAF(1),PAF(2),PAF(3)); }
  #undef PKW
  #undef PAF
  #undef VFR
  #undef PIN
  #undef MX3
  #undef GAPA
  #undef GAPB
  #undef EX
  #undef VRD
  #undef KRD
  #undef STEP
  #undef ENDW
  {auto rr=__builtin_amdgcn_permlane32_swap(__float_as_uint(l_reg),__float_as_uint(l_reg),false,false);l_reg=__uint_as_float(rr[0])+__uint_as_float(rr[1]);}
  if(hi==0)wsf[32+r32]=l_reg;asm volatile("s_waitcnt lgkmcnt(0)":::"memory");
  float rli[16];
  #pragma unroll
  for(int r=0;r<16;++r)rli[r]=__builtin_amdgcn_rcpf(wsf[32+crow(r,hi)]);
  bf16*Ow=Ou+(long)(wid*QBLK)*OP;
  { bf16*stg=(bf16*)(shm+LDS_OST)+wid*2048;
    #pragma unroll
    for(int r=0;r<16;++r){const int orow=crow(r,hi);
      #pragma unroll
      for(int d0=0;d0<2;++d0)stg[orow*64+d0*32+r32]=__float2bfloat16(o[d0][r]*rli[r]);}
    asm volatile("s_waitcnt lgkmcnt(0)":::"memory");
    #pragma unroll
    for(int i=0;i<4;++i){const int row=i*8+(lane>>3),ch=lane&7; const u32x4 v=*(const u32x4*)(stg+row*64+ch*8); ATTN_STORE16(Ow+(long)row*OP+ch*8,v);} }
  asm volatile("s_waitcnt lgkmcnt(0)\n\ts_barrier":::"memory");
  #undef DMA_K
  #undef DMA_V
  #undef CMASK
  #undef START
  #undef RESC
  #undef ROT
}
constexpr int ATTN_LDS_BYTES=LDS_BYTES;
#undef SBAR
#undef WAIT_BAR
}

constexpr int NB = 16, SEQ = 2048, CTXL = 256, DM = 1024, DEPTH = 4, DFF = 2816, DIN = 2320, NPROJ = 2304;
constexpr int ML = NB * SEQ, MC = NB * CTXL, MT = ML + MC;
constexpr int NCHUNK = 36;
constexpr float EPS = 1e-6f;
constexpr float QSCALE = 0.125f * 1.4426950408889634f;
constexpr int PC_Q = 0, PC_K = 512, PC_V = 640, PC_QM = 768, PC_KM = 1024, PC_VM = 1280, PC_OM = 1536, PC_UC = 1792, PC_VC = 2048;
constexpr size_t MiB = 1u << 20;
constexpr size_t WS_CTL = 0, CTL_ZERO_BYTES = 1 * MiB;
constexpr size_t WS_MOD = 1 * MiB, WS_BIASP = 3 * MiB, WS_WIN = 4 * MiB, WS_WOUT = 22 * MiB, WS_WUP = 30 * MiB, WS_WDOWN = 74 * MiB;
constexpr size_t WS_XC = 96 * MiB, WS_H = 112 * MiB, WS_PROJ = 184 * MiB, WS_GATES = 346 * MiB, WS_MIX = 349 * MiB;
constexpr size_t WS_MSC = 421 * MiB, WS_MSN = 493 * MiB, WS_MSS = 495 * MiB, WS_END = 496 * MiB;
constexpr size_t WS_APRE = 184 * MiB, WS_ACT = 382 * MiB;
constexpr int HALF_ROWS = 18432;
static_assert(WS_APRE + (size_t)HALF_ROWS * 2 * DFF * 2 <= WS_ACT && WS_ACT + (size_t)HALF_ROWS * DFF * 2 <= WS_MSN, "ffn overlay");
static_assert(WS_PROJ + (size_t)MT * NPROJ * 2 <= WS_GATES && WS_MIX + (size_t)MT * DM * 2 <= WS_MSC && WS_MSC + (size_t)128 * NCHUNK * 4096 * 4 <= WS_MSN, "ws map");

constexpr int NWAVES = 8, NTHREADS = 512;
constexpr int RING_BYTES = 131072, LDS_BYTES = 147456;

typedef unsigned short bf16;
typedef float f32x4 __attribute__((ext_vector_type(4)));
typedef float f32x2 __attribute__((ext_vector_type(2)));
typedef short bf16x8 __attribute__((ext_vector_type(8)));
typedef unsigned u32x4 __attribute__((ext_vector_type(4)));
typedef unsigned u32x2 __attribute__((ext_vector_type(2)));

__device__ __forceinline__ unsigned f2bf(float f) { unsigned u = __builtin_bit_cast(unsigned, f); return (u + 0x7fffu + ((u >> 16) & 1u)) >> 16; }
__device__ __forceinline__ unsigned pk2(float lo, float hi) { return f2bf(lo) | (f2bf(hi) << 16); }
__device__ __forceinline__ float bf2f(unsigned u16) { return __uint_as_float(u16 << 16); }
__device__ __forceinline__ float bflo(unsigned w) { return __uint_as_float(w << 16); }
__device__ __forceinline__ float bfhi(unsigned w) { return __uint_as_float(w & 0xffff0000u); }
__device__ __forceinline__ float silu_f(float x) { return x / (1.f + __expf(-x)); }
__device__ __forceinline__ float sigmoid_f(float x) { return 1.f / (1.f + __expf(-x)); }
__device__ __forceinline__ float gelu_tanh(float x) { const float u = 0.7978845608028654f * (x + 0.044715f * x * x * x); const float e = __expf(2.f * u); const float t = 1.f - 2.f / (e + 1.f); return 0.5f * x * (1.f + t); }
__device__ __forceinline__ float logsig(float x) { return fminf(x, 0.f) - log1pf(__expf(-fabsf(x))); }
__device__ __forceinline__ float wave_sum(float v) {
#pragma unroll
    for (int o = 1; o < 64; o <<= 1) v += __shfl_xor(v, o);
    return v;
}
__device__ __forceinline__ float wave_max(float v) {
#pragma unroll
    for (int o = 1; o < 64; o <<= 1) v = fmaxf(v, __shfl_xor(v, o));
    return v;
}
__device__ __forceinline__ float scan_add_fwd(float v, int lane) {
#pragma unroll
    for (int o = 1; o < 64; o <<= 1) { const float t = __shfl_up(v, o); if (lane >= o) v += t; }
    return v;
}
__device__ __forceinline__ float scan_add_bwd(float v, int lane) {
#pragma unroll
    for (int o = 1; o < 64; o <<= 1) { const float t = __shfl_down(v, o); if (lane + o < 64) v += t; }
    return v;
}
__device__ __forceinline__ float scan_max_fwd(float v, int lane) {
#pragma unroll
    for (int o = 1; o < 64; o <<= 1) { const float t = __shfl_up(v, o); if (lane >= o) v = fmaxf(v, t); }
    return v;
}
__device__ __forceinline__ float scan_max_bwd(float v, int lane) {
#pragma unroll
    for (int o = 1; o < 64; o <<= 1) { const float t = __shfl_down(v, o); if (lane + o < 64) v = fmaxf(v, t); }
    return v;
}
__device__ __forceinline__ f32x4 mma16(const bf16* A, int lda, const bf16* Bt, int ldb, int K, int mt, int nt, int lane, f32x4 acc) {
    const bf16* ap = A + (16 * mt + (lane & 15)) * lda + (lane >> 4) * 8;
    const bf16* bp = Bt + (16 * nt + (lane & 15)) * ldb + (lane >> 4) * 8;
    for (int k0 = 0; k0 < K; k0 += 32) {
        const bf16x8 a = *(const bf16x8*)(ap + k0), b = *(const bf16x8*)(bp + k0);
        acc = __builtin_amdgcn_mfma_f32_16x16x32_bf16(a, b, acc, 0, 0, 0);
    }
    return acc;
}

__device__ __forceinline__ int launder(int v) { asm volatile("" : "+v"(v)); return v; }
struct Args { const float* in[21]; float* out; unsigned char* ws; };
enum { I_X = 0, I_C, I_CTX, I_CCTX, I_WADA, I_BADA, I_GN1, I_WIN, I_BIN, I_GQ, I_GK, I_GMH, I_GV, I_WSP, I_BSP, I_WOUT, I_GN2, I_WUP, I_CONVW, I_CONVB, I_WDOWN };

__device__ __forceinline__ void p0_transpose_item(const float* W, int ldw, int K, bf16* WT, int k0, int src_col0, int dst_row0, float* scr, int lane) {
#pragma unroll 8
    for (int i = 0; i < 32; ++i) { const int kk = 2 * i + (lane >> 5); scr[kk * 33 + (lane & 31)] = W[(size_t)(k0 + kk) * ldw + src_col0 + (lane & 31)]; }
    asm volatile("s_waitcnt lgkmcnt(0)" ::: "memory");
    const int c = lane & 7;
#pragma unroll
    for (int j = 0; j < 4; ++j) { const int n = (lane >> 3) + 8 * j; const float* s = scr + (8 * c) * 33 + n;
        u32x4 o; o.x = pk2(s[0 * 33], s[1 * 33]); o.y = pk2(s[2 * 33], s[3 * 33]); o.z = pk2(s[4 * 33], s[5 * 33]); o.w = pk2(s[6 * 33], s[7 * 33]);
        *(u32x4*)(WT + (size_t)(dst_row0 + n) * K + k0 + 8 * c) = o; }
    asm volatile("s_waitcnt lgkmcnt(0)" ::: "memory");
}

__device__ __forceinline__ void p0_prologue(const Args& a, unsigned char* lds, int tid, int lane, int wave, int G) {
    unsigned char* ws = a.ws;
    {
        float* scr = (float*)(lds + wave * 16384);
        const int gw = blockIdx.x * NWAVES + wave, NGW = G * NWAVES;
        constexpr int I_IN = 16 * 72, I_OUT = 16 * 32, I_UP = 16 * 176, I_DN = 44 * 32, I_L = I_IN + I_OUT + I_UP + I_DN;
        for (int it = gw; it < DEPTH * I_L; it += NGW) {
            const int l = it / I_L; int r = it % I_L;
            if (r < I_IN) { const int kb = r / 72, nb = r % 72, n0 = 32 * nb;
                p0_transpose_item(a.in[I_WIN] + (size_t)l * DM * DIN, DIN, DM, (bf16*)(ws + WS_WIN) + (size_t)l * NPROJ * DM, 64 * kb, n0 + (n0 >= 1792 ? 16 : 0), n0, scr, lane); continue; } r -= I_IN;
            if (r < I_OUT) { const int kb = r / 32, nb = r % 32;
                p0_transpose_item(a.in[I_WOUT] + (size_t)l * DM * DM, DM, DM, (bf16*)(ws + WS_WOUT) + (size_t)l * DM * DM, 64 * kb, 32 * nb, 32 * nb, scr, lane); continue; } r -= I_OUT;
            if (r < I_UP) { const int kb = r / 176, nb = r % 176;
                p0_transpose_item(a.in[I_WUP] + (size_t)l * DM * 2 * DFF, 2 * DFF, DM, (bf16*)(ws + WS_WUP) + (size_t)l * 2 * DFF * DM, 64 * kb, 32 * nb, 32 * nb, scr, lane); continue; } r -= I_UP;
            { const int kb = r / 32, nb = r % 32;
                p0_transpose_item(a.in[I_WDOWN] + (size_t)l * DFF * DM, DM, DFF, (bf16*)(ws + WS_WDOWN) + (size_t)l * DM * DFF, 64 * kb, 32 * nb, 32 * nb, scr, lane); }
        }
        float* bp = (float*)(ws + WS_BIASP);
        for (int i = blockIdx.x * NTHREADS + tid; i < DEPTH * NPROJ; i += G * NTHREADS) { const int l = i / NPROJ, n = i % NPROJ; bp[i] = a.in[I_BIN][l * DIN + n + (n >= 1792 ? 16 : 0)]; }
    }
    __syncthreads();
    {
        float* sc = (float*)lds;
        float* red = (float*)(lds + 73728);
        for (int i = tid; i < 17 * DM; i += NTHREADS) { const int bi = i >> 10, k = i & 1023; const float v = bi < 16 ? a.in[I_C][bi * DM + k] : a.in[I_CCTX][k]; sc[i] = silu_f(v); }
        __syncthreads();
        float* mod = (float*)(ws + WS_MOD);
        const int cl = tid & 31, kp = tid >> 5;
        for (int grp = blockIdx.x; grp < DEPTH * 192; grp += G) {
            const int l = grp / 192, col = (grp % 192) * 32 + cl;
            const float* w = a.in[I_WADA] + (size_t)l * DM * 6144 + col;
            float acc[17];
#pragma unroll
            for (int b = 0; b < 17; ++b) acc[b] = 0.f;
#pragma unroll 4
            for (int k = kp * 64; k < kp * 64 + 64; ++k) { const float wv = w[(size_t)k * 6144];
#pragma unroll
                for (int b = 0; b < 17; ++b) acc[b] += sc[b * DM + k] * wv; }
#pragma unroll
            for (int b = 0; b < 17; ++b) red[(kp * 17 + b) * 32 + cl] = acc[b];
            __syncthreads();
            for (int i = tid; i < 17 * 32; i += NTHREADS) { const int b = i >> 5, c2 = i & 31; float s = 0.f;
#pragma unroll
                for (int p = 0; p < 16; ++p) s += red[(p * 17 + b) * 32 + c2];
                const int cc = (grp % 192) * 32 + c2; mod[((size_t)l * 17 + b) * 6144 + cc] = s + a.in[I_BADA][l * 6144 + cc]; }
            __syncthreads();
        }
    }
}

template <bool GATES>
__device__ __forceinline__ void norm_phase(const float* xl, const float* xc, const float* gnorm, const float* modl, int sh_off, int s_off, bf16* H, int nrows,
                                           const float* w_in_l, const float* b_in_l, float* gates, unsigned char* lds, int tid, int lane, int wave, int G) {
    float* wg = (float*)lds;
    if (GATES) {
        for (int idx = tid; idx < 16384; idx += NTHREADS) { const int k = idx >> 4, g = idx & 15; const int slot = ((k & 255) >> 2) + 64 * (4 * (k >> 8) + (k & 3));
            wg[slot * 20 + g] = w_in_l[(size_t)k * DIN + 1792 + g]; }
        __syncthreads();
    }
    const int gw = blockIdx.x * NWAVES + wave, NGW = G * NWAVES;
    f32x4 gn[4];
#pragma unroll
    for (int j = 0; j < 4; ++j) gn[j] = *(const f32x4*)(gnorm + 4 * lane + 256 * j);
    for (int r = gw; r < nrows; r += NGW) {
        const bool isctx = r >= ML; const int bi = isctx ? 16 : (r >> 11);
        const float* xr = isctx ? xc + (size_t)(r - ML) * DM : xl + (size_t)r * DM;
        f32x4 v[4]; float ss = 0.f;
#pragma unroll
        for (int j = 0; j < 4; ++j) { v[j] = *(const f32x4*)(xr + 4 * lane + 256 * j); ss += (v[j].x * v[j].x + v[j].y * v[j].y) + (v[j].z * v[j].z + v[j].w * v[j].w); }
        const float rstd = rsqrtf(wave_sum(ss) * (1.f / DM) + EPS);
        const float* mv = modl + bi * 6144;
        bf16* hr = H + (size_t)r * DM;
#pragma unroll
        for (int j = 0; j < 4; ++j) {
            const f32x4 sv = *(const f32x4*)(mv + s_off + 4 * lane + 256 * j), sh = *(const f32x4*)(mv + sh_off + 4 * lane + 256 * j);
            v[j] = v[j] * rstd * gn[j] * (1.f + sv) + sh;
            u32x2 o; o.x = pk2(v[j].x, v[j].y); o.y = pk2(v[j].z, v[j].w);
            *(u32x2*)(hr + 4 * lane + 256 * j) = o;
        }
        if (GATES) {
            f32x4 ga[4];
#pragma unroll
            for (int q = 0; q < 4; ++q) ga[q] = (f32x4){0.f, 0.f, 0.f, 0.f};
#pragma unroll
            for (int j = 0; j < 4; ++j)
#pragma unroll
                for (int e = 0; e < 4; ++e) { const float hv = v[j][e]; const float* wp = wg + (lane + 64 * (4 * j + e)) * 20;
#pragma unroll
                    for (int q = 0; q < 4; ++q) ga[q] += hv * *(const f32x4*)(wp + 4 * q);
                    if (e & 1) asm volatile("" ::: "memory"); }
#pragma unroll
            for (int q = 0; q < 4; ++q)
#pragma unroll
                for (int e = 0; e < 4; ++e) ga[q][e] = wave_sum(ga[q][e]);
            if (lane == 0) {
#pragma unroll
                for (int q = 0; q < 4; ++q) *(f32x4*)(gates + (size_t)r * 16 + 4 * q) = ga[q] + *(const f32x4*)(b_in_l + 1792 + 4 * q);
            }
        }
    }
}

__device__ __forceinline__ int chunk_row(int b, int cf, int t) { return cf < 4 ? ML + b * CTXL + cf * 64 + t : b * SEQ + (cf - 4) * 64 + t; }

__device__ __forceinline__ void postproj_phase(bf16* proj, const float* gq, const float* gk, unsigned char* lds, int tid, int G) {
    float* cs = (float*)lds; float* sn = cs + 1024;
    for (int i = tid; i < 1024; i += NTHREADS) { const int pos = i >> 4, f = i & 15; const float inv = powf(10000.f, -(float)f / 16.f); float s, c; sincosf((float)pos * inv, &s, &c); cs[i] = c; sn[i] = s; }
    __syncthreads();
    const int nth = G * NTHREADS;
    for (int idx = blockIdx.x * NTHREADS + tid; idx < MT * 40; idx += nth) {
        const int j = idx & 3, hh = (idx >> 2) % 10, row = (idx >> 2) / 10;
        const int axis = j >> 1, fh = j & 1;
        const bool isq = hh < 8;
        bf16* p = proj + (size_t)row * NPROJ + (isq ? PC_Q + hh * 64 : PC_K + (hh - 8) * 64) + axis * 32 + fh * 8;
        const u32x4 r1 = *(const u32x4*)p, r2 = *(const u32x4*)(p + 16);
        float x1[8], x2[8];
#pragma unroll
        for (int e = 0; e < 4; ++e) { x1[2 * e] = bflo(r1[e]); x1[2 * e + 1] = bfhi(r1[e]); x2[2 * e] = bflo(r2[e]); x2[2 * e + 1] = bfhi(r2[e]); }
        float ss = 0.f;
#pragma unroll
        for (int e = 0; e < 8; ++e) ss += x1[e] * x1[e] + x2[e] * x2[e];
        ss += __shfl_xor(ss, 1); ss += __shfl_xor(ss, 2);
        const float rstd = rsqrtf(ss * (1.f / 64.f) + EPS);
        const float* g = isq ? gq : gk;
        const bool lat = row < ML;
        const int pos = row & (SEQ - 1); const int pa = axis == 0 ? (pos >> 6) : (pos & 63);
        const float sc = isq ? QSCALE : 1.f;
        float o1[8], o2[8];
#pragma unroll
        for (int e = 0; e < 8; ++e) {
            const float y1 = x1[e] * rstd * g[axis * 32 + fh * 8 + e], y2 = x2[e] * rstd * g[axis * 32 + 16 + fh * 8 + e];
            float c = 1.f, s = 0.f; if (lat) { c = cs[pa * 16 + fh * 8 + e]; s = sn[pa * 16 + fh * 8 + e]; }
            o1[e] = (y1 * c - y2 * s) * sc; o2[e] = (y2 * c + y1 * s) * sc;
        }
        u32x4 w1, w2;
#pragma unroll
        for (int e = 0; e < 4; ++e) { w1[e] = pk2(o1[2 * e], o1[2 * e + 1]); w2[e] = pk2(o2[2 * e], o2[2 * e + 1]); }
        *(u32x4*)p = w1; *(u32x4*)(p + 16) = w2;
    }
    __syncthreads();
}

__device__ __forceinline__ void mlstm_local_phase(const bf16* proj, const float* gates, float* msc, float* msn, float* mss, unsigned char* lds, int tid, int lane, int wave, int G) {
    bf16* VT = (bf16*)lds;
    bf16* KF = VT + 64 * 72;
    bf16* KB_ = KF + 64 * 72;
    float* wv = (float*)(lds + 3 * 64 * 72 * 2);
    for (int task = blockIdx.x; task < NB * 4 * NCHUNK; task += G) {
        const int cf = task % NCHUNK, h = (task / NCHUNK) & 3, b = task / (NCHUNK * 4);
        const int sid0 = (b * 4 + h) * 2;
        if (wave < 2) {
            const int row = chunk_row(b, cf, lane);
            const float ig = gates[(size_t)row * 16 + wave * 8 + h], fg = gates[(size_t)row * 16 + wave * 8 + 4 + h];
            const float ls = logsig(fg);
            float g, tot;
            if (wave == 0) { const float inc = scan_add_fwd(ls, lane); tot = __shfl(inc, 63); g = tot - inc + ig; }
            else { const float inc = scan_add_bwd(ls, lane); tot = __shfl(inc, 0); g = tot - inc + ig; }
            const float ml = wave_max(g);
            wv[wave * 64 + lane] = __expf(g - ml) * 0.125f;
            if (lane == 0) { const int c = wave == 0 ? cf : (cf < 4 ? 3 - cf : 39 - cf); const int si = (sid0 + wave) * NCHUNK + c; mss[si] = ml; mss[128 * NCHUNK + si] = tot; }
        }
        const int s = tid >> 3, d8 = (tid & 7) * 8;
        const bf16* rp = proj + (size_t)chunk_row(b, cf, s) * NPROJ + h * 64 + d8;
        const u32x4 kr = *(const u32x4*)(rp + PC_KM), vr = *(const u32x4*)(rp + PC_VM);
        __syncthreads();
        const float wf = wv[s], wb = wv[64 + s];
#pragma unroll
        for (int e = 0; e < 4; ++e) {
            const float k0 = bflo(kr[e]), k1 = bfhi(kr[e]);
            VT[(d8 + 2 * e) * 72 + s] = (bf16)(vr[e] & 0xffffu); VT[(d8 + 2 * e + 1) * 72 + s] = (bf16)(vr[e] >> 16);
            KF[(d8 + 2 * e) * 72 + s] = (bf16)f2bf(k0 * wf); KF[(d8 + 2 * e + 1) * 72 + s] = (bf16)f2bf(k1 * wf);
            KB_[(d8 + 2 * e) * 72 + s] = (bf16)f2bf(k0 * wb); KB_[(d8 + 2 * e + 1) * 72 + s] = (bf16)f2bf(k1 * wb);
        }
        __syncthreads();
        const int cb = cf < 4 ? 3 - cf : 39 - cf;
        if (tid < 128) { const int dk = tid & 63, dir = tid >> 6; const bf16* kp = (dir ? KB_ : KF) + dk * 72; float sum = 0.f;
#pragma unroll 8
            for (int ss = 0; ss < 64; ++ss) sum += bf2f(kp[ss]);
            msn[((size_t)(sid0 + dir) * NCHUNK + (dir ? cb : cf)) * 64 + dk] = sum; }
        const int mt = wave >> 1, nt0 = 2 * (wave & 1);
#pragma unroll
        for (int dir = 0; dir < 2; ++dir) {
            float* dst = msc + ((size_t)(sid0 + dir) * NCHUNK + (dir ? cb : cf)) * 4096;
#pragma unroll
            for (int j = 0; j < 2; ++j) {
                const f32x4 acc = mma16(VT, 72, dir ? KB_ : KF, 72, 64, mt, nt0 + j, lane, (f32x4){0.f, 0.f, 0.f, 0.f});
#pragma unroll
                for (int i = 0; i < 4; ++i) dst[(16 * mt + 4 * (lane >> 4) + i) * 64 + 16 * (nt0 + j) + (lane & 15)] = acc[i];
            }
        }
        __syncthreads();
    }
}

__device__ __forceinline__ void mlstm_scan_phase(float* msc, float* msn, float* mss, int tid, int G) {
    const float* mloc = mss; const float* Gd = mss + 128 * NCHUNK; float* mprev = mss + 2 * 128 * NCHUNK;
    for (int w = blockIdx.x * NTHREADS + tid; w < 128 * 1024; w += G * NTHREADS) {
        const int sid = w >> 10, e4 = w & 1023;
        f32x4* cp = (f32x4*)(msc + (size_t)sid * NCHUNK * 4096) + e4;
        f32x4* np = (f32x4*)(msn + (size_t)sid * NCHUNK * 64) + (e4 & 15);
        const bool don = e4 < 16;
        float m = 0.f; f32x4 C = (f32x4){0.f, 0.f, 0.f, 0.f}, N = C;
#pragma unroll 6
        for (int c = 0; c < NCHUNK; ++c) {
            const f32x4 S = cp[(size_t)c * 1024];
            f32x4 nl = (f32x4){0.f, 0.f, 0.f, 0.f}; if (don) nl = np[c * 16];
            const float gd = Gd[sid * NCHUNK + c], ml = mloc[sid * NCHUNK + c];
            cp[(size_t)c * 1024] = C;
            if (don) np[c * 16] = N;
            if (e4 == 0) mprev[sid * NCHUNK + c] = m;
            const float mn = fmaxf(gd + m, ml); const float aa = __expf(gd + m - mn), bb = __expf(ml - mn);
            C = aa * C + bb * S; N = aa * N + bb * nl; m = mn;
        }
    }
}

__device__ __forceinline__ void mlstm_out_phase(const bf16* proj, const float* gates, const float* msc, const float* msn, const float* mss, const float* gmh, bf16* mix, bool need_ctx,
                                                unsigned char* lds, int tid, int lane, int wave, int G) {
    bf16* QS = (bf16*)lds;
    bf16* KS = QS + 64 * 72;
    bf16* AX = (bf16*)(lds + 18432);
    bf16* BX = (bf16*)(lds + 44032);
    float* vec = (float*)(lds + 69632);
    float* HS = (float*)lds;
    float* bm = vec, *us = vec + 128, *wi = vec + 256, *emt = vec + 384, *qn = vec + 512, *dsum = vec + 640, *rr = vec + 768, *al = vec + 896, *nv = vec + 1024;
    const float* mprev = mss + 2 * 128 * NCHUNK;
    const int c0 = need_ctx ? 0 : 4, nper = NCHUNK - c0;
    for (int task = blockIdx.x; task < NB * 4 * nper; task += G) {
        const int cf = c0 + task % nper, h = (task / nper) & 3, b = task / (nper * 4);
        const int cb = cf < 4 ? 3 - cf : 39 - cf;
        const int sid0 = (b * 4 + h) * 2;
        const size_t stf = (size_t)sid0 * NCHUNK + cf, stb = (size_t)(sid0 + 1) * NCHUNK + cb;
        if (wave < 2) {
            const int row = chunk_row(b, cf, lane);
            const float ig = gates[(size_t)row * 16 + wave * 8 + h], fg = gates[(size_t)row * 16 + wave * 8 + 4 + h];
            const float ls = logsig(fg);
            float inc, rmax; const float mp = mprev[wave == 0 ? stf : stb];
            if (wave == 0) { inc = scan_add_fwd(ls, lane); rmax = scan_max_fwd(ig - inc, lane); }
            else { inc = scan_add_bwd(ls, lane); rmax = scan_max_bwd(ig - inc, lane); }
            const float minter = inc + mp, mt_ = fmaxf(minter, inc + rmax);
            bm[wave * 64 + lane] = inc - mt_; us[wave * 64 + lane] = ig - inc; wi[wave * 64 + lane] = __expf(minter - mt_); emt[wave * 64 + lane] = __expf(-mt_);
        } else if (wave == 2) { dsum[lane] = 0.f; dsum[64 + lane] = 0.f; }
        else if (wave == 3) { nv[lane] = msn[stf * 64 + lane]; nv[64 + lane] = msn[stb * 64 + lane]; }
        {
            const int s = tid >> 3, d8 = (tid & 7) * 8;
            const bf16* rp = proj + (size_t)chunk_row(b, cf, s) * NPROJ + h * 64 + d8;
            const u32x4 qr = *(const u32x4*)(rp + PC_QM), kr = *(const u32x4*)(rp + PC_KM), vr = *(const u32x4*)(rp + PC_VM);
            *(u32x4*)(QS + s * 72 + d8) = qr; *(u32x4*)(KS + s * 72 + d8) = kr;
#pragma unroll
            for (int e = 0; e < 4; ++e) { BX[(d8 + 2 * e) * 200 + s] = (bf16)(vr[e] & 0xffffu); BX[(d8 + 2 * e + 1) * 200 + s] = (bf16)(vr[e] >> 16); }
            const float* cf_ = msc + stf * 4096 + s * 64 + d8; const float* cb_ = msc + stb * 4096 + s * 64 + d8;
            const f32x4 a0 = *(const f32x4*)cf_, a1 = *(const f32x4*)(cf_ + 4), b0 = *(const f32x4*)cb_, b1 = *(const f32x4*)(cb_ + 4);
            u32x4 pa, pb; pa.x = pk2(a0.x, a0.y); pa.y = pk2(a0.z, a0.w); pa.z = pk2(a1.x, a1.y); pa.w = pk2(a1.z, a1.w);
            pb.x = pk2(b0.x, b0.y); pb.y = pk2(b0.z, b0.w); pb.z = pk2(b1.x, b1.y); pb.w = pk2(b1.z, b1.w);
            *(u32x4*)(BX + s * 200 + 64 + d8) = pa; *(u32x4*)(BX + s * 200 + 128 + d8) = pb;
        }
        __syncthreads();
        if (tid < 128) { const int t = tid & 63, dir = tid >> 6; const bf16* qp = QS + t * 72; const float* np = nv + dir * 64; float sum = 0.f;
#pragma unroll 8
            for (int d = 0; d < 64; ++d) sum += bf2f(qp[d]) * np[d];
            qn[dir * 64 + t] = sum; }
        const int mt = wave >> 1, nt0 = 2 * (wave & 1);
        float Af[2][4], Ab[2][4];
#pragma unroll
        for (int j = 0; j < 2; ++j) {
            const f32x4 acc = mma16(QS, 72, KS, 72, 64, mt, nt0 + j, lane, (f32x4){0.f, 0.f, 0.f, 0.f});
            const int s = 16 * (nt0 + j) + (lane & 15);
            const float usf = us[s], usb = us[64 + s];
#pragma unroll
            for (int i = 0; i < 4; ++i) { const int t = 16 * mt + 4 * (lane >> 4) + i; const float sv = acc[i] * 0.125f;
                Af[j][i] = (s <= t) ? sv * __expf(bm[t] + usf) : 0.f;
                Ab[j][i] = (s >= t) ? sv * __expf(bm[64 + t] + usb) : 0.f; }
        }
#pragma unroll
        for (int i = 0; i < 4; ++i) {
            float pf = Af[0][i] + Af[1][i], pb = Ab[0][i] + Ab[1][i];
#pragma unroll
            for (int o = 1; o < 16; o <<= 1) { pf += __shfl_xor(pf, o); pb += __shfl_xor(pb, o); }
            if ((lane & 15) == 0) { const int t = 16 * mt + 4 * (lane >> 4) + i; atomicAdd(&dsum[t], pf); atomicAdd(&dsum[64 + t], pb); }
        }
        __syncthreads();
        if (tid < 128) { const float den = wi[tid] * qn[tid] + dsum[tid]; const float r = 1.f / fmaxf(fabsf(den), emt[tid]); rr[tid] = r; al[tid] = wi[tid] * r; }
        __syncthreads();
#pragma unroll
        for (int j = 0; j < 2; ++j) { const int s = 16 * (nt0 + j) + (lane & 15);
#pragma unroll
            for (int i = 0; i < 4; ++i) { const int t = 16 * mt + 4 * (lane >> 4) + i; AX[t * 200 + s] = (bf16)f2bf(Af[j][i] * rr[t] + Ab[j][i] * rr[64 + t]); } }
        {
            const int t = tid >> 3, d8 = (tid & 7) * 8; const u32x4 qv = *(const u32x4*)(QS + t * 72 + d8); const float af = al[t], ab = al[64 + t];
            u32x4 of, ob;
#pragma unroll
            for (int e = 0; e < 4; ++e) { const float lo = bflo(qv[e]), hi = bfhi(qv[e]); of[e] = pk2(lo * af, hi * af); ob[e] = pk2(lo * ab, hi * ab); }
            *(u32x4*)(AX + t * 200 + 64 + d8) = of; *(u32x4*)(AX + t * 200 + 128 + d8) = ob;
        }
        __syncthreads();
#pragma unroll
        for (int j = 0; j < 2; ++j) {
            const f32x4 acc = mma16(AX, 200, BX, 200, 192, mt, nt0 + j, lane, (f32x4){0.f, 0.f, 0.f, 0.f});
#pragma unroll
            for (int i = 0; i < 4; ++i) HS[(16 * mt + 4 * (lane >> 4) + i) * 68 + 16 * (nt0 + j) + (lane & 15)] = acc[i];
        }
        __syncthreads();
        {
            const int t = tid >> 3, c8 = (tid & 7) * 8; const int row = chunk_row(b, cf, t);
            const f32x4 v0 = *(const f32x4*)(HS + t * 68 + c8), v1 = *(const f32x4*)(HS + t * 68 + c8 + 4);
            float ss = (v0.x * v0.x + v0.y * v0.y) + (v0.z * v0.z + v0.w * v0.w) + (v1.x * v1.x + v1.y * v1.y) + (v1.z * v1.z + v1.w * v1.w);
            ss += __shfl_xor(ss, 1); ss += __shfl_xor(ss, 2); ss += __shfl_xor(ss, 4);
            const float rstd = rsqrtf(ss * (1.f / 64.f) + EPS);
            const u32x4 ov = *(const u32x4*)(proj + (size_t)row * NPROJ + PC_OM + h * 64 + c8);
            const f32x4 g0 = *(const f32x4*)(gmh + h * 64 + c8), g1 = *(const f32x4*)(gmh + h * 64 + c8 + 4);
            u32x4 w;
            w.x = pk2(sigmoid_f(bflo(ov.x)) * v0.x * rstd * g0.x, sigmoid_f(bfhi(ov.x)) * v0.y * rstd * g0.y);
            w.y = pk2(sigmoid_f(bflo(ov.y)) * v0.z * rstd * g0.z, sigmoid_f(bfhi(ov.y)) * v0.w * rstd * g0.w);
            w.z = pk2(sigmoid_f(bflo(ov.z)) * v1.x * rstd * g1.x, sigmoid_f(bfhi(ov.z)) * v1.y * rstd * g1.y);
            w.w = pk2(sigmoid_f(bflo(ov.w)) * v1.z * rstd * g1.z, sigmoid_f(bfhi(ov.w)) * v1.w * rstd * g1.w);
            *(u32x4*)(mix + (size_t)row * DM + 512 + h * 64 + c8) = w;
        }
        __syncthreads();
    }
}

__device__ __forceinline__ void cmlp_phase(const bf16* proj, const float* wsp, const float* bsp, const float* gv, bf16* mix, bool need_ctx, unsigned char* lds, int tid, int lane, int wave, int G) {
    bf16* WS_ = (bf16*)lds;
    bf16* VT = WS_ + 128 * 136;
    const int ntask = (NB * 16 + (need_ctx ? NB * 2 : 0)) * 4;
    for (int task = blockIdx.x; task < ntask; task += G) {
        const int g = task & 3, sc = task >> 2;
        const int row0 = sc < NB * 16 ? sc * 128 : ML + (sc - NB * 16) * 128;
        const float* wp = wsp + (size_t)g * 128 * 128;
#pragma unroll 4
        for (int i = 0; i < 8; ++i) { const int idx4 = tid + NTHREADS * i; const int p = idx4 >> 5, q4 = (idx4 & 31) * 4; const f32x4 wv = *(const f32x4*)(wp + p * 128 + q4);
            u32x2 o; o.x = pk2(wv.x, wv.y); o.y = pk2(wv.z, wv.w); *(u32x2*)(WS_ + p * 136 + q4) = o; }
        {
            const int q = tid >> 2, part = tid & 3;
            const bf16* vp = proj + (size_t)(row0 + q) * NPROJ + PC_VC + g * 64 + part * 16;
            const u32x4 r0 = *(const u32x4*)vp, r1 = *(const u32x4*)(vp + 8);
            float x[16];
#pragma unroll
            for (int e = 0; e < 4; ++e) { x[2 * e] = gelu_tanh(bflo(r0[e])); x[2 * e + 1] = gelu_tanh(bfhi(r0[e])); x[8 + 2 * e] = gelu_tanh(bflo(r1[e])); x[8 + 2 * e + 1] = gelu_tanh(bfhi(r1[e])); }
            float ss = 0.f;
#pragma unroll
            for (int e = 0; e < 16; ++e) ss += x[e] * x[e];
            ss += __shfl_xor(ss, 1); ss += __shfl_xor(ss, 2);
            const float rstd = rsqrtf(ss * (1.f / 64.f) + EPS);
#pragma unroll
            for (int e = 0; e < 16; ++e) VT[(part * 16 + e) * 136 + q] = (bf16)f2bf(x[e] * rstd * gv[g * 64 + part * 16 + e]);
        }
        __syncthreads();
#pragma unroll
        for (int nt = 0; nt < 4; ++nt) {
            const f32x4 acc = mma16(WS_, 136, VT, 136, 128, wave, nt, lane, (f32x4){0.f, 0.f, 0.f, 0.f});
            const int d = 16 * nt + (lane & 15);
#pragma unroll
            for (int i = 0; i < 4; ++i) { const int p = 16 * wave + 4 * (lane >> 4) + i;
                const float z = acc[i] + bsp[g * 128 + p];
                const float u = bf2f(proj[(size_t)(row0 + p) * NPROJ + PC_UC + g * 64 + d]);
                mix[(size_t)(row0 + p) * DM + 768 + g * 64 + d] = (bf16)f2bf(gelu_tanh(u) * z); }
        }
        __syncthreads();
    }
}

__device__ __forceinline__ void convgate_phase(const bf16* apre, bf16* act, const float* cw, const float* cb, int nrows, int row_off, int tid, int G) {
    const int nch = nrows / 32, ntask = nch * 352;
    for (int task = blockIdx.x * NTHREADS + tid; task < ntask; task += G * NTHREADS) {
        const int j8 = task % 352, rc = task / 352, j0 = j8 * 8;
        float wg[3][8], wvv[3][8], bg[8], bv[8];
#pragma unroll
        for (int k = 0; k < 3; ++k) { const f32x4 a0 = *(const f32x4*)(cw + k * 2 * DFF + j0), a1 = *(const f32x4*)(cw + k * 2 * DFF + j0 + 4), c0 = *(const f32x4*)(cw + k * 2 * DFF + DFF + j0), c1 = *(const f32x4*)(cw + k * 2 * DFF + DFF + j0 + 4);
#pragma unroll
            for (int e = 0; e < 4; ++e) { wg[k][e] = a0[e]; wg[k][4 + e] = a1[e]; wvv[k][e] = c0[e]; wvv[k][4 + e] = c1[e]; } }
        { const f32x4 a0 = *(const f32x4*)(cb + j0), a1 = *(const f32x4*)(cb + j0 + 4), c0 = *(const f32x4*)(cb + DFF + j0), c1 = *(const f32x4*)(cb + DFF + j0 + 4);
#pragma unroll
            for (int e = 0; e < 4; ++e) { bg[e] = a0[e]; bg[4 + e] = a1[e]; bv[e] = c0[e]; bv[4 + e] = c1[e]; } }
        const int i0 = rc * 32, gr0 = row_off + i0;
        const int seqlen = gr0 >= ML ? CTXL : SEQ, sp = gr0 >= ML ? (gr0 - ML) % CTXL : gr0 % SEQ;
        const bool has_prev = sp != 0, has_next = sp + 32 != seqlen;
        const bf16* ap = apre + (size_t)i0 * 2 * DFF + j0;
        const u32x4 z4 = (u32x4){0u, 0u, 0u, 0u};
        u32x4 pg = has_prev ? *(const u32x4*)(ap - 2 * DFF) : z4, pv = has_prev ? *(const u32x4*)(ap - 2 * DFF + DFF) : z4;
        u32x4 cg_ = *(const u32x4*)ap, cv = *(const u32x4*)(ap + DFF);
        for (int i = 0; i < 32; ++i) {
            const bool hn = (i < 31) || has_next;
            const u32x4 ng = hn ? *(const u32x4*)(ap + (size_t)(i + 1) * 2 * DFF) : z4, nv = hn ? *(const u32x4*)(ap + (size_t)(i + 1) * 2 * DFF + DFF) : z4;
            u32x4 o;
#pragma unroll
            for (int e = 0; e < 4; ++e) {
                const float g0 = wg[0][2 * e] * bflo(pg[e]) + wg[1][2 * e] * bflo(cg_[e]) + wg[2][2 * e] * bflo(ng[e]) + bg[2 * e];
                const float g1 = wg[0][2 * e + 1] * bfhi(pg[e]) + wg[1][2 * e + 1] * bfhi(cg_[e]) + wg[2][2 * e + 1] * bfhi(ng[e]) + bg[2 * e + 1];
                const float v0 = wvv[0][2 * e] * bflo(pv[e]) + wvv[1][2 * e] * bflo(cv[e]) + wvv[2][2 * e] * bflo(nv[e]) + bv[2 * e];
                const float v1 = wvv[0][2 * e + 1] * bfhi(pv[e]) + wvv[1][2 * e + 1] * bfhi(cv[e]) + wvv[2][2 * e + 1] * bfhi(nv[e]) + bv[2 * e + 1];
                o[e] = pk2(silu_f(g0) * v0, silu_f(g1) * v1);
            }
            *(u32x4*)(act + (size_t)(i0 + i) * DFF + j0) = o;
            pg = cg_; pv = cv; cg_ = ng; cv = nv;
        }
    }
}

__global__ void __launch_bounds__(NTHREADS, 2) mega_fwd(Args args) {
    extern __shared__ __attribute__((aligned(16))) unsigned char lds[];
    cg::grid_group grid = cg::this_grid();
    const int tid0 = threadIdx.x, G = gridDim.x;
    unsigned char* ws = args.ws;
    float* const mod = (float*)(ws + WS_MOD);
    float* const xc = (float*)(ws + WS_XC);
    bf16* const Hb = (bf16*)(ws + WS_H);
    bf16* const proj = (bf16*)(ws + WS_PROJ);
    float* const gates = (float*)(ws + WS_GATES);
    bf16* const mix = (bf16*)(ws + WS_MIX);
    float* const msc = (float*)(ws + WS_MSC); float* const msn = (float*)(ws + WS_MSN); float* const mss = (float*)(ws + WS_MSS);
    bf16* const apre = (bf16*)(ws + WS_APRE); bf16* const act = (bf16*)(ws + WS_ACT);
    PG8_LAS unsigned char* ldsl = (PG8_LAS unsigned char*)lds;
#define GRID_BAR() grid.sync()
#define FRESH() const int tid = launder(tid0), lane = tid & 63, wave = __builtin_amdgcn_readfirstlane(tid >> 6); (void)lane; (void)wave

    { FRESH(); p0_prologue(args, lds, tid, lane, wave, G); }
    GRID_BAR();

    for (int l = 0; l < DEPTH; ++l) {
        const bool last = (l == DEPTH - 1);
        const float* xl_in = (l == 0) ? args.in[I_X] : args.out;
        const float* xc_in = (l == 0) ? args.in[I_CTX] : xc;
        const float* modl = mod + (size_t)l * 17 * 6144;
        { FRESH(); norm_phase<true>(xl_in, xc_in, args.in[I_GN1] + l * DM, modl, 0, 1024, Hb, MT, args.in[I_WIN] + (size_t)l * DM * DIN, args.in[I_BIN] + l * DIN, gates, lds, tid, lane, wave, G); }
        GRID_BAR();
        {
            pg8::Gemm g{Hb, (const bf16*)(ws + WS_WIN) + (size_t)l * NPROJ * DM, MT, NPROJ, DM}; pg8::StaticOrder S; S.init(MT, NPROJ, G, (int)blockIdx.x);
            pg8::EpiBf16<0> E{proj, NPROJ, (const float*)(ws + WS_BIASP) + l * NPROJ, 0, 0, 1.f};
            pg8::gemm_phase<pg8::EpiBf16<0>, pg8::StaticOrder, true, true>(ldsl, g, S, E);
        }
        GRID_BAR();
        { FRESH(); postproj_phase(proj, args.in[I_GQ] + l * 64, args.in[I_GK] + l * 64, lds, tid, G); }
        { FRESH(); mlstm_local_phase(proj, gates, msc, msn, mss, lds, tid, lane, wave, G); }
        GRID_BAR();
        { FRESH(); mlstm_scan_phase(msc, msn, mss, tid, G); }
        {
            const int nunit = 1024 + (last ? 0 : 128);
            for (int u = blockIdx.x; u < nunit; u += G) {
                const attn_body::bf16* P = (const attn_body::bf16*)proj; attn_body::bf16* O = (attn_body::bf16*)mix;
                if (u < 1024) { const int b = u >> 6, hq = (u >> 3) & 7, qb = u & 7, kvh = hq >> 2;
                    const size_t qrow = (size_t)b * SEQ + qb * 256, crow0 = (size_t)ML + b * CTXL, lrow0 = (size_t)b * SEQ;
                    attn_body::attn_unit<8>(P + qrow * NPROJ + PC_Q + hq * 64, P + crow0 * NPROJ + PC_K + kvh * 64, P + crow0 * NPROJ + PC_V + kvh * 64,
                                            P + lrow0 * NPROJ + PC_K + kvh * 64, P + lrow0 * NPROJ + PC_V + kvh * 64, 36, O + qrow * DM + hq * 64, (char*)lds);
                } else { const int v = u - 1024, b = v >> 3, hq = v & 7, kvh = hq >> 2; const size_t crow0 = (size_t)ML + b * CTXL;
                    attn_body::attn_unit<8>(P + crow0 * NPROJ + PC_Q + hq * 64, P + crow0 * NPROJ + PC_K + kvh * 64, P + crow0 * NPROJ + PC_V + kvh * 64,
                                            P + crow0 * NPROJ + PC_K + kvh * 64, P + crow0 * NPROJ + PC_V + kvh * 64, 4, O + crow0 * DM + hq * 64, (char*)lds);
                }
            }
            asm volatile("s_waitcnt vmcnt(0) lgkmcnt(0)" ::: "memory"); __syncthreads();
        }
        { FRESH(); cmlp_phase(proj, args.in[I_WSP] + (size_t)l * 4 * 128 * 128, args.in[I_BSP] + l * 4 * 128, args.in[I_GV] + l * 256, mix, !last, lds, tid, lane, wave, G); }
        GRID_BAR();
        { FRESH(); mlstm_out_phase(proj, gates, msc, msn, mss, args.in[I_GMH] + l * 256, mix, !last, lds, tid, lane, wave, G); }
        GRID_BAR();
        {
            const int Mo = last ? ML : MT;
            pg8::Gemm g{mix, (const bf16*)(ws + WS_WOUT) + (size_t)l * DM * DM, Mo, DM, DM}; pg8::StaticOrder S; S.init(Mo, DM, G, (int)blockIdx.x);
            pg8::EpiRes E{xl_in, xc_in, args.out, xc, modl + 2048, 0};
            pg8::gemm_phase<pg8::EpiRes, pg8::StaticOrder, true, true>(ldsl, g, S, E);
        }
        GRID_BAR();
        { FRESH(); norm_phase<false>(args.out, xc, args.in[I_GN2] + l * DM, modl, 3072, 4096, Hb, last ? ML : MT, nullptr, nullptr, nullptr, lds, tid, lane, wave, G); }
        GRID_BAR();
        for (int hf = 0; hf < 2; ++hf) {
            const int row_off = hf * HALF_ROWS; const int nrows = hf == 0 ? HALF_ROWS : ((last ? ML : MT) - HALF_ROWS);
            {
                pg8::Gemm g{Hb + (size_t)row_off * DM, (const bf16*)(ws + WS_WUP) + (size_t)l * 2 * DFF * DM, nrows, 2 * DFF, DM}; pg8::StaticOrder S; S.init(nrows, 2 * DFF, G, (int)blockIdx.x);
                pg8::EpiBf16<0> E{apre, 2 * DFF, nullptr, 0, 0, 1.f};
                pg8::gemm_phase<pg8::EpiBf16<0>, pg8::StaticOrder, true, true>(ldsl, g, S, E);
            }
            GRID_BAR();
            { FRESH(); convgate_phase(apre, act, args.in[I_CONVW] + (size_t)l * 3 * 2 * DFF, args.in[I_CONVB] + (size_t)l * 2 * DFF, nrows, row_off, tid, G); }
            GRID_BAR();
            {
                pg8::Gemm g{act, (const bf16*)(ws + WS_WDOWN) + (size_t)l * DM * DFF, nrows, DM, DFF}; pg8::StaticOrder S; S.init(nrows, DM, G, (int)blockIdx.x);
                pg8::EpiRes E{args.out, xc, args.out, xc, modl + 5120, row_off};
                pg8::gemm_phase<pg8::EpiRes, pg8::StaticOrder, true, true>(ldsl, g, S, E);
            }
            GRID_BAR();
        }
    }
}

extern "C" void kernel_launch(void* const* d_in, const int* in_sizes, int n_in, void* d_out, int out_size, void* d_ws, size_t ws_size, hipStream_t stream) {
    static int grid = 0;
    if (grid == 0) {
        if (n_in != 21 || out_size != ML * DM || ws_size < WS_END) { fprintf(stderr, "kernel_launch: unexpected problem (n_in %d out %d ws %zu)\n", n_in, out_size, ws_size); grid = -1; return; }
        int dev = 0, cus = 0, per_cu = 0;
        if (hipGetDevice(&dev) != hipSuccess || hipDeviceGetAttribute(&cus, hipDeviceAttributeMultiprocessorCount, dev) != hipSuccess) { grid = -1; return; }
        if (hipFuncSetAttribute((const void*)mega_fwd, hipFuncAttributeMaxDynamicSharedMemorySize, LDS_BYTES) != hipSuccess) { fprintf(stderr, "kernel_launch: hipFuncSetAttribute failed\n"); grid = -1; return; }
        if (hipOccupancyMaxActiveBlocksPerMultiprocessor(&per_cu, (const void*)mega_fwd, NTHREADS, LDS_BYTES) != hipSuccess || per_cu < 1) { fprintf(stderr, "kernel_launch: occupancy query says %d\n", per_cu); (void)hipGetLastError(); per_cu = 1; }
        grid = cus;
    }
    if (grid < 0) return;
    (void)hipMemsetAsync((char*)d_ws + WS_CTL, 0, CTL_ZERO_BYTES, stream);
    Args a{};
    for (int i = 0; i < 21; ++i) a.in[i] = (const float*)d_in[i];
    a.out = (float*)d_out; a.ws = (unsigned char*)d_ws;
    void* kargs[] = {&a};
    hipError_t e = hipLaunchCooperativeKernel((const void*)mega_fwd, dim3(grid), dim3(NTHREADS), kargs, LDS_BYTES, stream);
    if (e != hipSuccess) fprintf(stderr, "kernel_launch: cooperative launch failed: %s (grid %d)\n", hipGetErrorString(e), grid);
}
```

```cpp
#include <hip/hip_runtime.h>
#include <hip/hip_cooperative_groups.h>
#include <hip/hip_bf16.h>
#include <cstdio>
#include <cstdint>
#include <cmath>
namespace cg = cooperative_groups;
#define PROBE 0
namespace pg8 {
#define PG8_LAS __attribute__((address_space(3)))
typedef unsigned short bf16_t;
typedef short bf16x8 __attribute__((ext_vector_type(8)));
typedef float f32x4 __attribute__((ext_vector_type(4)));
typedef unsigned u32x4 __attribute__((ext_vector_type(4)));
constexpr int BM = 256, BK = 64, HALF = 128, HTB = HALF * BK * 2  , STAGE_BYTES = 8 * HTB, NXCD = 8, WGM = 8;

__host__ __device__ __forceinline__ int lds_byte(int r, int c) { const int st = (r >> 4) * 2 + (c >> 5), rr = r & 15, cc = c & 31, ob = rr * 64 + cc * 2; return st * 1024 + (ob ^ (((ob >> 9) & 1) << 5)); }
__host__ __device__ __forceinline__ void stage_rc(int b, int& R, int& C) { const int st = b / 1024, sb = b % 1024, swz = sb ^ (((sb >> 9) & 1) << 5); R = (st >> 1) * 16 + swz / 64; C = (st & 1) * 32 + (swz % 64) / 2; }
__host__ __device__ __forceinline__ int perm32(int rho) { const int n = rho >> 4, i = rho & 15; return 8 * (i >> 2) + 4 * n + (i & 3); }

struct Unit { int pm, pn; };
struct Gemm { const bf16_t* A; const bf16_t* Bt; int M, N, K; int ld; };

struct StaticOrder {
    int nM, nN, nwg, G, c;
    __host__ __device__ void init(int M, int N, int G_, int c_) { nM = M / BM; nN = N / BM; nwg = nM * nN; G = G_; c = c_; }
    __host__ __device__ bool next(int i, Unit& u) const {
        const long L = (long)i * G + c; if (L >= nwg) return false;
        int wgid = (int)L; { const int q = nwg / NXCD, r = nwg % NXCD, xcd = wgid % NXCD, off = wgid / NXCD; wgid = (xcd < r ? xcd * (q + 1) : r * (q + 1) + (xcd - r) * q) + off; }
        const int nig = WGM * nN, gid = wgid / nig, fm = gid * WGM, gsz = (nM - fm) < WGM ? (nM - fm) : WGM;
        u.pm = fm + ((wgid % nig) % gsz); u.pn = (wgid % nig) / gsz; return true;
    }
    __device__ __forceinline__ void a_ready(const Unit&) const {}
    __device__ __forceinline__ void done(const Unit&) const {}
};

__device__ __forceinline__ unsigned cvt_pk_bf16(float lo, float hi) { unsigned r; asm volatile("v_cvt_pk_bf16_f32 %0, %1, %2" : "=v"(r) : "v"(lo), "v"(hi)); return r; }
typedef float f32x2 __attribute__((ext_vector_type(2)));
__device__ __forceinline__ f32x2 gelu_pk(f32x2 v) {
    const f32x2 av = __builtin_elementwise_abs(v), d = av * 0.2316418882f + 1.0f;
    f32x2 t; t.x = __builtin_amdgcn_rcpf(d.x); t.y = __builtin_amdgcn_rcpf(d.y);
    f32x2 q = t * 0.5307027145f + (-0.7265760135f); q = q * t + 0.7107068705f; q = q * t + (-0.142248368f); q = q * t + 0.127414796f; q = q * t;
    const f32x2 s = (v * v) * (-0.72134752044f);
    f32x2 e; e.x = __builtin_amdgcn_exp2f(s.x); e.y = __builtin_amdgcn_exp2f(s.y);
    const f32x2 m = v * (q * e), r = v - m;
    f32x2 o; o.x = v.x < 0.f ? m.x : r.x; o.y = v.y < 0.f ? m.y : r.y; return o;
}

template <int ACT  > struct EpiBf16 {
    static constexpr bool PERM = true, AFTER_DRAIN = false; static_assert(ACT == 0 || ACT == 1, "EpiBf16: ACT is 0 (none) or 1 (gelu_pk)");
    bf16_t* O; int ldc; const float* bias; int split_cols; size_t split_stride; float scale0;
    __device__ __forceinline__ void operator()(const f32x4 (&acc)[2][2][4][2], const Unit& u, int wr, int wc, int fr, int fq) const {
        const int row0 = u.pm * BM + wr * 64 + fr; int colt = u.pn * BM; bf16_t* base = O;
        float sc = 1.f; if (split_cols) { const int t = colt / split_cols; base += (size_t)t * split_stride; colt -= t * split_cols; if (t == 0) sc = scale0; }
        const int col0 = colt + wc * 32 + 8 * fq, bcol0 = u.pn * BM + wc * 32 + 8 * fq;
        f32x4 bv[2][2];
#pragma unroll
        for (int bj = 0; bj < 2; ++bj)
#pragma unroll
            for (int n = 0; n < 2; ++n) bv[bj][n] = bias ? *(const f32x4*)(bias + bcol0 + bj * HALF + 4 * n) : (f32x4){0.f, 0.f, 0.f, 0.f};
#pragma unroll
        for (int ai = 0; ai < 2; ++ai)
#pragma unroll
            for (int m = 0; m < 4; ++m) { bf16_t* rowp = base + (size_t)(row0 + ai * HALF + m * 16) * ldc + col0;
#pragma unroll
                for (int bj = 0; bj < 2; ++bj) { f32x4 v0 = acc[ai][bj][m][0] + bv[bj][0], v1 = acc[ai][bj][m][1] + bv[bj][1];
                    if (ACT == 1) { f32x2 a = gelu_pk((f32x2){v0[0], v0[1]}), b = gelu_pk((f32x2){v0[2], v0[3]}), c = gelu_pk((f32x2){v1[0], v1[1]}), d = gelu_pk((f32x2){v1[2], v1[3]});
                        v0 = (f32x4){a.x, a.y, b.x, b.y}; v1 = (f32x4){c.x, c.y, d.x, d.y}; }
                    v0 = v0 * sc; v1 = v1 * sc; u32x4 w; w.x = cvt_pk_bf16(v0[0], v0[1]); w.y = cvt_pk_bf16(v0[2], v0[3]); w.z = cvt_pk_bf16(v1[0], v1[1]); w.w = cvt_pk_bf16(v1[2], v1[3]);
                    *(u32x4*)(rowp + bj * HALF) = w; } }
    }
};

struct EpiRes {
    static constexpr bool PERM = false, AFTER_DRAIN = false;
    const float* base_lat; const float* base_ctx; float* out_lat; float* out_ctx; const float* gvec; int row_off;
    __device__ __forceinline__ void operator()(const f32x4 (&acc)[2][2][4][2], const Unit& u, int wr, int wc, int fr, int fq) const {
        const int grow0 = row_off + u.pm * BM;
        const bool isctx = grow0 >= 32768;
        const int bi = isctx ? 16 : (grow0 >> 11);
        const float* base = isctx ? base_ctx + (size_t)(grow0 - 32768) * 1024 : base_lat + (size_t)grow0 * 1024;
        float* out = isctx ? out_ctx + (size_t)(grow0 - 32768) * 1024 : out_lat + (size_t)grow0 * 1024;
        const int col0 = u.pn * BM + wc * 32 + 4 * fq;
        const float* gv = gvec + bi * 6144 + col0;
        f32x4 g[2][2];
#pragma unroll
        for (int bj = 0; bj < 2; ++bj)
#pragma unroll
            for (int n = 0; n < 2; ++n) g[bj][n] = *(const f32x4*)(gv + bj * HALF + n * 16);
#pragma unroll
        for (int ai = 0; ai < 2; ++ai)
#pragma unroll
            for (int m = 0; m < 4; ++m) { const size_t off = (size_t)(ai * HALF + wr * 64 + m * 16 + fr) * 1024 + col0;
#pragma unroll
                for (int bj = 0; bj < 2; ++bj)
#pragma unroll
                    for (int n = 0; n < 2; ++n) { const f32x4 bs = *(const f32x4*)(base + off + bj * HALF + n * 16);
                        *(f32x4*)(out + off + bj * HALF + n * 16) = bs + g[bj][n] * acc[ai][bj][m][n]; }
                if (m & 1) asm volatile("" ::: "memory"); }
    }
};

template <int CTRL> __device__ __forceinline__ float dppf(float x) { return __builtin_bit_cast(float, __builtin_amdgcn_update_dpp(0, __builtin_bit_cast(int, x), CTRL, 0xf, 0xf, true)); }
template <int CTRL> __device__ __forceinline__ f32x4 dpp4(const f32x4 v) { f32x4 r; r.x = dppf<CTRL>(v.x); r.y = dppf<CTRL>(v.y); r.z = dppf<CTRL>(v.z); r.w = dppf<CTRL>(v.w); return r; }
__device__ __forceinline__ float silu_r(float x) { return x * __builtin_amdgcn_rcpf(1.f + __expf(-x)); }
struct EpiConv {
    static constexpr bool PERM = true, AFTER_DRAIN = false;
    bf16_t* act; float* edge; const float* cw; const float* cb; const float* rowss; const float* shw;
    __device__ __forceinline__ void operator()(const f32x4 (&acc)[2][2][4][2], const Unit& u, int wr, int wc, int fr_in, int fq_in) const {
        int fr = fr_in, fq = fq_in; asm volatile("" : "+v"(fr), "+v"(fq));
        const int f0 = u.pn * 128 + wc * 32 + 8 * fq;
        const int bi = (u.pm * BM >= 32768) ? 16 : ((u.pm * BM) >> 11);
        const float* sp = shw + (size_t)bi * 5632 + u.pn * BM + wc * 32 + 8 * fq;
        const int Rw = u.pm * BM + wr * 64;
        float rs[2][4];
#pragma unroll
        for (int ai = 0; ai < 2; ++ai)
#pragma unroll
            for (int m = 0; m < 4; ++m) rs[ai][m] = __builtin_amdgcn_rsqf(rowss[Rw + ai * HALF + 16 * m + fr] * (1.f / 1024.f) + 1e-6f);
        unsigned pk[2][2][4][2];
#pragma unroll
        for (int n = 0; n < 2; ++n) {
            const int f = f0 + 4 * n;
            const f32x4 w0g = *(const f32x4*)(cw + f), w1g = *(const f32x4*)(cw + 5632 + f), w2g = *(const f32x4*)(cw + 2 * 5632 + f), bg = *(const f32x4*)(cb + f);
            const f32x4 w0v = *(const f32x4*)(cw + 2816 + f), w1v = *(const f32x4*)(cw + 5632 + 2816 + f), w2v = *(const f32x4*)(cw + 2 * 5632 + 2816 + f), bv = *(const f32x4*)(cb + 2816 + f);
            const f32x4 sg = *(const f32x4*)(sp + 4 * n), sv = *(const f32x4*)(sp + HALF + 4 * n);
#pragma unroll
            for (int ai = 0; ai < 2; ++ai) {
                const int R0 = Rw + ai * HALF;
                f32x4 xg[4], xv[4];
#pragma unroll
                for (int m = 0; m < 4; ++m) { xg[m] = acc[ai][0][m][n] * rs[ai][m] + sg; xv[m] = acc[ai][1][m][n] * rs[ai][m] + sv; }
#pragma unroll
                for (int m = 0; m < 4; ++m) {
                    const f32x4 g = xg[m], v = xv[m];
                    f32x4 pg = dpp4<0x111>(g), pv = dpp4<0x111>(v), ng = dpp4<0x101>(g), nv = dpp4<0x101>(v);
                    if (m > 0) { pg += dpp4<0x10F>(xg[m - 1]); pv += dpp4<0x10F>(xv[m - 1]); }
                    if (m < 3) { ng += dpp4<0x11F>(xg[m + 1]); nv += dpp4<0x11F>(xv[m + 1]); }
                    const f32x4 cg = w0g * pg + w1g * g + w2g * ng + bg, cv = w0v * pv + w1v * v + w2v * nv + bv;
                    if ((m == 0 && fr == 0) || (m == 3 && fr == 15)) {
                        float* ep = edge + ((size_t)((R0 >> 6) * 2 + (m == 3 ? 1 : 0)) * 4) * 2816 + f;
                        *(f32x4*)ep = cg; *(f32x4*)(ep + 2816) = cv; *(f32x4*)(ep + 2 * 2816) = g; *(f32x4*)(ep + 3 * 2816) = v;
                    }
                    pk[ai][n][m][0] = cvt_pk_bf16(silu_r(cg.x) * cv.x, silu_r(cg.y) * cv.y); pk[ai][n][m][1] = cvt_pk_bf16(silu_r(cg.z) * cv.z, silu_r(cg.w) * cv.w);
                }
            }
        }
#pragma unroll
        for (int ai = 0; ai < 2; ++ai)
#pragma unroll
            for (int m = 0; m < 4; ++m) { u32x4 w; w.x = pk[ai][0][m][0]; w.y = pk[ai][0][m][1]; w.z = pk[ai][1][m][0]; w.w = pk[ai][1][m][1];
                *(u32x4*)(act + (size_t)(Rw + ai * HALF + 16 * m + fr) * 2816 + f0) = w; }
    }
};

struct EpiProj {
    static constexpr bool PERM = true, AFTER_DRAIN = false;
    bf16_t* O; float* gates; const float* cvec; const float* rowss; const float* gq; const float* gk; const float* rope; float qscale;
    __device__ __forceinline__ void operator()(const f32x4 (&acc)[2][2][4][2], const Unit& u, int wr, int wc, int fr_in, int fq_in) const {
        int fr = fr_in, fq = fq_in; asm volatile("" : "+v"(fr), "+v"(fq));
        const int row0 = u.pm * BM + wr * 64 + fr;
        const int col0 = u.pn * BM + wc * 32 + 8 * fq;
        const bool isctx = u.pm * BM >= 32768;
        const int bi = isctx ? 16 : ((u.pm * BM) >> 11);
        const float* bias = cvec + (size_t)bi * 2560;
        float rs[2][4];
#pragma unroll
        for (int ai = 0; ai < 2; ++ai)
#pragma unroll
            for (int m = 0; m < 4; ++m) rs[ai][m] = __builtin_amdgcn_rsqf(rowss[row0 + ai * HALF + m * 16] * (1.f / 1024.f) + 1e-6f);
        if (u.pn < 9) {
            f32x4 bv[2][2];
#pragma unroll
            for (int bj = 0; bj < 2; ++bj)
#pragma unroll
                for (int n = 0; n < 2; ++n) bv[bj][n] = *(const f32x4*)(bias + col0 + bj * HALF + 4 * n);
            const bool qk = u.pn < 2 || (u.pn == 2 && wc < 2);
            if (qk) {
                const bool isq = u.pn < 2;
                const float* gw_ = isq ? gq : gk;
                const int hoff = isq ? (4 * u.pn + wc) * 64 : 512 + wc * 64;
                const float sc = isq ? qscale : 1.f;
                f32x4 gw[2][2];
#pragma unroll
                for (int bj = 0; bj < 2; ++bj)
#pragma unroll
                    for (int n = 0; n < 2; ++n) gw[bj][n] = *(const f32x4*)(gw_ + 32 * bj + 16 * n + 4 * fq) * sc;
                const int ln_ = fq * 16 + fr;
#pragma unroll
                for (int ai = 0; ai < 2; ++ai)
#pragma unroll
                    for (int m = 0; m < 4; ++m) {
                        const int row = row0 + ai * HALF + m * 16;
                        f32x4 v[2][2]; float ss = 0.f;
#pragma unroll
                        for (int bj = 0; bj < 2; ++bj)
#pragma unroll
                            for (int n = 0; n < 2; ++n) { v[bj][n] = acc[ai][bj][m][n] * rs[ai][m] + bv[bj][n]; ss += (v[bj][n].x * v[bj][n].x + v[bj][n].y * v[bj][n].y) + (v[bj][n].z * v[bj][n].z + v[bj][n].w * v[bj][n].w); }
                        ss += __builtin_bit_cast(float, __builtin_amdgcn_ds_bpermute((ln_ ^ 16) << 2, __builtin_bit_cast(int, ss)));
                        ss += __builtin_bit_cast(float, __builtin_amdgcn_ds_bpermute((ln_ ^ 32) << 2, __builtin_bit_cast(int, ss)));
                        const float rstd = __builtin_amdgcn_rsqf(ss * (1.f / 64.f) + 1e-6f);
                        const int pos = row & 2047;
#pragma unroll
                        for (int bj = 0; bj < 2; ++bj) {
                            f32x4 y1 = v[bj][0] * rstd * gw[bj][0], y2 = v[bj][1] * rstd * gw[bj][1];
                            if (!isctx) { const int pa = bj == 0 ? (pos >> 6) : (pos & 63);
                                const f32x4 c = *(const f32x4*)(rope + pa * 16 + 4 * fq), s = *(const f32x4*)(rope + 1024 + pa * 16 + 4 * fq);
                                const f32x4 o1 = y1 * c - y2 * s, o2 = y2 * c + y1 * s; y1 = o1; y2 = o2; }
                            u32x4 w; w.x = cvt_pk_bf16(y1[0], y1[1]); w.y = cvt_pk_bf16(y1[2], y1[3]); w.z = cvt_pk_bf16(y2[0], y2[1]); w.w = cvt_pk_bf16(y2[2], y2[3]);
                            *(u32x4*)(O + (size_t)row * 2304 + hoff + 32 * bj + 8 * fq) = w;
                        }
                    }
            } else {
                const int ocol = (u.pn == 2) ? 640 + 64 * (wc - 2) + 8 * fq : col0;
                const int ostep = (u.pn == 2) ? 32 : HALF;
#pragma unroll
                for (int ai = 0; ai < 2; ++ai)
#pragma unroll
                    for (int m = 0; m < 4; ++m) { bf16_t* rowp = O + (size_t)(row0 + ai * HALF + m * 16) * 2304 + ocol;
#pragma unroll
                        for (int bj = 0; bj < 2; ++bj) { const f32x4 v0 = acc[ai][bj][m][0] * rs[ai][m] + bv[bj][0], v1 = acc[ai][bj][m][1] * rs[ai][m] + bv[bj][1];
                            u32x4 w; w.x = cvt_pk_bf16(v0[0], v0[1]); w.y = cvt_pk_bf16(v0[2], v0[3]); w.z = cvt_pk_bf16(v1[0], v1[1]); w.w = cvt_pk_bf16(v1[2], v1[3]);
                            *(u32x4*)(rowp + bj * ostep) = w; } }
            }
        } else if (wc == 0 && fq < 2) {
            const f32x4 b0 = *(const f32x4*)(bias + col0), b1 = *(const f32x4*)(bias + col0 + 4);
#pragma unroll
            for (int ai = 0; ai < 2; ++ai)
#pragma unroll
                for (int m = 0; m < 4; ++m) { float* gp = gates + (size_t)(row0 + ai * HALF + m * 16) * 16 + 8 * fq;
                    *(f32x4*)gp = acc[ai][0][m][0] * rs[ai][m] + b0; *(f32x4*)(gp + 4) = acc[ai][0][m][1] * rs[ai][m] + b1; }
        }
    }
};

struct EpiRes2 {
    static constexpr bool PERM = true, AFTER_DRAIN = false;
    const float* base_lat; const float* base_ctx; float* out_lat; float* out_ctx; const float* gvec;
    bf16_t* an; const float* gn; const float* svec; float* rowss;
    __device__ __forceinline__ void operator()(const f32x4 (&acc)[2][2][4][2], const Unit& u, int wr, int wc, int fr_in, int fq_in) const {
        int fr = fr_in, fq = fq_in; asm volatile("" : "+v"(fr), "+v"(fq));
        const int grow0 = u.pm * BM;
        const bool isctx = grow0 >= 32768;
        const int bi = isctx ? 16 : (grow0 >> 11);
        const float* base = isctx ? base_ctx + (size_t)(grow0 - 32768) * 1024 : base_lat + (size_t)grow0 * 1024;
        float* out = isctx ? out_ctx + (size_t)(grow0 - 32768) * 1024 : out_lat + (size_t)grow0 * 1024;
        const int col0 = u.pn * BM + wc * 32 + 8 * fq;
        const float* gv = gvec + bi * 6144 + col0;
        bf16_t* anb = an + (size_t)grow0 * 1024; float* rsb = rowss + grow0;
        f32x4 g[2][2], ns[2][2];
#pragma unroll
        for (int bj = 0; bj < 2; ++bj)
#pragma unroll
            for (int n = 0; n < 2; ++n) { g[bj][n] = *(const f32x4*)(gv + bj * HALF + 4 * n);
                if (an) ns[bj][n] = *(const f32x4*)(gn + col0 + bj * HALF + 4 * n) * (1.f + *(const f32x4*)(svec + bi * 6144 + col0 + bj * HALF + 4 * n)); }
#pragma unroll
        for (int ai = 0; ai < 2; ++ai) {
            f32x4 pre[4][2][2];
#pragma unroll
            for (int m = 0; m < 4; ++m) { const unsigned off = (unsigned)((ai * HALF + wr * 64 + m * 16 + fr) * 1024 + col0);
#pragma unroll
                for (int bj = 0; bj < 2; ++bj) { pre[m][bj][0] = *(const f32x4*)(base + off + bj * HALF); pre[m][bj][1] = *(const f32x4*)(base + off + bj * HALF + 4); } }
#pragma unroll
            for (int m = 0; m < 4; ++m) { const int row = ai * HALF + wr * 64 + m * 16 + fr; const unsigned off = (unsigned)(row * 1024 + col0); float ss = 0.f;
#pragma unroll
                for (int bj = 0; bj < 2; ++bj) {
                    const f32x4 o0 = pre[m][bj][0] + g[bj][0] * acc[ai][bj][m][0], o1 = pre[m][bj][1] + g[bj][1] * acc[ai][bj][m][1];
                    *(f32x4*)(out + off + bj * HALF) = o0; *(f32x4*)(out + off + bj * HALF + 4) = o1;
                    if (an) { ss += (o0.x * o0.x + o0.y * o0.y) + (o0.z * o0.z + o0.w * o0.w) + (o1.x * o1.x + o1.y * o1.y) + (o1.z * o1.z + o1.w * o1.w);
                        const f32x4 a0 = o0 * ns[bj][0], a1 = o1 * ns[bj][1];
                        u32x4 w; w.x = cvt_pk_bf16(a0[0], a0[1]); w.y = cvt_pk_bf16(a0[2], a0[3]); w.z = cvt_pk_bf16(a1[0], a1[1]); w.w = cvt_pk_bf16(a1[2], a1[3]);
                        *(u32x4*)(anb + off + bj * HALF) = w; }
                }
                if (an) { const int ln_ = fq * 16 + fr;
                    ss += __builtin_bit_cast(float, __builtin_amdgcn_ds_bpermute((ln_ ^ 16) << 2, __builtin_bit_cast(int, ss))); ss += __builtin_bit_cast(float, __builtin_amdgcn_ds_bpermute((ln_ ^ 32) << 2, __builtin_bit_cast(int, ss)));
                    if (fq == 0) unsafeAtomicAdd(rsb + row, ss); }
            }
            asm volatile("" ::: "memory");
        }
    }
};


struct SingleUnit {
    int pm, pn;
    __device__ __forceinline__ bool next(int i, Unit& u) const { if (i) return false; u.pm = pm; u.pn = pn; return true; }
    __device__ __forceinline__ void a_ready(const Unit&) const {}
    __device__ __forceinline__ void done(const Unit&) const {}
};
struct EpiSlab {
    static constexpr bool PERM = true, AFTER_DRAIN = false;
    float* O;
    __device__ __forceinline__ void operator()(const f32x4 (&acc)[2][2][4][2], const Unit& u, int wr, int wc, int fr, int fq) const {
        float* base = O + (size_t)(u.pm * BM + wr * 64 + fr) * 1024 + u.pn * BM + wc * 32 + 8 * fq;
#pragma unroll
        for (int ai = 0; ai < 2; ++ai)
#pragma unroll
            for (int m = 0; m < 4; ++m)
#pragma unroll
                for (int bj = 0; bj < 2; ++bj) { float* p = base + (size_t)(ai * HALF + m * 16) * 1024 + bj * HALF; *(f32x4*)p = acc[ai][bj][m][0]; *(f32x4*)(p + 4) = acc[ai][bj][m][1]; }
    }
};

template <class Epi, class Sched, bool ALIGN_EPI = false, bool SP2 = false>
__device__ __forceinline__ void gemm_phase(PG8_LAS unsigned char* lds, const Gemm g, const Sched& S, const Epi& E, const int tid_in) {
    const int tid = tid_in, wid = __builtin_amdgcn_readfirstlane(tid >> 6), lane = tid & 63, wr = wid >> 2, wc = wid & 3, fr = lane & 15, fq = lane >> 4;
    const int K = g.K, nt = K / BK, LD = g.ld ? g.ld : K;
    unsigned voffA[2], voffB[2];
#pragma unroll
    for (int i = 0; i < 2; ++i) { int R, C; stage_rc(tid * 16 + i * 8192, R, C); const int Rb = Epi::PERM ? ((R & ~31) + perm32(R & 31)) : R;
        voffA[i] = (unsigned)(R * LD + C) * 2u; voffB[i] = (unsigned)(Rb * LD + C) * 2u; }
    const size_t kstep = (size_t)(BK * 2);
    const size_t hstep = (size_t)HALF * LD * 2;
    const size_t tstep = 2 * hstep;
    const unsigned ldsw = (unsigned)wid * 1024u;
    const int aoff = lds_byte(wr * 64 + fr, fq * 8), boff = lds_byte(wc * 32 + fr, fq * 8);
#define PG8_SA(b, h) (((b) * 2 + (h)) * HTB)
#define PG8_SB(b, h) ((4 + (b) * 2 + (h)) * HTB)
#define PG8_STAGE(bufoff, gbase, voff) do { _Pragma("unroll") for (int _i = 0; _i < 2; ++_i) \
        __builtin_amdgcn_global_load_lds((const unsigned*)((const char*)(gbase) + (voff)[_i]), (PG8_LAS unsigned*)(lds + (bufoff) + ldsw + _i * 8192), 16, 0, 0); } while (0)
#define PG8_LDA(dst, b, h) do { _Pragma("unroll") for (int m = 0; m < 4; ++m) _Pragma("unroll") for (int k = 0; k < 2; ++k) dst[m][k] = *(const PG8_LAS bf16x8*)(lds + PG8_SA(b, h) + aoff + m * 2048 + k * 1024); } while (0)
#define PG8_LDB(dst, b, h) do { _Pragma("unroll") for (int n = 0; n < 2; ++n) _Pragma("unroll") for (int k = 0; k < 2; ++k) dst[n][k] = *(const PG8_LAS bf16x8*)(lds + PG8_SB(b, h) + boff + n * 2048 + k * 1024); } while (0)
#define PG8_MMA(ai, bj, At, Bt) do { __builtin_amdgcn_s_setprio(1); _Pragma("unroll") for (int m = 0; m < 4; ++m) _Pragma("unroll") for (int n = 0; n < 2; ++n) _Pragma("unroll") for (int k = 0; k < 2; ++k) \
        acc[ai][bj][m][n] = __builtin_amdgcn_mfma_f32_16x16x32_bf16(Bt[n][k], At[m][k], acc[ai][bj][m][n], 0, 0, 0); __builtin_amdgcn_s_setprio(0); } while (0)
#define PG8_WAIT_V(n) asm volatile("s_waitcnt vmcnt(" #n ")" ::: "memory")
#define PG8_WAIT_L(n) asm volatile("s_waitcnt lgkmcnt(" #n ")" ::: "memory")
#define PG8_BAR __builtin_amdgcn_s_barrier()
#define PG8_SCHED __builtin_amdgcn_sched_barrier(0)
    Unit cur, nxt; int ui = 0;
    if (!S.next(0, cur)) return;
    f32x4 acc[2][2][4][2];
#pragma unroll
    for (int a = 0; a < 2; ++a)
#pragma unroll
        for (int b = 0; b < 2; ++b)
#pragma unroll
            for (int m = 0; m < 4; ++m)
#pragma unroll
                for (int n = 0; n < 2; ++n) acc[a][b][m][n] = (f32x4){0.f, 0.f, 0.f, 0.f};
    bf16x8 At[4][2], B0[2][2], B1[2][2];
    const char* cA = (const char*)g.A + (size_t)cur.pm * tstep; const char* cB = (const char*)g.Bt + (size_t)cur.pn * tstep;
    S.a_ready(cur);
    if constexpr (SP2) {
        PG8_STAGE(PG8_SB(0, 0), cB, voffB); PG8_STAGE(PG8_SB(0, 1), cB + hstep, voffB); PG8_STAGE(PG8_SA(0, 0), cA, voffA); PG8_STAGE(PG8_SA(0, 1), cA + hstep, voffA);
        if (wr == 1) PG8_BAR;
        PG8_WAIT_V(2); PG8_BAR;
        PG8_STAGE(PG8_SB(1, 0), cB + kstep, voffB); PG8_STAGE(PG8_SA(1, 0), cA + kstep, voffA); PG8_STAGE(PG8_SB(1, 1), cB + hstep + kstep, voffB);
        PG8_WAIT_V(6); PG8_BAR;
    } else {
        PG8_STAGE(PG8_SB(0, 0), cB, voffB); PG8_STAGE(PG8_SA(0, 0), cA, voffA); PG8_STAGE(PG8_SB(0, 1), cB + hstep, voffB); PG8_STAGE(PG8_SA(0, 1), cA + hstep, voffA);
        if (wr == 1) PG8_BAR;
        PG8_WAIT_V(4); PG8_BAR;
        PG8_STAGE(PG8_SB(1, 0), cB + kstep, voffB); PG8_STAGE(PG8_SA(1, 0), cA + kstep, voffA); PG8_STAGE(PG8_SB(1, 1), cB + hstep + kstep, voffB);
        PG8_WAIT_V(6); PG8_BAR;
    }
    for (;;) {
        const bool has_next = S.next(ui + 1, nxt);
        const char* nA = has_next ? (const char*)g.A + (size_t)nxt.pm * tstep : cA; const char* nB = has_next ? (const char*)g.Bt + (size_t)nxt.pn * tstep : cB;
        for (int t = 0; t < nt; t += 2) {
            const bool last = (t == nt - 2);
            const char* a1 = cA + (size_t)(t + 1) * kstep;
            const char* a2 = last ? nA : cA + (size_t)(t + 2) * kstep; const char* b2 = last ? nB : cB + (size_t)(t + 2) * kstep;
            const char* a3 = a2 + kstep; const char* b3 = b2 + kstep;
            if (last && has_next) S.a_ready(nxt);
            if constexpr (SP2) {
            PG8_LDB(B0, 0, 0); PG8_LDB(B1, 0, 1); PG8_SCHED; PG8_LDA(At, 0, 0); PG8_STAGE(PG8_SA(1, 1), a1 + hstep, voffA);
            PG8_WAIT_V(8); PG8_WAIT_L(0); PG8_BAR; PG8_MMA(0, 0, At, B0); PG8_MMA(0, 1, At, B1); PG8_BAR; PG8_SCHED;
            PG8_LDA(At, 0, 1); PG8_STAGE(PG8_SB(0, 0), b2, voffB); PG8_STAGE(PG8_SB(0, 1), b2 + hstep, voffB); PG8_STAGE(PG8_SA(0, 0), a2, voffA);
            PG8_WAIT_V(8); PG8_WAIT_L(0); PG8_BAR; PG8_MMA(1, 0, At, B0); PG8_MMA(1, 1, At, B1); PG8_BAR; PG8_SCHED;
            PG8_LDB(B0, 1, 0); PG8_LDB(B1, 1, 1); PG8_SCHED; PG8_LDA(At, 1, 0); PG8_STAGE(PG8_SA(0, 1), a2 + hstep, voffA);
            PG8_WAIT_V(8); PG8_WAIT_L(0); PG8_BAR; PG8_MMA(0, 0, At, B0); PG8_MMA(0, 1, At, B1); PG8_BAR; PG8_SCHED;
            PG8_LDA(At, 1, 1); PG8_STAGE(PG8_SB(1, 0), b3, voffB); PG8_STAGE(PG8_SB(1, 1), b3 + hstep, voffB); PG8_STAGE(PG8_SA(1, 0), a3, voffA);
            PG8_WAIT_V(8); PG8_WAIT_L(0); PG8_BAR; PG8_MMA(1, 0, At, B0); PG8_MMA(1, 1, At, B1); PG8_BAR; PG8_SCHED;
            } else {
            PG8_LDB(B0, 0, 0); PG8_SCHED; PG8_LDA(At, 0, 0); PG8_STAGE(PG8_SA(1, 1), a1 + hstep, voffA);
            PG8_WAIT_L(8); PG8_BAR; PG8_WAIT_L(0); PG8_MMA(0, 0, At, B0); PG8_BAR; PG8_SCHED;
            PG8_LDB(B1, 0, 1); PG8_STAGE(PG8_SB(0, 0), b2, voffB);
            PG8_BAR; PG8_WAIT_L(0); PG8_MMA(0, 1, At, B1); PG8_BAR;
            PG8_LDA(At, 0, 1); PG8_STAGE(PG8_SA(0, 0), a2, voffA);
            PG8_BAR; PG8_WAIT_L(0); PG8_MMA(1, 0, At, B0); PG8_BAR; PG8_SCHED;
            PG8_STAGE(PG8_SB(0, 1), b2 + hstep, voffB);
            PG8_WAIT_V(6); PG8_BAR; PG8_MMA(1, 1, At, B1); PG8_BAR;
            PG8_LDB(B0, 1, 0); PG8_SCHED; PG8_LDA(At, 1, 0); PG8_STAGE(PG8_SA(0, 1), a2 + hstep, voffA);
            PG8_WAIT_L(8); PG8_BAR; PG8_WAIT_L(0); PG8_MMA(0, 0, At, B0); PG8_BAR; PG8_SCHED;
            PG8_LDB(B1, 1, 1); PG8_STAGE(PG8_SB(1, 0), b3, voffB);
            PG8_BAR; PG8_WAIT_L(0); PG8_MMA(0, 1, At, B1); PG8_BAR;
            PG8_LDA(At, 1, 1); PG8_STAGE(PG8_SA(1, 0), a3, voffA);
            PG8_BAR; PG8_WAIT_L(0); PG8_MMA(1, 0, At, B0); PG8_BAR; PG8_SCHED;
            PG8_STAGE(PG8_SB(1, 1), b3 + hstep, voffB);
            PG8_WAIT_V(6); PG8_BAR; PG8_MMA(1, 1, At, B1); PG8_BAR;
            }
        }
        if constexpr (ALIGN_EPI) { if (wr == 0) PG8_BAR; }
        if constexpr (!Epi::AFTER_DRAIN) { E(acc, cur, wr, wc, fr, fq); S.done(cur); }
        if (!has_next) break;
#pragma unroll
        for (int a = 0; a < 2; ++a)
#pragma unroll
            for (int b = 0; b < 2; ++b)
#pragma unroll
                for (int m = 0; m < 4; ++m)
#pragma unroll
                    for (int n = 0; n < 2; ++n) acc[a][b][m][n] = (f32x4){0.f, 0.f, 0.f, 0.f};
        cur = nxt; cA = nA; cB = nB; ++ui;
        if constexpr (ALIGN_EPI) { if (wr == 1) PG8_BAR; }
    }
    PG8_WAIT_V(0);
    if constexpr (!ALIGN_EPI) { if (wr == 0) PG8_BAR; }
    PG8_BAR;
    if constexpr (Epi::AFTER_DRAIN) { E.fused(acc, cur, wr, wc, fr, fq, lds, wid, lane); S.done(cur); }
#undef PG8_SA
#undef PG8_SB
#undef PG8_STAGE
#undef PG8_LDA
#undef PG8_LDB
#undef PG8_MMA
#undef PG8_WAIT_V
#undef PG8_WAIT_L
#undef PG8_BAR
#undef PG8_SCHED
}
}
namespace attn_body {
using bf16=__hip_bfloat16;
using bf16x8=__attribute__((ext_vector_type(8)))short;
using s16x4=__attribute__((ext_vector_type(4)))short;
using f32x16=__attribute__((ext_vector_type(16)))float;
using u32x4=__attribute__((ext_vector_type(4)))unsigned;
constexpr int D=64,QP=2304,KP=2304,OP=1024;
constexpr int NW=8,QBLK=32,QB=QBLK*NW,KVBLK=64;
__device__ __forceinline__ int crow(int r,int hi){return (r&3)+8*(r>>2)+4*hi;}
#define SBAR() __builtin_amdgcn_sched_barrier(0)
__device__ __forceinline__ void cmask(f32x16&p0,f32x16&p1,int jb,int qrel,int hi){
  const float NEG=-INFINITY; int kb=64*jb+4*hi;
  #pragma unroll
  for(int r=0;r<16;++r){int kv=kb+(r&3)+8*(r>>2); if(kv>qrel)p0[r]=NEG; if(kv+32>qrel)p1[r]=NEG;}
}

constexpr int NSLOT=3, SLOTB=8192;
constexpr int LDS_K=0, LDS_V=NSLOT*SLOTB, LDS_WS=2*NSLOT*SLOTB, LDS_OST=LDS_WS+NW*64*4, LDS_BYTES=LDS_OST+NW*4096;
constexpr float C2=0.125f*1.4426950408889634f;
__device__ __forceinline__ void glds16(const void*gsrc,unsigned lds_dst){unsigned keep;
  asm volatile("s_mov_b32 %0, m0\n\ts_mov_b32 m0, %2\n\ts_nop 0\n\tglobal_load_lds_dwordx4 %1, off\n\ts_mov_b32 m0, %0":"=&s"(keep):"v"(gsrc),"s"(lds_dst):"memory");}
__device__ __forceinline__ float max3f(float a,float b,float c){float r;asm("v_max3_f32 %0, %1, %2, %3":"=v"(r):"v"(a),"v"(b),"v"(c));return r;}
__device__ __forceinline__ float max2f(float a,float b){float r;asm("v_max_f32_e32 %0, %1, %2":"=v"(r):"v"(a),"v"(b));return r;}
__device__ __forceinline__ float fadd_s(float a,float b){float r;asm("v_add_f32_e32 %0, %1, %2":"=v"(r):"v"(a),"v"(b));return r;}
__device__ __forceinline__ float fsub_s(float a,float b){float r;asm("v_sub_f32_e32 %0, %1, %2":"=v"(r):"v"(a),"v"(b));return r;}
typedef float f32x2_t __attribute__((ext_vector_type(2))); typedef __bf16 bf16x2_t __attribute__((ext_vector_type(2)));
__device__ __forceinline__ unsigned cvtpk_s(float lo,float hi){f32x2_t v={lo,hi};bf16x2_t b=__builtin_convertvector(v,bf16x2_t);return __builtin_bit_cast(unsigned,b);}
#define WAIT_BAR(N) asm volatile("s_waitcnt vmcnt(" #N ") lgkmcnt(0)\n\ts_barrier":::"memory")

__device__ __forceinline__ void qkt(f32x16&p0,f32x16&p1,const char*Kslot,const bf16x8*qr,const f32x16&negm,int r32,int hi){
  const char*kb=Kslot+hi*1024+r32*16;
  #pragma unroll
  for(int d0=0;d0<4;++d0){
    const bf16x8 b0=*reinterpret_cast<const bf16x8*>(kb+d0*2048);
    const bf16x8 b1=*reinterpret_cast<const bf16x8*>(kb+d0*2048+512);
    if(d0==0){p0=__builtin_amdgcn_mfma_f32_32x32x16_bf16(b0,qr[0],negm,0,0,0);p1=__builtin_amdgcn_mfma_f32_32x32x16_bf16(b1,qr[0],negm,0,0,0);}
    else{p0=__builtin_amdgcn_mfma_f32_32x32x16_bf16(b0,qr[d0],p0,0,0,0);p1=__builtin_amdgcn_mfma_f32_32x32x16_bf16(b1,qr[d0],p1,0,0,0);}}
}
typedef __attribute__((address_space(3))) const char* lds_cptr;
typedef short v4i16_t __attribute__((ext_vector_type(4)));
__device__ __forceinline__ void kload8(bf16x8*kf,lds_cptr kp){
  kf[0]=*(const __attribute__((address_space(3))) bf16x8*)(kp);      kf[1]=*(const __attribute__((address_space(3))) bf16x8*)(kp+512);
  kf[2]=*(const __attribute__((address_space(3))) bf16x8*)(kp+2048); kf[3]=*(const __attribute__((address_space(3))) bf16x8*)(kp+2560);
  kf[4]=*(const __attribute__((address_space(3))) bf16x8*)(kp+4096); kf[5]=*(const __attribute__((address_space(3))) bf16x8*)(kp+4608);
  kf[6]=*(const __attribute__((address_space(3))) bf16x8*)(kp+6144); kf[7]=*(const __attribute__((address_space(3))) bf16x8*)(kp+6656);
}
__device__ __forceinline__ void kload2(bf16x8*kf,lds_cptr kp,int j){ kf[2*j]=*(const __attribute__((address_space(3))) bf16x8*)(kp+j*2048); kf[2*j+1]=*(const __attribute__((address_space(3))) bf16x8*)(kp+j*2048+512); }
__device__ __forceinline__ s16x4 vtr(lds_cptr p){ return __builtin_bit_cast(s16x4,__builtin_amdgcn_ds_read_tr16_b64_v4i16((__attribute__((address_space(3))) v4i16_t*)p)); }
__device__ __forceinline__ float rowmax(const f32x16&p0,const f32x16&p1){
  float a=max3f(p0[0],p0[1],p1[0]),b=max3f(p0[2],p0[3],p1[1]);a=max3f(a,p1[2],p1[3]);
  #pragma unroll
  for(int r=4;r<16;r+=4){a=max3f(a,p0[r],p0[r+1]);b=max3f(b,p0[r+2],p0[r+3]);a=max3f(a,p1[r],p1[r+1]);b=max3f(b,p1[r+2],p1[r+3]);}
  const float m=max2f(a,b);
  auto rr=__builtin_amdgcn_permlane32_swap(__float_as_uint(m),__float_as_uint(m),false,false);
  return max2f(__uint_as_float(rr[0]),__uint_as_float(rr[1]));
}
__device__ __forceinline__ void pv(f32x16*o,int vb,bf16x8 pa0,bf16x8 pa1,bf16x8 pa2,bf16x8 pa3){
  #pragma unroll
  for(int d0=0;d0<2;++d0){s16x4 lo[4],hi[4];
    #pragma unroll
    for(int ks=0;ks<4;++ks){
      asm volatile("ds_read_b64_tr_b16 %0,%1 offset:%c2":"=&v"(lo[ks]):"v"(vb),"i"(d0*4096+ks*1024):"memory");
      asm volatile("ds_read_b64_tr_b16 %0,%1 offset:%c2":"=&v"(hi[ks]):"v"(vb),"i"(d0*4096+ks*1024+512):"memory");}
    asm volatile("s_waitcnt lgkmcnt(0)":::"memory");SBAR();
    #define PK(k) (bf16x8){lo[k][0],lo[k][1],lo[k][2],lo[k][3],hi[k][0],hi[k][1],hi[k][2],hi[k][3]}
    o[d0]=__builtin_amdgcn_mfma_f32_32x32x16_bf16(pa0,PK(0),o[d0],0,0,0);
    o[d0]=__builtin_amdgcn_mfma_f32_32x32x16_bf16(pa1,PK(1),o[d0],0,0,0);
    o[d0]=__builtin_amdgcn_mfma_f32_32x32x16_bf16(pa2,PK(2),o[d0],0,0,0);
    o[d0]=__builtin_amdgcn_mfma_f32_32x32x16_bf16(pa3,PK(3),o[d0],0,0,0);
    #undef PK
  }
}

#ifndef ATTN_STORE16
#define ATTN_STORE16(p,v) (*(u32x4*)(p)=(v))
#endif
template<int THRL> __device__ __forceinline__ void attn_unit(const bf16*Qu,const bf16*__restrict__ Kc,const bf16*__restrict__ Vc,const bf16*__restrict__ Kl,const bf16*__restrict__ Vl,const int NT,bf16*Ou,char*shm,const int tid_in){
  const int tid=tid_in,lane=tid&63,r32=lane&31,hi=lane>>5; const int wid=__builtin_amdgcn_readfirstlane(tid>>6);
  const bf16*Qw=Qu+(long)(wid*QBLK)*QP;
  const unsigned lds0=(unsigned)(uintptr_t)shm;
  float*wsf=(float*)(shm+LDS_WS)+wid*64;
  const long koff=(long)lane*KP+wid*8;
  const long voff=(long)(16*(wid&3)+(lane>>2))*KP+(wid>>2)*32+(lane&3)*8;
  const unsigned kdst=lds0+LDS_K+wid*1024, vdst=lds0+LDS_V+wid*1024;
  #define DMA_K(t,slot) glds16((((t)<4)?(Kc+(long)(t)*KVBLK*KP):(Kl+(long)((t)-4)*KVBLK*KP))+koff,(unsigned)__builtin_amdgcn_readfirstlane(kdst+(slot)))
  #define DMA_V(t,slot) glds16((((t)<4)?(Vc+(long)(t)*KVBLK*KP):(Vl+(long)((t)-4)*KVBLK*KP))+voff,(unsigned)__builtin_amdgcn_readfirstlane(vdst+(slot)))
  const int vb0=(int)(lds0+LDS_V)+((lane>>4)&1)*32+(lane&3)*8+(4*hi+((lane&15)>>2))*64;
  const char*Kbase=shm+LDS_K; bf16x8 kf[8];
  const lds_cptr shm3=(lds_cptr)shm; const lds_cptr kp0=shm3+LDS_K+hi*1024+r32*16; const lds_cptr vp0=shm3+LDS_V+((lane>>4)&1)*32+(lane&3)*8+(4*hi+((lane&15)>>2))*64;
  DMA_K(0,0);DMA_V(0,0);DMA_K(1,SLOTB);
  bf16x8 qr[4];
  #pragma unroll
  for(int d0=0;d0<4;++d0)qr[d0]=*reinterpret_cast<const bf16x8*>(&Qw[(long)r32*QP+d0*16+hi*8]);
  float mhat=0.f,l_reg=0.f;f32x16 o[2];o[0]=f32x16{};o[1]=f32x16{};f32x16 negm=f32x16{};asm volatile("":"+v"(negm));
  #define CMASK(P0,P1,t) do{}while(0)
  bool resc=false;
  #define START(P0,P1) do{ const float rm=rowmax(P0,P1); resc=false; \
    { const float dl=rm; mhat=fadd_s(mhat,dl); \
      _Pragma("unroll") for(int r=0;r<16;++r){P0[r]=fsub_s(P0[r],dl);P1[r]=fsub_s(P1[r],dl);} \
      _Pragma("unroll") for(int r=0;r<16;++r)negm[r]=-mhat; asm volatile("":"+v"(negm)); } \
    _Pragma("unroll") for(int r=0;r<16;++r)P0[r]=__builtin_amdgcn_exp2f(P0[r]); }while(0)
  #define RESC() do{ if(resc){ asm volatile("s_waitcnt lgkmcnt(0)":::"memory"); \
      _Pragma("unroll") for(int d_=0;d_<2;++d_) _Pragma("unroll") for(int r=0;r<16;++r)o[d_][r]*=wsf[crow(r,hi)]; } }while(0)
  f32x16 pA0,pA1,pB0,pB1;
  int sl_prev=0,sl_cur=0,sl_next=SLOTB;
  #define ROT() do{sl_prev=sl_cur;sl_cur=sl_next;sl_next=(sl_next==(NSLOT-1)*SLOTB)?0:sl_next+SLOTB;}while(0)
  DMA_K(2,2*SLOTB);
  WAIT_BAR(3);
  qkt(pA0,pA1,Kbase,qr,negm,r32,hi);asm volatile("s_nop 15\n\ts_nop 7":"+v"(pA0),"+v"(pA1));CMASK(pA0,pA1,0);
  START(pA0,pA1);
  _Pragma("unroll") for(int r=0;r<16;++r)pA1[r]=__builtin_amdgcn_exp2f(pA1[r]);
  WAIT_BAR(0);
  DMA_K(3,0);DMA_V(1,SLOTB);
  ROT();
  kload8(kf,kp0+sl_cur);
  WAIT_BAR(2);
  s16x4 vlo[8],vhi[8]; u32x4 pw0,pw1,pw2,pw3;
  #define PKW(P,B) cvtpk_s(P[B],P[B+1])
  #define PAF(k) __builtin_bit_cast(bf16x8,pw##k)
  #define VFR(i) (bf16x8){vlo[i][0],vlo[i][1],vlo[i][2],vlo[i][3],vhi[i][0],vhi[i][1],vhi[i][2],vhi[i][3]}
  #define PIN(x) asm volatile("":"+v"(x))
  #define MX3(a,b,c) __builtin_fmaxf(__builtin_fmaxf((a),(b)),(c))
  #define GAPA(MF,A0,A1,A2,A3,W0,W1,PW) do{ MF; sacc+=A0; sacc+=A1; sacc+=A2; sacc+=A3; PIN(sacc); W0; W1; PIN(PW); SBAR(); }while(0)
  #define EX(v) __builtin_amdgcn_exp2f(v)
  #define GAPB(MF,X,B) do{ MF; X[B]=EX(X[B]); X[B+1]=EX(X[B+1]); X[B+2]=EX(X[B+2]); X[B+3]=EX(X[B+3]); PIN(X); SBAR(); }while(0)
  #define VRD(i) do{ vlo[i]=vtr(vp_+(((i)>>2)*4096+((i)&3)*1024)); vhi[i]=vtr(vp_+(((i)>>2)*4096+((i)&3)*1024+512)); }while(0)
  #define KRD(G,j) do{ if(G){ kload2(kf,kp0+sl_next,j); SBAR(); } }while(0)
  #define STEP(C0,C1,P0,P1,t,GK,GV,GL) do{ SBAR(); \
    const lds_cptr vp_=vp0+sl_prev; \
    VRD(0); SBAR(); float sacc=(P0[0]+P0[1]); \
    GAPA(C0=__builtin_amdgcn_mfma_f32_32x32x16_bf16(kf[0],qr[0],negm,0,0,0), P0[2],P0[3],P0[4],P0[5],     pw0[0]=PKW(P0,0), pw0[1]=PKW(P0,2), pw0); \
    VRD(4); SBAR(); GAPA(C1=__builtin_amdgcn_mfma_f32_32x32x16_bf16(kf[1],qr[0],negm,0,0,0), P0[6],P0[7],P0[8],P0[9],     pw0[2]=PKW(P0,4), pw0[3]=PKW(P0,6), pw0); \
    VRD(1); SBAR(); GAPA(C0=__builtin_amdgcn_mfma_f32_32x32x16_bf16(kf[2],qr[1],C0,0,0,0),   P0[10],P0[11],P0[12],P0[13], pw1[0]=PKW(P0,8), pw1[1]=PKW(P0,10), pw1); \
    VRD(5); SBAR(); GAPA(C1=__builtin_amdgcn_mfma_f32_32x32x16_bf16(kf[3],qr[1],C1,0,0,0),   P0[14],P0[15],P1[0],P1[1],   pw1[2]=PKW(P0,12),pw1[3]=PKW(P0,14), pw1); \
    VRD(2); SBAR(); GAPA(C0=__builtin_amdgcn_mfma_f32_32x32x16_bf16(kf[4],qr[2],C0,0,0,0),   P1[2],P1[3],P1[4],P1[5],     pw2[0]=PKW(P1,0), pw2[1]=PKW(P1,2), pw2); \
    VRD(6); SBAR(); GAPA(C1=__builtin_amdgcn_mfma_f32_32x32x16_bf16(kf[5],qr[2],C1,0,0,0),   P1[6],P1[7],P1[8],P1[9],     pw2[2]=PKW(P1,4), pw2[3]=PKW(P1,6), pw2); \
    VRD(3); SBAR(); GAPA(C0=__builtin_amdgcn_mfma_f32_32x32x16_bf16(kf[6],qr[3],C0,0,0,0),   P1[10],P1[11],P1[12],P1[13], pw3[0]=PKW(P1,8), pw3[1]=PKW(P1,10), pw3); \
    VRD(7); SBAR(); GAPA(C1=__builtin_amdgcn_mfma_f32_32x32x16_bf16(kf[7],qr[3],C1,0,0,0),   P1[14],P1[15],0.f,0.f,       pw3[2]=PKW(P1,12),pw3[3]=PKW(P1,14), pw3); \
    l_reg+=sacc; \
    if(GK){DMA_K((t)+3,sl_cur);} if(GV){DMA_V((t)+1,sl_next);} \
    CMASK(C0,C1,t); \
    { float a=MX3(C0[0],C0[1],C1[0]),b=MX3(C0[2],C0[3],C1[1]); a=MX3(a,C1[2],C1[3]); \
      _Pragma("unroll") for(int r=4;r<16;r+=4){a=MX3(a,C0[r],C0[r+1]);b=MX3(b,C0[r+2],C0[r+3]);a=MX3(a,C1[r],C1[r+1]);b=MX3(b,C1[r+2],C1[r+3]);} \
      float rm=__builtin_fmaxf(a,b); { auto rr=__builtin_amdgcn_permlane32_swap(__float_as_uint(rm),__float_as_uint(rm),false,false); rm=__builtin_fmaxf(__uint_as_float(rr[0]),__uint_as_float(rr[1])); } \
      resc=false; \
      if(__builtin_expect(__any(rm>(float)THRL),0)){ const float dl=__builtin_fmaxf(rm,0.f); mhat+=dl; \
        _Pragma("unroll") for(int r=0;r<16;++r){C0[r]-=dl;C1[r]-=dl;} \
        _Pragma("unroll") for(int r=0;r<16;++r)negm[r]=-mhat; asm volatile("":"+v"(negm)); \
        const float f=__builtin_amdgcn_exp2f(-dl); l_reg*=f; if(hi==0)wsf[r32]=f; resc=true; } } \
    SBAR(); \
    GAPB(o[0]=__builtin_amdgcn_mfma_f32_32x32x16_bf16(PAF(0),VFR(0),o[0],0,0,0), C0,0); \
    GAPB(o[1]=__builtin_amdgcn_mfma_f32_32x32x16_bf16(PAF(0),VFR(4),o[1],0,0,0), C0,4); \
    KRD(GL,0); GAPB(o[0]=__builtin_amdgcn_mfma_f32_32x32x16_bf16(PAF(1),VFR(1),o[0],0,0,0), C0,8); \
    KRD(GL,1); GAPB(o[1]=__builtin_amdgcn_mfma_f32_32x32x16_bf16(PAF(1),VFR(5),o[1],0,0,0), C0,12); \
    KRD(GL,2); GAPB(o[0]=__builtin_amdgcn_mfma_f32_32x32x16_bf16(PAF(2),VFR(2),o[0],0,0,0), C1,0); \
    KRD(GL,3); GAPB(o[1]=__builtin_amdgcn_mfma_f32_32x32x16_bf16(PAF(2),VFR(6),o[1],0,0,0), C1,4); \
    GAPB(o[0]=__builtin_amdgcn_mfma_f32_32x32x16_bf16(PAF(3),VFR(3),o[0],0,0,0), C1,8); \
    GAPB(o[1]=__builtin_amdgcn_mfma_f32_32x32x16_bf16(PAF(3),VFR(7),o[1],0,0,0), C1,12); \
    }while(0)
  int t=1;
  #undef CMASK
  #define CMASK(P0,P1,t) do{}while(0)
  for(;t+5<NT;t+=2){
    STEP(pB0,pB1,pA0,pA1,t,true,true,true);     WAIT_BAR(2); RESC(); ROT();
    STEP(pA0,pA1,pB0,pB1,t+1,true,true,true);   WAIT_BAR(2); RESC(); ROT();
  }
  #undef CMASK
  #define CMASK(P0,P1,t) do{}while(0)
  #define ENDW(tt) do{ if((tt)+3<NT){WAIT_BAR(2);} else if((tt)+2<NT){WAIT_BAR(1);} else {WAIT_BAR(0);} }while(0)
  for(;t+1<NT;t+=2){
    STEP(pB0,pB1,pA0,pA1,t,(t+3<NT),(t+1<NT),(t+1<NT));       ENDW(t);   RESC(); ROT();
    STEP(pA0,pA1,pB0,pB1,t+1,(t+4<NT),(t+2<NT),(t+2<NT));     ENDW(t+1); RESC(); ROT();
  }
  STEP(pB0,pB1,pA0,pA1,NT-1,false,false,false); RESC();
  { float sacc=pB0[0]+pB0[1]; _Pragma("unroll") for(int r=2;r<16;++r)sacc+=pB0[r]; _Pragma("unroll") for(int r=0;r<16;++r)sacc+=pB1[r]; l_reg+=sacc;
    pw0=(u32x4){PKW(pB0,0),PKW(pB0,2),PKW(pB0,4),PKW(pB0,6)};pw1=(u32x4){PKW(pB0,8),PKW(pB0,10),PKW(pB0,12),PKW(pB0,14)};pw2=(u32x4){PKW(pB1,0),PKW(pB1,2),PKW(pB1,4),PKW(pB1,6)};pw3=(u32x4){PKW(pB1,8),PKW(pB1,10),PKW(pB1,12),PKW(pB1,14)};
    SBAR(); pv(o,vb0+sl_cur,PAF(0),PAF(1),PAF(2),PAF(3)); }
  #undef PKW
  #undef PAF
  #undef VFR
  #undef PIN
  #undef MX3
  #undef GAPA
  #undef GAPB
  #undef EX
  #undef VRD
  #undef KRD
  #undef STEP
  #undef ENDW
  {auto rr=__builtin_amdgcn_permlane32_swap(__float_as_uint(l_reg),__float_as_uint(l_reg),false,false);l_reg=__uint_as_float(rr[0])+__uint_as_float(rr[1]);}
  if(hi==0)wsf[32+r32]=l_reg;asm volatile("s_waitcnt lgkmcnt(0)":::"memory");
  float rli[16];
  #pragma unroll
  for(int r=0;r<16;++r)rli[r]=__builtin_amdgcn_rcpf(wsf[32+crow(r,hi)]);
  bf16*Ow=Ou+(long)(wid*QBLK)*OP;
  { bf16*stg=(bf16*)(shm+LDS_OST)+wid*2048;
    #pragma unroll
    for(int r=0;r<16;++r){const int orow=crow(r,hi);
      #pragma unroll
      for(int d0=0;d0<2;++d0)stg[orow*64+d0*32+r32]=__float2bfloat16(o[d0][r]*rli[r]);}
    asm volatile("s_waitcnt lgkmcnt(0)":::"memory");
    #pragma unroll
    for(int i=0;i<4;++i){const int row=i*8+(lane>>3),ch=lane&7; const u32x4 v=*(const u32x4*)(stg+row*64+ch*8); ATTN_STORE16(Ow+(long)row*OP+ch*8,v);} }
  asm volatile("s_waitcnt lgkmcnt(0)\n\ts_barrier":::"memory");
  #undef DMA_K
  #undef DMA_V
  #undef CMASK
  #undef START
  #undef RESC
  #undef ROT
}
constexpr int ATTN_LDS_BYTES=LDS_BYTES;
#undef SBAR
#undef WAIT_BAR
}
#define GAS __attribute__((address_space(1)))
#define LAS __attribute__((address_space(3)))
typedef GAS unsigned gu32;
typedef GAS unsigned long long gu64;
#define RLX_AGENT __ATOMIC_RELAXED, __HIP_MEMORY_SCOPE_AGENT
#define LDS_WAIT() asm volatile("s_waitcnt lgkmcnt(0)" ::: "memory")
#define VM_WAIT() asm volatile("s_waitcnt vmcnt(0)" ::: "memory")
__device__ __forceinline__ unsigned long long rt() { return __builtin_amdgcn_s_memrealtime(); }
#define XB_TMO      128
#define XB_XCNT(j)  (256  + 64 * (j))
#define XB_XSUB(j)  (1280 + 64 * (j))
#define XB_XGEN(j)  (2304 + 64 * (j))
#define XB_TOP      3328
#define XB_TOPGEN   3392
#define XCD_BAR_WORDS 3456
#define XB_SPIN_CAP (1u << 18)

__device__ __forceinline__ unsigned xb_ld(unsigned* p)              { return __hip_atomic_load(p, __ATOMIC_RELAXED, __HIP_MEMORY_SCOPE_AGENT); }
__device__ __forceinline__ unsigned xb_add(unsigned* p, unsigned v) { return __hip_atomic_fetch_add(p, v, __ATOMIC_RELAXED, __HIP_MEMORY_SCOPE_AGENT); }
__device__ __forceinline__ unsigned xb_xcc_id() { return (unsigned)__builtin_amdgcn_s_getreg((3 << 11) | 20) & 0xFu; }
#define XB_SPIN(cond, bar) do { unsigned _sp = 0; while (cond) { __builtin_amdgcn_s_sleep(1); \
    if ((++_sp & 255u) == 0u) { if (xb_ld(&(bar)[XB_TMO])) break; if (_sp > XB_SPIN_CAP) { atomicAdd(&(bar)[XB_TMO], 1u); break; } } } } while (0)

struct XcdBarrier {
    unsigned* bar; unsigned x;
    volatile LAS unsigned* st;
};

__device__ __forceinline__ XcdBarrier xcd_barrier_post(unsigned* bar, volatile LAS unsigned* st) {
    XcdBarrier b; b.bar = bar; b.x = xb_xcc_id(); b.st = st;
    if (threadIdx.x == 0) (void)xb_add(&bar[XB_XCNT(b.x)], 1u);
    return b;
}
__device__ __forceinline__ void xcd_barrier_complete(unsigned* bar, unsigned x, unsigned& nloc, unsigned& nx) {
    const unsigned G = gridDim.x * gridDim.y * gridDim.z;
    unsigned sum, cnt, mine, sp = 0u;
    for (;;) {
        sum = 0u; cnt = 0u; mine = 0u;
#pragma unroll
        for (unsigned j = 0; j < 16; ++j) { const unsigned c = xb_ld(&bar[XB_XCNT(j)]); sum += c; cnt += (c > 0u) ? 1u : 0u; mine = (j == x) ? c : mine; }
        if (sum == G) break;
        __builtin_amdgcn_s_sleep(1);
        if ((++sp & 255u) == 0u) { if (xb_ld(&bar[XB_TMO])) break; if (sp > XB_SPIN_CAP) { atomicAdd(&bar[XB_TMO], 1u); break; } }
    }
    nloc = mine > 0u ? mine : 1u; nx = cnt > 0u ? cnt : 1u;
}

__device__ __forceinline__ void xcd_barrier(const XcdBarrier& b) {
    asm volatile("s_waitcnt vmcnt(0)" ::: "memory");
    __syncthreads();
    if (threadIdx.x == 0) {
        unsigned* bar = b.bar;
        __builtin_amdgcn_s_waitcnt(0);
        unsigned nloc = b.st[0], nx = b.st[1];
        if (nloc == 0u) { xcd_barrier_complete(bar, b.x, nloc, nx); b.st[0] = nloc; b.st[1] = nx; }
        const unsigned old = xb_add(&bar[XB_XSUB(b.x)], 1u);
        const unsigned gen = old / nloc;
        if (old + 1u == (gen + 1u) * nloc) {
            __builtin_amdgcn_fence(__ATOMIC_RELEASE, "agent");
            asm volatile("s_waitcnt vmcnt(0)" ::: "memory");
            const unsigned og = xb_add(&bar[XB_TOP], 1u);
            const unsigned tg = og / nx;
            if (og + 1u == (tg + 1u) * nx) xb_add(&bar[XB_TOPGEN], 1u);
            else XB_SPIN(xb_ld(&bar[XB_TOPGEN]) == tg, bar);
            __builtin_amdgcn_fence(__ATOMIC_ACQUIRE, "agent");
            xb_add(&bar[XB_XGEN(b.x)], 1u);
            asm volatile("s_waitcnt vmcnt(0)" ::: "memory");
        } else {
            XB_SPIN(xb_ld(&bar[XB_XGEN(b.x)]) == gen, bar);
            __builtin_amdgcn_fence(__ATOMIC_ACQUIRE, "agent");
            asm volatile("s_waitcnt vmcnt(0)" ::: "memory");
        }
    }
    __syncthreads();
}


constexpr int NB = 16, SEQ = 2048, CTXL = 256, DM = 1024, DEPTH = 4, DFF = 2816, DIN = 2320, NPROJ = 2304, NPROJP = 2560;
constexpr int ML = NB * SEQ, MC = NB * CTXL, MT = ML + MC;
constexpr int NCHUNK = 36;
constexpr float EPS = 1e-6f;
constexpr float QSCALE = 0.125f * 1.4426950408889634f;
constexpr int PC_Q = 0, PC_K = 512, PC_V = 640, PC_QM = 768, PC_KM = 1024, PC_VM = 1280, PC_OM = 1536, PC_UC = 1792, PC_VC = 2048;
constexpr size_t MiB = 1u << 20;
constexpr size_t WS_CTL = 0, CTL_ZERO_BYTES = 65536, WS_ROPE = 32768, WS_SHW1 = 65536, WS_ROWSS = 2816 * 1024, WS_SHW2 = 3328 * 1024;
constexpr size_t WS_MOD = 1 * MiB, WS_WIN = 6 * MiB, WS_WOUT = 26 * MiB, WS_WUP = 34 * MiB, WS_WDOWN = 78 * MiB;
constexpr size_t WS_XC = 100 * MiB, WS_H = 116 * MiB, WS_PROJ = 188 * MiB, WS_GATES = 350 * MiB, WS_MIX = 353 * MiB;
constexpr size_t WS_MSC = 425 * MiB, WS_MSN = 497 * MiB, WS_MSS = 499 * MiB, WS_END = 500 * MiB;
constexpr size_t WS_ACT = 188 * MiB, WS_EDGE = 386 * MiB;
static_assert(WS_ACT + (size_t)MT * DFF * 2 <= WS_EDGE && WS_EDGE + (size_t)(MT / 64) * 2 * 4 * DFF * 4 <= WS_MSN, "ffn overlay");
static_assert(WS_SHW1 + (size_t)4 * 17 * 2560 * 4 <= WS_MOD && WS_MOD + (size_t)4 * 17 * 6144 * 4 <= WS_ROWSS && WS_ROWSS + (size_t)2 * 36864 * 4 <= WS_SHW2 && WS_SHW2 + (size_t)4 * 17 * 5632 * 4 <= WS_WIN, "ws map lo");
static_assert(WS_PROJ + (size_t)MT * NPROJ * 2 <= WS_GATES && WS_MIX + (size_t)MT * DM * 2 <= WS_MSC && WS_MSC + (size_t)128 * NCHUNK * 4096 * 4 <= WS_MSN, "ws map");

constexpr int NWAVES = 8, NTHREADS = 512;
constexpr int RING_BYTES = 131072, LDS_BYTES = 147456;

typedef unsigned short bf16;
typedef float f32x4 __attribute__((ext_vector_type(4)));
typedef float f32x2 __attribute__((ext_vector_type(2)));
typedef short bf16x8 __attribute__((ext_vector_type(8)));
typedef unsigned u32x4 __attribute__((ext_vector_type(4)));
typedef unsigned u32x2 __attribute__((ext_vector_type(2)));

__device__ __forceinline__ unsigned f2bf(float f) { unsigned u = __builtin_bit_cast(unsigned, f); return (u + 0x7fffu + ((u >> 16) & 1u)) >> 16; }
__device__ __forceinline__ unsigned pk2(float lo, float hi) { return f2bf(lo) | (f2bf(hi) << 16); }
__device__ __forceinline__ float bf2f(unsigned u16) { return __uint_as_float(u16 << 16); }
__device__ __forceinline__ float bflo(unsigned w) { return __uint_as_float(w << 16); }
__device__ __forceinline__ float bfhi(unsigned w) { return __uint_as_float(w & 0xffff0000u); }
__device__ __forceinline__ float silu_f(float x) { return x / (1.f + __expf(-x)); }
__device__ __forceinline__ float sigmoid_f(float x) { return 1.f / (1.f + __expf(-x)); }
__device__ __forceinline__ float gelu_tanh(float x) { const float u = 0.7978845608028654f * (x + 0.044715f * x * x * x); const float e = __expf(2.f * u); const float t = 1.f - 2.f / (e + 1.f); return 0.5f * x * (1.f + t); }
__device__ __forceinline__ float logsig(float x) { return fminf(x, 0.f) - log1pf(__expf(-fabsf(x))); }
__device__ __forceinline__ float bperm(float v, int src) { return __builtin_bit_cast(float, __builtin_amdgcn_ds_bpermute(src << 2, __builtin_bit_cast(int, v))); }
__device__ __forceinline__ float wave_sum(float v, int lane) {
#pragma unroll
    for (int o = 1; o < 64; o <<= 1) v += bperm(v, lane ^ o);
    return v;
}
__device__ __forceinline__ float wave_max(float v, int lane) {
#pragma unroll
    for (int o = 1; o < 64; o <<= 1) v = fmaxf(v, bperm(v, lane ^ o));
    return v;
}
__device__ __forceinline__ float scan_add_fwd(float v, int lane) {
#pragma unroll
    for (int o = 1; o < 64; o <<= 1) { const float t = bperm(v, lane >= o ? lane - o : lane); if (lane >= o) v += t; }
    return v;
}
__device__ __forceinline__ float scan_add_bwd(float v, int lane) {
#pragma unroll
    for (int o = 1; o < 64; o <<= 1) { const float t = bperm(v, lane + o < 64 ? lane + o : lane); if (lane + o < 64) v += t; }
    return v;
}
__device__ __forceinline__ float scan_max_fwd(float v, int lane) {
#pragma unroll
    for (int o = 1; o < 64; o <<= 1) { const float t = bperm(v, lane >= o ? lane - o : lane); if (lane >= o) v = fmaxf(v, t); }
    return v;
}
__device__ __forceinline__ float scan_max_bwd(float v, int lane) {
#pragma unroll
    for (int o = 1; o < 64; o <<= 1) { const float t = bperm(v, lane + o < 64 ? lane + o : lane); if (lane + o < 64) v = fmaxf(v, t); }
    return v;
}
__device__ __forceinline__ f32x4 mma16(const bf16* A, int lda, const bf16* Bt, int ldb, int K, int mt, int nt, int lane, f32x4 acc) {
    const bf16* ap = A + (16 * mt + (lane & 15)) * lda + (lane >> 4) * 8;
    const bf16* bp = Bt + (16 * nt + (lane & 15)) * ldb + (lane >> 4) * 8;
    for (int k0 = 0; k0 < K; k0 += 32) {
        const bf16x8 a = *(const bf16x8*)(ap + k0), b = *(const bf16x8*)(bp + k0);
        acc = __builtin_amdgcn_mfma_f32_16x16x32_bf16(a, b, acc, 0, 0, 0);
    }
    return acc;
}

__device__ __forceinline__ int launder(int v) { asm volatile("" : "+v"(v)); return v; }
__device__ __forceinline__ int fresh_lane() { int l; asm volatile("v_mbcnt_lo_u32_b32 %0, -1, 0\n\tv_mbcnt_hi_u32_b32 %0, -1, %0" : "=v"(l)); return l; }
__device__ __forceinline__ int launder_s(int v) { asm volatile("" : "+s"(v)); return v; }
struct Args { const float* in[21]; float* out; unsigned char* ws; };
enum { I_X = 0, I_C, I_CTX, I_CCTX, I_WADA, I_BADA, I_GN1, I_WIN, I_BIN, I_GQ, I_GK, I_GMH, I_GV, I_WSP, I_BSP, I_WOUT, I_GN2, I_WUP, I_CONVW, I_CONVB, I_WDOWN };

__device__ __forceinline__ int win_src_col(int n) {
    if (n >= NPROJ) return n < NPROJ + 16 ? 1792 + (n - NPROJ) : -1;
    const int pn = n >> 8, c = n & 255, bj = c >> 7, wc = (c >> 5) & 3, j = c & 31;
    if (pn < 2 || (pn == 2 && wc < 2)) { const int hb = pn < 2 ? (4 * pn + wc) * 64 : 512 + wc * 64; return hb + 32 * bj + 16 * ((j >> 2) & 1) + 4 * (j >> 3) + (j & 3); }
    if (pn == 2) return 640 + 64 * (wc - 2) + 32 * bj + j;
    return n + (n >= 1792 ? 16 : 0);
}
__device__ __forceinline__ void p0_transpose_item(const float* W, int ldw, int K, bf16* WT, int k0, int src_col_lane, int dst_row0, float* scr, int lane) {
#pragma unroll 8
    for (int i = 0; i < 32; ++i) { const int kk = 2 * i + (lane >> 5); scr[kk * 33 + (lane & 31)] = W[(size_t)(k0 + kk) * ldw + src_col_lane]; }
    asm volatile("s_waitcnt lgkmcnt(0)" ::: "memory");
    const int c = lane & 7;
#pragma unroll
    for (int j = 0; j < 4; ++j) { const int n = (lane >> 3) + 8 * j; const float* s = scr + (8 * c) * 33 + n;
        u32x4 o; o.x = pk2(s[0 * 33], s[1 * 33]); o.y = pk2(s[2 * 33], s[3 * 33]); o.z = pk2(s[4 * 33], s[5 * 33]); o.w = pk2(s[6 * 33], s[7 * 33]);
        *(u32x4*)(WT + (size_t)(dst_row0 + n) * K + k0 + 8 * c) = o; }
    asm volatile("s_waitcnt lgkmcnt(0)" ::: "memory");
}

__device__ __forceinline__ void convert_layer_weights(const float* w_in, const float* w_out, const float* w_up, const float* w_down, unsigned char* ws, int l, float* scr, int lane, int gw, int NGW) {
    constexpr int I_IN = 16 * 73, I_OUT = 16 * 32, I_UP = 16 * 176, I_DN = 44 * 32, I_L = I_IN + I_OUT + I_UP + I_DN;
    for (int it = gw; it < I_L; it += NGW) {
        int r = it;
        if (r < I_IN) { const int kb = r / 73, nb = r % 73, n0 = 32 * nb;
            p0_transpose_item(w_in + (size_t)l * DM * DIN, DIN, DM, (bf16*)(ws + WS_WIN) + (size_t)l * NPROJP * DM, 64 * kb, max(win_src_col(n0 + (lane & 31)), 0), n0, scr, lane); continue; } r -= I_IN;
        if (r < I_OUT) { const int kb = r / 32, nb = r % 32;
            p0_transpose_item(w_out + (size_t)l * DM * DM, DM, DM, (bf16*)(ws + WS_WOUT) + (size_t)l * DM * DM, 64 * kb, 32 * nb + (lane & 31), 32 * nb, scr, lane); continue; } r -= I_OUT;
        if (r < I_UP) { const int kb = r / 176, nb = r % 176;
            const int n0 = 32 * nb, src = ((n0 >> 7) & 1) * DFF + (n0 >> 8) * 128 + (n0 & 127);
            p0_transpose_item(w_up + (size_t)l * DM * 2 * DFF, 2 * DFF, DM, (bf16*)(ws + WS_WUP) + (size_t)l * 2 * DFF * DM, 64 * kb, src + (lane & 31), n0, scr, lane); continue; } r -= I_UP;
        { const int kb = r / 32, nb = r % 32;
            p0_transpose_item(w_down + (size_t)l * DFF * DM, DM, DFF, (bf16*)(ws + WS_WDOWN) + (size_t)l * DM * DFF, 64 * kb, 32 * nb + (lane & 31), 32 * nb, scr, lane); }
    }
}

__device__ __forceinline__ void p0_prologue(const Args& a, unsigned char* lds, int tid, int lane, int wave, int G) {
    unsigned char* ws = a.ws;
    {
        convert_layer_weights(a.in[I_WIN], a.in[I_WOUT], a.in[I_WUP], a.in[I_WDOWN], ws, 0, (float*)(lds + wave * 16384), lane, blockIdx.x * NWAVES + wave, G * NWAVES);
        for (int i = blockIdx.x * NTHREADS + tid; i < 1024; i += G * NTHREADS) { const int pos = i >> 4, f = i & 15; const float inv = powf(10000.f, -(float)f / 16.f); float sn_, cs_; sincosf((float)pos * inv, &sn_, &cs_);
            ((float*)(ws + WS_ROPE))[i] = cs_; ((float*)(ws + WS_ROPE))[1024 + i] = sn_; }
        for (int i = blockIdx.x * NTHREADS + tid; i < DEPTH * 224 * (DM / 8); i += G * NTHREADS) { const int l = i / (224 * 128), r2 = (i / 128) % 224, c8 = (i % 128) * 8;
            *(u32x4*)((bf16*)(ws + WS_WIN) + ((size_t)l * NPROJP + 2336 + r2) * DM + c8) = (u32x4){0u, 0u, 0u, 0u}; }
    }
    __syncthreads();
    {
        float* sc = (float*)lds;
        float* red = (float*)(lds + 73728);
        for (int i = tid; i < 17 * DM; i += NTHREADS) { const int bi = i >> 10, k = i & 1023; const float v = bi < 16 ? a.in[I_C][bi * DM + k] : a.in[I_CCTX][k]; sc[i] = silu_f(v); }
        __syncthreads();
        float* mod = (float*)(ws + WS_MOD);
        const int cl = tid & 31, kp = tid >> 5;
        for (int grp = blockIdx.x; grp < DEPTH * 192; grp += G) {
            const int l = grp / 192, col = (grp % 192) * 32 + cl;
            const float* w = a.in[I_WADA] + (size_t)l * DM * 6144 + col;
            float acc[17];
#pragma unroll
            for (int b = 0; b < 17; ++b) acc[b] = 0.f;
#pragma unroll 4
            for (int k = kp * 64; k < kp * 64 + 64; ++k) { const float wv = w[(size_t)k * 6144];
#pragma unroll
                for (int b = 0; b < 17; ++b) acc[b] += sc[b * DM + k] * wv; }
#pragma unroll
            for (int b = 0; b < 17; ++b) red[(kp * 17 + b) * 32 + cl] = acc[b];
            __syncthreads();
            for (int i = tid; i < 17 * 32; i += NTHREADS) { const int b = i >> 5, c2 = i & 31; float s = 0.f;
#pragma unroll
                for (int p = 0; p < 16; ++p) s += red[(p * 17 + b) * 32 + c2];
                const int cc = (grp % 192) * 32 + c2; mod[((size_t)l * 17 + b) * 6144 + cc] = s + a.in[I_BADA][l * 6144 + cc]; }
            __syncthreads();
        }
    }
}

template <bool GATES>
__device__ __forceinline__ void norm_phase(const float* xl, const float* xc, const float* gnorm, const float* modl, int sh_off, int s_off, bf16* H, int nrows,
                                           const float* w_in_l, const float* b_in_l, float* gates, unsigned char* lds, int tid, int lane, int wave, int G) {
    float* wg = (float*)lds;
    if (GATES) {
        for (int idx = tid; idx < 16384; idx += NTHREADS) { const int k = idx >> 4, g = idx & 15; const int slot = ((k & 255) >> 2) + 64 * (4 * (k >> 8) + (k & 3));
            wg[slot * 20 + g] = w_in_l[(size_t)k * DIN + 1792 + g]; }
        __syncthreads();
    }
    const int gw = blockIdx.x * NWAVES + wave, NGW = G * NWAVES;
    f32x4 gn[4];
#pragma unroll
    for (int j = 0; j < 4; ++j) gn[j] = *(const f32x4*)(gnorm + 4 * lane + 256 * j);
    for (int r = gw; r < nrows; r += NGW) {
        const bool isctx = r >= ML; const int bi = isctx ? 16 : (r >> 11);
        const float* xr = isctx ? xc + (size_t)(r - ML) * DM : xl + (size_t)r * DM;
        f32x4 v[4]; float ss = 0.f;
#pragma unroll
        for (int j = 0; j < 4; ++j) { v[j] = *(const f32x4*)(xr + 4 * lane + 256 * j); ss += (v[j].x * v[j].x + v[j].y * v[j].y) + (v[j].z * v[j].z + v[j].w * v[j].w); }
        const float rstd = rsqrtf(wave_sum(ss, lane) * (1.f / DM) + EPS);
        const float* mv = modl + bi * 6144;
        bf16* hr = H + (size_t)r * DM;
#pragma unroll
        for (int j = 0; j < 4; ++j) {
            const f32x4 sv = *(const f32x4*)(mv + s_off + 4 * lane + 256 * j), sh = *(const f32x4*)(mv + sh_off + 4 * lane + 256 * j);
            v[j] = v[j] * rstd * gn[j] * (1.f + sv) + sh;
            u32x2 o; o.x = pk2(v[j].x, v[j].y); o.y = pk2(v[j].z, v[j].w);
            *(u32x2*)(hr + 4 * lane + 256 * j) = o;
        }
        if (GATES) {
            f32x4 ga[4];
#pragma unroll
            for (int q = 0; q < 4; ++q) ga[q] = (f32x4){0.f, 0.f, 0.f, 0.f};
#pragma unroll
            for (int j = 0; j < 4; ++j)
#pragma unroll
                for (int e = 0; e < 4; ++e) { const float hv = v[j][e]; const float* wp = wg + (lane + 64 * (4 * j + e)) * 20;
#pragma unroll
                    for (int q = 0; q < 4; ++q) ga[q] += hv * *(const f32x4*)(wp + 4 * q);
                    if (e & 1) asm volatile("" ::: "memory"); }
#pragma unroll
            for (int q = 0; q < 4; ++q)
#pragma unroll
                for (int e = 0; e < 4; ++e) ga[q][e] = wave_sum(ga[q][e], lane);
            if (lane == 0) {
#pragma unroll
                for (int q = 0; q < 4; ++q) *(f32x4*)(gates + (size_t)r * 16 + 4 * q) = ga[q] + *(const f32x4*)(b_in_l + 1792 + 4 * q);
            }
        }
    }
}

__device__ __forceinline__ void shw_phase(const float* w_in_all, const float* w_up_all, const float* b_in_all, unsigned char* ws, int l_only, int bidx, int nb, unsigned char* lds, int tid) {
    float* sc = (float*)lds;
    float* red = (float*)(lds + 73728);
    const float* mod = (const float*)(ws + WS_MOD);
    const int cl = tid & 31, kp = tid >> 5;
    for (int gi = bidx; gi < 256; gi += nb) {
        const int l = l_only, r = gi, which = r >= 80 ? 1 : 0, n0 = (which ? r - 80 : r) * 32;
        for (int i = tid; i < 17 * DM; i += NTHREADS) sc[i] = mod[((size_t)l * 17 + (i >> 10)) * 6144 + (which ? 3072 : 0) + (i & 1023)];
        __syncthreads();
        const float* W; int ldw, src; bool live = true;
        if (which == 0) { W = w_in_all + (size_t)l * DM * DIN; ldw = DIN; src = win_src_col(n0 + cl); live = src >= 0; }
        else { W = w_up_all + (size_t)l * DM * 2 * DFF; ldw = 2 * DFF; src = ((n0 >> 7) & 1) * DFF + (n0 >> 8) * 128 + (n0 & 127) + cl; }
        float acc[17];
#pragma unroll
        for (int b = 0; b < 17; ++b) acc[b] = 0.f;
        if (live) {
            const float* w = W + src;
#pragma unroll 4
            for (int k = kp * 64; k < kp * 64 + 64; ++k) { const float wv = w[(size_t)k * ldw];
#pragma unroll
                for (int b = 0; b < 17; ++b) acc[b] += sc[b * DM + k] * wv; }
        }
#pragma unroll
        for (int b = 0; b < 17; ++b) red[(kp * 17 + b) * 32 + cl] = acc[b];
        __syncthreads();
        for (int i = tid; i < 17 * 32; i += NTHREADS) { const int b = i >> 5, c2 = i & 31; float sum = 0.f;
#pragma unroll
            for (int p = 0; p < 16; ++p) sum += red[(p * 17 + b) * 32 + c2];
            const int n = n0 + c2;
            if (which == 0) { const int sc_ = win_src_col(n); const float bias = sc_ >= 0 ? b_in_all[l * DIN + sc_] : 0.f;
                ((float*)(ws + WS_SHW1))[((size_t)l * 17 + b) * NPROJP + n] = sum + bias; }
            else ((float*)(ws + WS_SHW2))[((size_t)l * 17 + b) * 2 * DFF + n] = sum; }
        __syncthreads();
    }
}

__device__ __forceinline__ void norm0_phase(const float* xl, const float* xc, const float* gnorm, const float* modl, int s_off, bf16* H, float* rowss, int tid, int lane, int wave, int G) {
    const int gw = blockIdx.x * NWAVES + wave, NGW = G * NWAVES;
    f32x4 gn[4];
#pragma unroll
    for (int j = 0; j < 4; ++j) gn[j] = *(const f32x4*)(gnorm + 4 * lane + 256 * j);
    for (int r = gw; r < MT; r += NGW) {
        const bool isctx = r >= ML; const int bi = isctx ? 16 : (r >> 11);
        const float* xr = isctx ? xc + (size_t)(r - ML) * DM : xl + (size_t)r * DM;
        f32x4 v[4]; float ss = 0.f;
#pragma unroll
        for (int j = 0; j < 4; ++j) { v[j] = *(const f32x4*)(xr + 4 * lane + 256 * j); ss += (v[j].x * v[j].x + v[j].y * v[j].y) + (v[j].z * v[j].z + v[j].w * v[j].w); }
        ss = wave_sum(ss, lane);
        const float* mv = modl + bi * 6144;
        bf16* hr = H + (size_t)r * DM;
#pragma unroll
        for (int j = 0; j < 4; ++j) {
            const f32x4 sv = *(const f32x4*)(mv + s_off + 4 * lane + 256 * j);
            v[j] = v[j] * gn[j] * (1.f + sv);
            u32x2 o; o.x = pk2(v[j].x, v[j].y); o.y = pk2(v[j].z, v[j].w);
            *(u32x2*)(hr + 4 * lane + 256 * j) = o;
        }
        if (lane == 0) rowss[r] = ss;
    }
}

__device__ __forceinline__ void ctxfin_phase(const float* xbase, float* xc, const float* slab, const float* g2c, const float* gn1n, const float* s1cn, bf16* Hctx, float* rowss_ctx, int lane, int wave, int G) {
    const int gw = blockIdx.x * NWAVES + wave, NGW = G * NWAVES;
    for (int r = gw; r < MC; r += NGW) {
        float* xr = xc + (size_t)r * DM; const float* xb = xbase + (size_t)r * DM; f32x4 v[4]; float ss = 0.f;
#pragma unroll
        for (int j = 0; j < 4; ++j) { const int c = 4 * lane + 256 * j; const float* sp = slab + (size_t)r * DM + c;
            const f32x4 sum = (*(const f32x4*)sp + *(const f32x4*)(sp + (size_t)MC * DM)) + (*(const f32x4*)(sp + (size_t)2 * MC * DM) + *(const f32x4*)(sp + (size_t)3 * MC * DM));
            v[j] = *(const f32x4*)(xb + c) + *(const f32x4*)(g2c + c) * sum; *(f32x4*)(xr + c) = v[j];
            ss += (v[j].x * v[j].x + v[j].y * v[j].y) + (v[j].z * v[j].z + v[j].w * v[j].w); }
        ss = wave_sum(ss, lane);
#pragma unroll
        for (int j = 0; j < 4; ++j) { const int c = 4 * lane + 256 * j; const f32x4 a = v[j] * *(const f32x4*)(gn1n + c) * (1.f + *(const f32x4*)(s1cn + c));
            u32x2 o; o.x = pk2(a.x, a.y); o.y = pk2(a.z, a.w); *(u32x2*)(Hctx + (size_t)r * DM + c) = o; }
        if (lane == 0) rowss_ctx[r] = ss;
    }
}

__device__ __forceinline__ int chunk_row(int b, int cf, int t) { return cf < 4 ? ML + b * CTXL + cf * 64 + t : b * SEQ + (cf - 4) * 64 + t; }

__device__ __forceinline__ void postproj_phase(bf16* proj, const float* gq, const float* gk, unsigned char* lds, int tid, int G, bf16* dryb = nullptr) {
    float* cs = (float*)lds; float* sn = cs + 1024;
    for (int i = tid; i < 1024; i += NTHREADS) { const int pos = i >> 4, f = i & 15; const float inv = powf(10000.f, -(float)f / 16.f); float s, c; sincosf((float)pos * inv, &s, &c); cs[i] = c; sn[i] = s; }
    __syncthreads();
    const int nth = G * NTHREADS, lane = tid & 63;
    for (int idx = blockIdx.x * NTHREADS + tid; idx < MT * 40; idx += nth) {
        const int j = idx & 3, hh = (idx >> 2) % 10, row = (idx >> 2) / 10;
        const int axis = j >> 1, fh = j & 1;
        const bool isq = hh < 8;
        bf16* p = proj + (size_t)row * NPROJ + (isq ? PC_Q + hh * 64 : PC_K + (hh - 8) * 64) + axis * 32 + fh * 8;
        const u32x4 r1 = *(const u32x4*)p, r2 = *(const u32x4*)(p + 16);
        float x1[8], x2[8];
#pragma unroll
        for (int e = 0; e < 4; ++e) { x1[2 * e] = bflo(r1[e]); x1[2 * e + 1] = bfhi(r1[e]); x2[2 * e] = bflo(r2[e]); x2[2 * e + 1] = bfhi(r2[e]); }
        float ss = 0.f;
#pragma unroll
        for (int e = 0; e < 8; ++e) ss += x1[e] * x1[e] + x2[e] * x2[e];
        ss += bperm(ss, lane ^ 1); ss += bperm(ss, lane ^ 2);
        const float rstd = rsqrtf(ss * (1.f / 64.f) + EPS);
        const float* g = isq ? gq : gk;
        const bool lat = row < ML;
        const int pos = row & (SEQ - 1); const int pa = axis == 0 ? (pos >> 6) : (pos & 63);
        const float sc = isq ? QSCALE : 1.f;
        float o1[8], o2[8];
#pragma unroll
        for (int e = 0; e < 8; ++e) {
            const float y1 = x1[e] * rstd * g[axis * 32 + fh * 8 + e], y2 = x2[e] * rstd * g[axis * 32 + 16 + fh * 8 + e];
            float c = 1.f, s = 0.f; if (lat) { c = cs[pa * 16 + fh * 8 + e]; s = sn[pa * 16 + fh * 8 + e]; }
            o1[e] = (y1 * c - y2 * s) * sc; o2[e] = (y2 * c + y1 * s) * sc;
        }
        u32x4 w1, w2;
#pragma unroll
        for (int e = 0; e < 4; ++e) { w1[e] = pk2(o1[2 * e], o1[2 * e + 1]); w2[e] = pk2(o2[2 * e], o2[2 * e + 1]); }
        bf16* pd = dryb ? dryb + (((size_t)idx * 32) & ((32u << 20) - 1)) : p;
        *(u32x4*)pd = w1; *(u32x4*)(pd + 16) = w2;
    }
    __syncthreads();
}

__device__ __forceinline__ void mlstm_local_phase(const bf16* proj, const float* gates, float* msc, float* msn, float* mss, unsigned char* lds, int tid, int lane, int wave, int G) {
    bf16* VT = (bf16*)lds;
    bf16* KF = VT + 64 * 72;
    bf16* KB_ = KF + 64 * 72;
    float* wv = (float*)(lds + 3 * 64 * 72 * 2);
    u32x4 pkr, pvr; float pig = 0.f, pfg = 0.f;
#define M1_ISSUE(T) do { const int cf_ = (T) % NCHUNK, h_ = ((T) / NCHUNK) & 3, b_ = (T) / (NCHUNK * 4); \
        const bf16* rp_ = proj + (size_t)chunk_row(b_, cf_, tid >> 3) * NPROJ + h_ * 64 + (tid & 7) * 8; pkr = *(const u32x4*)(rp_ + PC_KM); pvr = *(const u32x4*)(rp_ + PC_VM); \
        if (wave < 2) { const int row_ = chunk_row(b_, cf_, lane); pig = gates[(size_t)row_ * 16 + wave * 8 + h_]; pfg = gates[(size_t)row_ * 16 + wave * 8 + 4 + h_]; } } while (0)
    if ((int)blockIdx.x < NB * 4 * NCHUNK) M1_ISSUE((int)blockIdx.x);
    for (int task = blockIdx.x; task < NB * 4 * NCHUNK; task += G) {
        const int cf = task % NCHUNK, h = (task / NCHUNK) & 3, b = task / (NCHUNK * 4);
        const int sid0 = (b * 4 + h) * 2;
        if (wave < 2) {
            const float ig = pig, fg = pfg;
            const float ls = logsig(fg);
            float g, tot;
            if (wave == 0) { const float inc = scan_add_fwd(ls, lane); tot = bperm(inc, 63); g = tot - inc + ig; }
            else { const float inc = scan_add_bwd(ls, lane); tot = bperm(inc, 0); g = tot - inc + ig; }
            const float ml = wave_max(g, lane);
            wv[wave * 64 + lane] = __expf(g - ml) * 0.125f;
            if (lane == 0) { const int c = wave == 0 ? cf : (cf < 4 ? 3 - cf : 39 - cf); const int si = (sid0 + wave) * NCHUNK + c; mss[si] = ml; mss[128 * NCHUNK + si] = tot; }
        }
        const int s = tid >> 3, d8 = (tid & 7) * 8;
        const u32x4 kr = pkr, vr = pvr;
        __syncthreads();
        if (task + G < NB * 4 * NCHUNK) M1_ISSUE(task + G);
        const float wf = wv[s], wb = wv[64 + s];
#pragma unroll
        for (int e = 0; e < 4; ++e) {
            const float k0 = bflo(kr[e]), k1 = bfhi(kr[e]);
            VT[(d8 + 2 * e) * 72 + s] = (bf16)(vr[e] & 0xffffu); VT[(d8 + 2 * e + 1) * 72 + s] = (bf16)(vr[e] >> 16);
            KF[(d8 + 2 * e) * 72 + s] = (bf16)f2bf(k0 * wf); KF[(d8 + 2 * e + 1) * 72 + s] = (bf16)f2bf(k1 * wf);
            KB_[(d8 + 2 * e) * 72 + s] = (bf16)f2bf(k0 * wb); KB_[(d8 + 2 * e + 1) * 72 + s] = (bf16)f2bf(k1 * wb);
        }
        __syncthreads();
        const int cb = cf < 4 ? 3 - cf : 39 - cf;
        if (tid < 128) { const int dk = tid & 63, dir = tid >> 6; const bf16* kp = (dir ? KB_ : KF) + dk * 72; float sum = 0.f;
#pragma unroll 8
            for (int ss = 0; ss < 64; ++ss) sum += bf2f(kp[ss]);
            msn[((size_t)(sid0 + dir) * NCHUNK + (dir ? cb : cf)) * 64 + dk] = sum; }
        const int mt = wave >> 1, nt0 = 2 * (wave & 1);
#pragma unroll
        for (int dir = 0; dir < 2; ++dir) {
            bf16* dst = (bf16*)msc + ((size_t)(sid0 + dir) * NCHUNK + (dir ? cb : cf)) * 4096;
#pragma unroll
            for (int j = 0; j < 2; ++j) {
                const f32x4 acc = mma16(dir ? KB_ : KF, 72, VT, 72, 64, mt, nt0 + j, lane, (f32x4){0.f, 0.f, 0.f, 0.f});
                u32x2 o; o.x = pk2(acc[0], acc[1]); o.y = pk2(acc[2], acc[3]);
                *(u32x2*)(dst + (16 * (nt0 + j) + (lane & 15)) * 64 + 16 * mt + 4 * (lane >> 4)) = o;
            }
        }
        __syncthreads();
    }
}

__device__ __forceinline__ void mlstm_scan_phase(float* msc, float* msn, float* mss, bf16* dstc, float* dstn, float* dstm, int tid, int G) {
    const float* mloc = mss; const float* Gd = mss + 128 * NCHUNK; float* mprev = dstm;
    for (int w = blockIdx.x * NTHREADS + tid; w < 128 * 1024; w += G * NTHREADS) {
        const int sid = w >> 10, e4 = w & 1023;
        const u32x2* cp = (const u32x2*)((const bf16*)msc + (size_t)sid * NCHUNK * 4096) + e4;
        f32x4* np = (f32x4*)(msn + (size_t)sid * NCHUNK * 64) + (e4 & 15);
        u32x2* cpd = (u32x2*)(dstc + (size_t)sid * NCHUNK * 4096) + e4; f32x4* npd = (f32x4*)(dstn + (size_t)sid * NCHUNK * 64) + (e4 & 15);
        const bool don = e4 < 16;
        float m = 0.f; f32x4 C = (f32x4){0.f, 0.f, 0.f, 0.f}, N = C;
#pragma unroll 12
        for (int c = 0; c < NCHUNK; ++c) {
            const u32x2 sw_ = cp[(size_t)c * 1024]; const f32x4 S = (f32x4){bflo(sw_.x), bfhi(sw_.x), bflo(sw_.y), bfhi(sw_.y)};
            f32x4 nl = (f32x4){0.f, 0.f, 0.f, 0.f}; if (don) nl = np[c * 16];
            const float gd = Gd[sid * NCHUNK + c], ml = mloc[sid * NCHUNK + c];
            { u32x2 cw_; cw_.x = pk2(C.x, C.y); cw_.y = pk2(C.z, C.w); cpd[(size_t)c * 1024] = cw_; }
            if (don) npd[c * 16] = N;
            if (e4 == 0) mprev[sid * NCHUNK + c] = m;
            const float mn = fmaxf(gd + m, ml); const float aa = __expf(gd + m - mn), bb = __expf(ml - mn);
            C = aa * C + bb * S; N = aa * N + bb * nl; m = mn;
        }
    }
}

__device__ __forceinline__ void mlstm_out_phase(const bf16* proj, const float* gates, const bf16* cpb, const float* msn, const float* mss, const float* gmh, bf16* mix, bool need_ctx,
                                                unsigned char* lds, int tid, int lane, int wave, int G) {
    bf16* QS = (bf16*)lds;
    bf16* KS = QS + 64 * 72;
    bf16* AX = (bf16*)(lds + 18432);
    bf16* BX = (bf16*)(lds + 44032);
    float* vec = (float*)(lds + 69632);
    float* HS = (float*)lds;
    float* bm = vec, *us = vec + 128, *wi = vec + 256, *emt = vec + 384, *qn = vec + 512, *dsum = vec + 640, *rr = vec + 768, *al = vec + 896, *nv = vec + 1024;
    const float* mprev = mss + 2 * 128 * NCHUNK;
    const int c0 = need_ctx ? 0 : 4, nper = NCHUNK - c0;
    u32x4 pq, pk, pv, po, pcf, pcb; float pig = 0.f, pfg = 0.f, pmp = 0.f, pn0 = 0.f, pn1 = 0.f;
#define M3_ISSUE(T) do { const int cf_ = c0 + (T) % nper, h_ = ((T) / nper) & 3, b_ = (T) / (nper * 4); const int cb2_ = cf_ < 4 ? 3 - cf_ : 39 - cf_; const int s_ = tid >> 3, d8_ = (tid & 7) * 8; \
        const bf16* rp_ = proj + (size_t)chunk_row(b_, cf_, s_) * NPROJ + h_ * 64 + d8_; pq = *(const u32x4*)(rp_ + PC_QM); pk = *(const u32x4*)(rp_ + PC_KM); pv = *(const u32x4*)(rp_ + PC_VM); po = *(const u32x4*)(rp_ + PC_OM); \
        { const size_t stf_ = (size_t)((b_ * 4 + h_) * 2) * NCHUNK + cf_, stb_ = (size_t)((b_ * 4 + h_) * 2 + 1) * NCHUNK + cb2_; \
          if (wave < 2) { const int row_ = chunk_row(b_, cf_, lane); pig = gates[(size_t)row_ * 16 + wave * 8 + h_]; pfg = gates[(size_t)row_ * 16 + wave * 8 + 4 + h_]; pmp = mprev[wave == 0 ? stf_ : stb_]; } \
          else if (wave == 3) { pn0 = msn[stf_ * 64 + lane]; pn1 = msn[stb_ * 64 + lane]; } } \
        pcf = *(const u32x4*)(cpb + ((size_t)((b_ * 4 + h_) * 2) * NCHUNK + cf_) * 4096 + s_ * 64 + d8_); pcb = *(const u32x4*)(cpb + ((size_t)((b_ * 4 + h_) * 2 + 1) * NCHUNK + cb2_) * 4096 + s_ * 64 + d8_); } while (0)
    if ((int)blockIdx.x < NB * 4 * nper) M3_ISSUE((int)blockIdx.x);
    for (int task = blockIdx.x; task < NB * 4 * nper; task += G) {
        const int cf = c0 + task % nper, h = (task / nper) & 3, b = task / (nper * 4);
        const int cb = cf < 4 ? 3 - cf : 39 - cf;
        const int sid0 = (b * 4 + h) * 2;
        const size_t stf = (size_t)sid0 * NCHUNK + cf, stb = (size_t)(sid0 + 1) * NCHUNK + cb;
        if (wave < 2) {
            const float ig = pig, fg = pfg;
            const float ls = logsig(fg);
            float inc, rmax; const float mp = pmp;
            if (wave == 0) { inc = scan_add_fwd(ls, lane); rmax = scan_max_fwd(ig - inc, lane); }
            else { inc = scan_add_bwd(ls, lane); rmax = scan_max_bwd(ig - inc, lane); }
            const float minter = inc + mp, mt_ = fmaxf(minter, inc + rmax);
            bm[wave * 64 + lane] = inc - mt_; us[wave * 64 + lane] = ig - inc; wi[wave * 64 + lane] = __expf(minter - mt_); emt[wave * 64 + lane] = __expf(-mt_);
        } else if (wave == 2) { dsum[lane] = 0.f; dsum[64 + lane] = 0.f; }
        else if (wave == 3) { nv[lane] = pn0; nv[64 + lane] = pn1; }
        const u32x4 ov = po;
        {
            const int s = tid >> 3, d8 = (tid & 7) * 8;
            const u32x4 qr = pq, kr = pk, vr = pv;
            *(u32x4*)(QS + s * 72 + d8) = qr; *(u32x4*)(KS + s * 72 + d8) = kr;
#pragma unroll
            for (int e = 0; e < 4; ++e) { BX[(d8 + 2 * e) * 200 + s] = (bf16)(vr[e] & 0xffffu); BX[(d8 + 2 * e + 1) * 200 + s] = (bf16)(vr[e] >> 16); }
            *(u32x4*)(BX + s * 200 + 64 + d8) = pcf; *(u32x4*)(BX + s * 200 + 128 + d8) = pcb;
        }
        __syncthreads();
        if (task + G < NB * 4 * nper) M3_ISSUE(task + G);
        if (tid < 128) { const int t = tid & 63, dir = tid >> 6; const bf16* qp = QS + t * 72; const float* np = nv + dir * 64; float sum = 0.f;
#pragma unroll 8
            for (int d = 0; d < 64; ++d) sum += bf2f(qp[d]) * np[d];
            qn[dir * 64 + t] = sum; }
        const int mt = wave >> 1, nt0 = 2 * (wave & 1);
        float Af[2][4], Ab[2][4];
#pragma unroll
        for (int j = 0; j < 2; ++j) {
            const f32x4 acc = mma16(QS, 72, KS, 72, 64, mt, nt0 + j, lane, (f32x4){0.f, 0.f, 0.f, 0.f});
            const int s = 16 * (nt0 + j) + (lane & 15);
            const float usf = us[s], usb = us[64 + s];
#pragma unroll
            for (int i = 0; i < 4; ++i) { const int t = 16 * mt + 4 * (lane >> 4) + i; const float sv = acc[i] * 0.125f;
                Af[j][i] = (s <= t) ? sv * __expf(bm[t] + usf) : 0.f;
                Ab[j][i] = (s >= t) ? sv * __expf(bm[64 + t] + usb) : 0.f; }
        }
#pragma unroll
        for (int i = 0; i < 4; ++i) {
            float pf = Af[0][i] + Af[1][i], pb = Ab[0][i] + Ab[1][i];
#pragma unroll
            for (int o = 1; o < 16; o <<= 1) { pf += bperm(pf, lane ^ o); pb += bperm(pb, lane ^ o); }
            if ((lane & 15) == 0) { const int t = 16 * mt + 4 * (lane >> 4) + i; atomicAdd(&dsum[t], pf); atomicAdd(&dsum[64 + t], pb); }
        }
        __syncthreads();
        if (tid < 128) { const float den = wi[tid] * qn[tid] + dsum[tid]; const float r = 1.f / fmaxf(fabsf(den), emt[tid]); rr[tid] = r; al[tid] = wi[tid] * r; }
        __syncthreads();
#pragma unroll
        for (int j = 0; j < 2; ++j) { const int s = 16 * (nt0 + j) + (lane & 15);
#pragma unroll
            for (int i = 0; i < 4; ++i) { const int t = 16 * mt + 4 * (lane >> 4) + i; AX[t * 200 + s] = (bf16)f2bf(Af[j][i] * rr[t] + Ab[j][i] * rr[64 + t]); } }
        {
            const int t = tid >> 3, d8 = (tid & 7) * 8; const u32x4 qv = *(const u32x4*)(QS + t * 72 + d8); const float af = al[t], ab = al[64 + t];
            u32x4 of, ob;
#pragma unroll
            for (int e = 0; e < 4; ++e) { const float lo = bflo(qv[e]), hi = bfhi(qv[e]); of[e] = pk2(lo * af, hi * af); ob[e] = pk2(lo * ab, hi * ab); }
            *(u32x4*)(AX + t * 200 + 64 + d8) = of; *(u32x4*)(AX + t * 200 + 128 + d8) = ob;
        }
        __syncthreads();
#pragma unroll
        for (int j = 0; j < 2; ++j) {
            const f32x4 acc = mma16(AX, 200, BX, 200, 192, mt, nt0 + j, lane, (f32x4){0.f, 0.f, 0.f, 0.f});
#pragma unroll
            for (int i = 0; i < 4; ++i) HS[(16 * mt + 4 * (lane >> 4) + i) * 68 + 16 * (nt0 + j) + (lane & 15)] = acc[i];
        }
        __syncthreads();
        {
            const int t = tid >> 3, c8 = (tid & 7) * 8; const int row = chunk_row(b, cf, t);
            const f32x4 v0 = *(const f32x4*)(HS + t * 68 + c8), v1 = *(const f32x4*)(HS + t * 68 + c8 + 4);
            float ss = (v0.x * v0.x + v0.y * v0.y) + (v0.z * v0.z + v0.w * v0.w) + (v1.x * v1.x + v1.y * v1.y) + (v1.z * v1.z + v1.w * v1.w);
            ss += bperm(ss, lane ^ 1); ss += bperm(ss, lane ^ 2); ss += bperm(ss, lane ^ 4);
            const float rstd = rsqrtf(ss * (1.f / 64.f) + EPS);
            const f32x4 g0 = *(const f32x4*)(gmh + h * 64 + c8), g1 = *(const f32x4*)(gmh + h * 64 + c8 + 4);
            u32x4 w;
            w.x = pk2(sigmoid_f(bflo(ov.x)) * v0.x * rstd * g0.x, sigmoid_f(bfhi(ov.x)) * v0.y * rstd * g0.y);
            w.y = pk2(sigmoid_f(bflo(ov.y)) * v0.z * rstd * g0.z, sigmoid_f(bfhi(ov.y)) * v0.w * rstd * g0.w);
            w.z = pk2(sigmoid_f(bflo(ov.z)) * v1.x * rstd * g1.x, sigmoid_f(bfhi(ov.z)) * v1.y * rstd * g1.y);
            w.w = pk2(sigmoid_f(bflo(ov.w)) * v1.z * rstd * g1.z, sigmoid_f(bfhi(ov.w)) * v1.w * rstd * g1.w);
            *(u32x4*)(mix + (size_t)row * DM + 512 + h * 64 + c8) = w;
        }
        __syncthreads();
    }
}

__device__ __forceinline__ void cmlp_phase(const bf16* proj, const float* wsp, const float* bsp, const float* gv, bf16* mix, bool need_ctx, unsigned char* lds, int tid, int lane, int wave, int G) {
    bf16* WS_ = (bf16*)lds;
    bf16* VT = WS_ + 128 * 136;
    float* ZS = (float*)(lds + 52224);
    const int nsc = NB * 16 + (need_ctx ? NB * 2 : 0);
    const int g = blockIdx.x & 3;
    {
        const float* wp = wsp + (size_t)g * 128 * 128;
#pragma unroll 4
        for (int i = 0; i < 8; ++i) { const int idx4 = tid + NTHREADS * i; const int p = idx4 >> 5, q4 = (idx4 & 31) * 4; const f32x4 wv = *(const f32x4*)(wp + p * 128 + q4);
            u32x2 o; o.x = pk2(wv.x, wv.y); o.y = pk2(wv.z, wv.w); *(u32x2*)(WS_ + p * 136 + q4) = o; }
    }
    u32x4 pr0, pr1, pu0, pu1;
#define CM_ISSUE(SC) do { const int row0_ = (SC) < NB * 16 ? (SC) * 128 : ML + ((SC) - NB * 16) * 128; const bf16* bp_ = proj + (size_t)(row0_ + (tid >> 2)) * NPROJ + g * 64 + (tid & 3) * 16; \
        pr0 = *(const u32x4*)(bp_ + PC_VC); pr1 = *(const u32x4*)(bp_ + PC_VC + 8); pu0 = *(const u32x4*)(bp_ + PC_UC); pu1 = *(const u32x4*)(bp_ + PC_UC + 8); } while (0)
    if ((int)(blockIdx.x >> 2) < nsc) CM_ISSUE((int)(blockIdx.x >> 2));
    for (int sc = blockIdx.x >> 2; sc < nsc; sc += G >> 2) {
        const int row0 = sc < NB * 16 ? sc * 128 : ML + (sc - NB * 16) * 128;
        const u32x4 u0 = pu0, u1 = pu1;
        {
            const int q = tid >> 2, part = tid & 3;
            const u32x4 r0 = pr0, r1 = pr1;
            float x[16];
#pragma unroll
            for (int e = 0; e < 4; ++e) { x[2 * e] = gelu_tanh(bflo(r0[e])); x[2 * e + 1] = gelu_tanh(bfhi(r0[e])); x[8 + 2 * e] = gelu_tanh(bflo(r1[e])); x[8 + 2 * e + 1] = gelu_tanh(bfhi(r1[e])); }
            float ss = 0.f;
#pragma unroll
            for (int e = 0; e < 16; ++e) ss += x[e] * x[e];
            ss += bperm(ss, lane ^ 1); ss += bperm(ss, lane ^ 2);
            const float rstd = rsqrtf(ss * (1.f / 64.f) + EPS);
#pragma unroll
            for (int e = 0; e < 16; ++e) VT[(part * 16 + e) * 136 + q] = (bf16)f2bf(x[e] * rstd * gv[g * 64 + part * 16 + e]);
        }
        __syncthreads();
        if (sc + (G >> 2) < nsc) CM_ISSUE(sc + (G >> 2));
#pragma unroll
        for (int nt = 0; nt < 4; ++nt) {
            const f32x4 acc = mma16(WS_, 136, VT, 136, 128, wave, nt, lane, (f32x4){0.f, 0.f, 0.f, 0.f});
            const int d = 16 * nt + (lane & 15);
#pragma unroll
            for (int i = 0; i < 4; ++i) { const int p = 16 * wave + 4 * (lane >> 4) + i; ZS[p * 68 + d] = acc[i] + bsp[g * 128 + p]; }
        }
        __syncthreads();
        {
            const int p = tid >> 2, part = tid & 3;
            const float* zp = ZS + p * 68 + part * 16;
            const f32x4 z0 = *(const f32x4*)zp, z1 = *(const f32x4*)(zp + 4), z2 = *(const f32x4*)(zp + 8), z3 = *(const f32x4*)(zp + 12);
            u32x4 o0, o1;
            o0.x = pk2(gelu_tanh(bflo(u0.x)) * z0.x, gelu_tanh(bfhi(u0.x)) * z0.y); o0.y = pk2(gelu_tanh(bflo(u0.y)) * z0.z, gelu_tanh(bfhi(u0.y)) * z0.w);
            o0.z = pk2(gelu_tanh(bflo(u0.z)) * z1.x, gelu_tanh(bfhi(u0.z)) * z1.y); o0.w = pk2(gelu_tanh(bflo(u0.w)) * z1.z, gelu_tanh(bfhi(u0.w)) * z1.w);
            o1.x = pk2(gelu_tanh(bflo(u1.x)) * z2.x, gelu_tanh(bfhi(u1.x)) * z2.y); o1.y = pk2(gelu_tanh(bflo(u1.y)) * z2.z, gelu_tanh(bfhi(u1.y)) * z2.w);
            o1.z = pk2(gelu_tanh(bflo(u1.z)) * z3.x, gelu_tanh(bfhi(u1.z)) * z3.y); o1.w = pk2(gelu_tanh(bflo(u1.w)) * z3.z, gelu_tanh(bfhi(u1.w)) * z3.w);
            bf16* op = mix + (size_t)(row0 + p) * DM + 768 + g * 64 + part * 16;
            *(u32x4*)op = o0; *(u32x4*)(op + 8) = o1;
        }
    }
    __syncthreads();
}

__device__ __forceinline__ void convfix_items(const float* edge, bf16* act, const float* cw, const float* cb, int i_begin, int i_end, int i_stride) {
    for (int idx = i_begin; idx < i_end; idx += i_stride) {
        const int ei = idx / 704, f = (idx % 704) * 4, side = ei & 1, row = (ei >> 1) * 64 + (side ? 63 : 0);
        const int pos = row < ML ? (row & (SEQ - 1)) : ((row - ML) & (CTXL - 1)), slen = row < ML ? SEQ : CTXL;
        const float* ep = edge + (size_t)ei * 4 * DFF + f;
        f32x4 g = *(const f32x4*)ep, v = *(const f32x4*)(ep + DFF);
        if (side == 0 && pos != 0) { const float* nb = edge + (size_t)(ei - 1) * 4 * DFF + f;
            g += *(const f32x4*)(cw + f) * *(const f32x4*)(nb + 2 * DFF); v += *(const f32x4*)(cw + DFF + f) * *(const f32x4*)(nb + 3 * DFF); }
        if (side == 1 && pos != slen - 1) { const float* nb = edge + (size_t)(ei + 1) * 4 * DFF + f;
            g += *(const f32x4*)(cw + 4 * DFF + f) * *(const f32x4*)(nb + 2 * DFF); v += *(const f32x4*)(cw + 5 * DFF + f) * *(const f32x4*)(nb + 3 * DFF); }
        u32x2 o; o.x = pk2(silu_f(g.x) * v.x, silu_f(g.y) * v.y); o.y = pk2(silu_f(g.z) * v.z, silu_f(g.w) * v.w);
        *(u32x2*)(act + (size_t)row * DFF + f) = o;
    }
}

typedef const Args __attribute__((address_space(4)))* KArgsP;
__device__ __forceinline__ KArgsP kargs() { KArgsP p = (KArgsP)__builtin_amdgcn_kernarg_segment_ptr(); asm volatile("" : "+s"(p)); return p; }
constexpr int MISC_OFF = RING_BYTES + 320;
#define GRID_BAR() do { XcdBarrier xb_; xb_.bar = (unsigned*)(kargs()->ws + WS_CTL) + 4096; xb_.x = xb_xcc_id(); xb_.st = (volatile LAS unsigned*)((PG8_LAS unsigned char*)lds + MISC_OFF) + 8; xcd_barrier(xb_); if (PROBE & 1024) xcd_barrier(xb_); } while (0)
#ifndef PROBE
#define PROBE 0
#endif
#define NDUP(bit) ((PROBE & (bit)) ? 2 : 1)
#define FRESH() const int lane = fresh_lane(), wave = launder_s(wave0), tid = (wave << 6) | lane, G = launder_s(G0); (void)lane; (void)wave; (void)tid; (void)G
#define ENV() KArgsP ap = kargs(); unsigned char* const ws = ap->ws; float* const out = ap->out; \
    float* const mod = (float*)(ws + WS_MOD); float* const xc = (float*)(ws + WS_XC); bf16* const Hb = (bf16*)(ws + WS_H); bf16* const proj = (bf16*)(ws + WS_PROJ); \
    float* const gates = (float*)(ws + WS_GATES); float* const rowss1 = (float*)(ws + WS_ROWSS); float* const rowss2 = rowss1 + MT; bf16* const mix = (bf16*)(ws + WS_MIX); \
    float* const msc = (float*)(ws + WS_MSC); float* const msn = (float*)(ws + WS_MSN); float* const mss = (float*)(ws + WS_MSS); bf16* const act = (bf16*)(ws + WS_ACT); float* const edge = (float*)(ws + WS_EDGE); \
    (void)out; (void)mod; (void)xc; (void)Hb; (void)proj; (void)gates; (void)rowss1; (void)rowss2; (void)mix; (void)msc; (void)msn; (void)mss; (void)act; (void)edge
#define IN(k) (ap->in[k])

__device__ __forceinline__ void layer_fwd(const int l, unsigned char* lds, PG8_LAS unsigned char* ldsl, const int wave0, const int G0) {
        const bool last = (l == DEPTH - 1);
        for (int rep_ = 0; rep_ < NDUP(2); ++rep_) {
            ENV();
            pg8::Gemm g{Hb, (const bf16*)(ws + WS_WIN) + (size_t)l * NPROJP * DM, MT, NPROJP, DM}; pg8::StaticOrder S; S.init(MT, NPROJP, launder_s(G0), (int)blockIdx.x);
            pg8::EpiProj E{proj, gates, (const float*)(ws + WS_SHW1) + (size_t)l * 17 * NPROJP, rowss1, IN(I_GQ) + l * 64, IN(I_GK) + l * 64, (const float*)(ws + WS_ROPE), QSCALE};
            { FRESH(); pg8::gemm_phase<pg8::EpiProj, pg8::StaticOrder, true, true>(ldsl, g, S, E, tid); }
        }
        if (l + 1 < DEPTH) {
            ENV(); FRESH();
            const int rem = ((MT / 256) * (NPROJP / 256)) % G, c = (int)blockIdx.x;
            if (rem == 0) convert_layer_weights(IN(I_WIN), IN(I_WOUT), IN(I_WUP), IN(I_WDOWN), ws, l + 1, (float*)(lds + wave * 16384), lane, c * NWAVES + wave, G * NWAVES);
            else if (c >= rem) convert_layer_weights(IN(I_WIN), IN(I_WOUT), IN(I_WUP), IN(I_WDOWN), ws, l + 1, (float*)(lds + wave * 16384), lane, (c - rem) * NWAVES + wave, (G - rem) * NWAVES);
        }
        GRID_BAR();
        { ENV(); FRESH(); for (int i = blockIdx.x * NTHREADS + tid; i < 2 * MT; i += G * NTHREADS) rowss1[i] = 0.f; }
        for (int rep_ = 0; rep_ < NDUP(4); ++rep_) { ENV(); FRESH(); mlstm_local_phase(proj, gates, msc, msn, mss, lds, tid, lane, wave, G); }
        GRID_BAR();
#if PROBE & 2048
        { ENV(); FRESH(); mlstm_scan_phase(msc, msn, mss, Hb, (float*)Hb + 16 * 1024 * 1024, (float*)Hb + 16 * 1024 * 1024, tid, G); }
#endif
        { ENV(); FRESH(); mlstm_scan_phase(msc, msn, mss, Hb, msn, mss + 2 * 128 * NCHUNK, tid, G); }
        for (int rep_ = 0; rep_ < NDUP(8); ++rep_) {
            ENV();
            FRESH();
            const int vcu = (G % 8 == 0) ? ((int)blockIdx.x % 8) * (G / 8) + (int)blockIdx.x / 8 : (int)blockIdx.x;
            const attn_body::bf16* P = (const attn_body::bf16*)proj; attn_body::bf16* O = (attn_body::bf16*)mix;
            for (int u = vcu; u < 1024; u += G) {
                const int b = u >> 6, hq = (u >> 3) & 7, qb = u & 7, kvh = hq >> 2;
                const size_t qrow = (size_t)b * SEQ + qb * 256, crow0 = (size_t)ML + b * CTXL, lrow0 = (size_t)b * SEQ;
                attn_body::attn_unit<8>(P + qrow * NPROJ + PC_Q + hq * 64, P + crow0 * NPROJ + PC_K + kvh * 64, P + crow0 * NPROJ + PC_V + kvh * 64,
                                        P + lrow0 * NPROJ + PC_K + kvh * 64, P + lrow0 * NPROJ + PC_V + kvh * 64, 36, O + qrow * DM + hq * 64, (char*)lds, tid);
            }
            if (!last) {
                for (int v = (G >= 128) ? (int)blockIdx.x - (G - 128) : (int)blockIdx.x; v < 128; v += G) {
                    if (v < 0) continue;
                    const int b = v >> 3, hq = v & 7, kvh = hq >> 2; const size_t crow0 = (size_t)ML + b * CTXL;
                    attn_body::attn_unit<8>(P + crow0 * NPROJ + PC_Q + hq * 64, P + crow0 * NPROJ + PC_K + kvh * 64, P + crow0 * NPROJ + PC_V + kvh * 64,
                                            P + crow0 * NPROJ + PC_K + kvh * 64, P + crow0 * NPROJ + PC_V + kvh * 64, 4, O + crow0 * DM + hq * 64, (char*)lds, tid);
                }
            }
            asm volatile("s_waitcnt vmcnt(0) lgkmcnt(0)" ::: "memory"); __syncthreads();
        }
        for (int rep_ = 0; rep_ < NDUP(16); ++rep_) { ENV(); FRESH(); cmlp_phase(proj, IN(I_WSP) + (size_t)l * 4 * 128 * 128, IN(I_BSP) + l * 4 * 128, IN(I_GV) + l * 256, mix, !last, lds, tid, lane, wave, G); }
        GRID_BAR();
        for (int rep_ = 0; rep_ < NDUP(32); ++rep_) { ENV(); FRESH(); mlstm_out_phase(proj, gates, Hb, msn, mss, IN(I_GMH) + l * 256, mix, !last, lds, tid, lane, wave, G); }
        GRID_BAR();
        {
            ENV();
            const float* modl = mod + (size_t)l * 17 * 6144;
            pg8::Gemm g{mix, (const bf16*)(ws + WS_WOUT) + (size_t)l * DM * DM, ML, DM, DM, 0}; pg8::StaticOrder S; S.init(ML, DM, launder_s(G0), (int)blockIdx.x);
            pg8::EpiRes2 E{l == 0 ? IN(I_X) : out, xc, out, xc, modl + 2048, Hb, IN(I_GN2) + l * DM, modl + 4096, rowss2};
            { FRESH(); pg8::gemm_phase<pg8::EpiRes2, pg8::StaticOrder, true, true>(ldsl, g, S, E, tid); }
#if PROBE & 1
            { pg8::EpiRes2 E2{out, xc, (float*)proj, (float*)proj + (size_t)ML * DM, modl + 2048, nullptr, nullptr, nullptr, nullptr}; FRESH(); pg8::gemm_phase<pg8::EpiRes2, pg8::StaticOrder, true, true>(ldsl, g, S, E2, tid); }
#endif
            if (!last) {
                FRESH();
                for (int v = blockIdx.x; v < 256; v += G) {
                    const int part = v >> 6, un = v & 63;
                    pg8::Gemm gc{mix + (size_t)ML * DM + part * 256, (const bf16*)(ws + WS_WOUT) + (size_t)l * DM * DM + part * 256, MC, DM, 256, DM};
                    pg8::SingleUnit Sc{un >> 2, un & 3};
                    pg8::EpiSlab Ec{(float*)proj + (size_t)part * MC * DM};
                    pg8::gemm_phase<pg8::EpiSlab, pg8::SingleUnit, true, true>(ldsl, gc, Sc, Ec, tid);
                }
            }
        }
        GRID_BAR();
        if (!last) {
            { ENV(); FRESH(); const float* modl = mod + (size_t)l * 17 * 6144;
              ctxfin_phase(l == 0 ? IN(I_CTX) : xc, xc, (const float*)proj, modl + 16 * 6144 + 2048, IN(I_GN2) + l * DM, modl + 16 * 6144 + 4096, Hb + (size_t)ML * DM, rowss2 + ML, lane, wave, G); }
            GRID_BAR();
        }
        for (int rep_ = 0; rep_ < NDUP(128); ++rep_) {
            ENV();
            const int Mo = last ? ML : MT;
            pg8::Gemm g{Hb, (const bf16*)(ws + WS_WUP) + (size_t)l * 2 * DFF * DM, Mo, 2 * DFF, DM}; pg8::StaticOrder S; S.init(Mo, 2 * DFF, launder_s(G0), (int)blockIdx.x);
            pg8::EpiConv E{act, edge, IN(I_CONVW) + (size_t)l * 3 * 2 * DFF, IN(I_CONVB) + (size_t)l * 2 * DFF, rowss2, (const float*)(ws + WS_SHW2) + (size_t)l * 17 * 2 * DFF};
            { FRESH(); pg8::gemm_phase<pg8::EpiConv, pg8::StaticOrder, true, true>(ldsl, g, S, E, tid); }
        }
        if (l + 1 < DEPTH) {
            ENV(); FRESH();
            const int rem = ((MT / 256) * (2 * DFF / 256)) % G, c = (int)blockIdx.x;
            __syncthreads();
            if (rem == 0) shw_phase(IN(I_WIN), IN(I_WUP), IN(I_BIN), ws, l + 1, c, G, lds, tid);
            else if (c >= rem) shw_phase(IN(I_WIN), IN(I_WUP), IN(I_BIN), ws, l + 1, c - rem, G - rem, lds, tid);
        }
        GRID_BAR();
        { ENV(); FRESH(); const int nit = ((last ? ML : MT) / 64) * 2 * 704; convfix_items(edge, act, IN(I_CONVW) + (size_t)l * 3 * 2 * DFF, IN(I_CONVB) + (size_t)l * 2 * DFF, blockIdx.x * NTHREADS + tid, nit, G * NTHREADS); }
        GRID_BAR();
        {
            ENV();
            const float* modl = mod + (size_t)l * 17 * 6144;
            pg8::Gemm g{act, (const bf16*)(ws + WS_WDOWN) + (size_t)l * DM * DFF, ML, DM, DFF, 0}; pg8::StaticOrder S; S.init(ML, DM, launder_s(G0), (int)blockIdx.x);
            pg8::EpiRes2 E{out, xc, out, xc, modl + 5120, last ? nullptr : Hb, IN(I_GN1) + (last ? 0 : (l + 1) * DM), modl + 17 * 6144 + 1024, rowss1};
            { FRESH(); pg8::gemm_phase<pg8::EpiRes2, pg8::StaticOrder, true, true>(ldsl, g, S, E, tid); }
#if PROBE & 64
            { pg8::EpiBf16<0> E2{(bf16*)(ws + WS_EDGE), 1024, nullptr, 0, 0, 1.f}; FRESH(); pg8::gemm_phase<pg8::EpiBf16<0>, pg8::StaticOrder, true, true>(ldsl, g, S, E2, tid); }
#endif
            if (!last) {
                FRESH();
                for (int v = blockIdx.x; v < 256; v += G) {
                    const int part = v >> 6, un = v & 63, kt0 = part == 0 ? 0 : (part == 1 ? 12 : (part == 2 ? 22 : 34)), ktn = (part & 1) ? 10 : 12;
                    pg8::Gemm gc{act + (size_t)ML * DFF + kt0 * 64, (const bf16*)(ws + WS_WDOWN) + (size_t)l * DM * DFF + kt0 * 64, MC, DM, ktn * 64, DFF};
                    pg8::SingleUnit Sc{un >> 2, un & 3};
                    pg8::EpiSlab Ec{(float*)(ws + WS_EDGE) + (size_t)part * MC * DM};
                    pg8::gemm_phase<pg8::EpiSlab, pg8::SingleUnit, true, true>(ldsl, gc, Sc, Ec, tid);
                }
            }
        }
        GRID_BAR();
        if (!last) {
            { ENV(); FRESH(); const float* modl = mod + (size_t)l * 17 * 6144;
              ctxfin_phase(xc, xc, (const float*)(ws + WS_EDGE), modl + 16 * 6144 + 5120, IN(I_GN1) + (l + 1) * DM, modl + 17 * 6144 + 16 * 6144 + 1024, Hb + (size_t)ML * DM, rowss1 + ML, lane, wave, G); }
            GRID_BAR();
        }
}

__global__ void __launch_bounds__(NTHREADS, 2) mega_fwd(Args args) {
    extern __shared__ __attribute__((aligned(16))) unsigned char lds[];
    cg::grid_group grid = cg::this_grid();
    int wave0_ = __builtin_amdgcn_readfirstlane((int)threadIdx.x >> 6); asm volatile("" : "+s"(wave0_)); const int wave0 = wave0_; const int G0 = gridDim.x;
    PG8_LAS unsigned char* ldsl = (PG8_LAS unsigned char*)lds;
    for (int u = threadIdx.x; u < 64; u += NTHREADS) ((LAS unsigned*)(ldsl + MISC_OFF))[u] = 0u;
    __syncthreads();
    (void)xcd_barrier_post((unsigned*)(args.ws + WS_CTL) + 4096, (volatile LAS unsigned*)(ldsl + MISC_OFF) + 8);

    { FRESH(); p0_prologue(args, lds, tid, lane, wave, G); }
#if PROBE & 256
    __syncthreads();
    { FRESH(); p0_prologue(args, lds, tid, lane, wave, G); }
#endif
    grid.sync();
    { FRESH(); shw_phase(args.in[I_WIN], args.in[I_WUP], args.in[I_BIN], args.ws, 0, (int)blockIdx.x, G, lds, tid); }
    { ENV(); FRESH(); norm0_phase(IN(I_X), IN(I_CTX), IN(I_GN1), mod, 1024, Hb, rowss1, tid, lane, wave, G); }
    GRID_BAR();

#pragma nounroll
    for (int l = 0; l < DEPTH; ++l) layer_fwd(launder_s(l), lds, ldsl, wave0, G0);
}

extern "C" void kernel_launch(void* const* d_in, const int* in_sizes, int n_in, void* d_out, int out_size, void* d_ws, size_t ws_size, hipStream_t stream) {
    static int grid = 0;
    if (grid == 0) {
        if (n_in != 21 || out_size != ML * DM || ws_size < WS_END) { fprintf(stderr, "kernel_launch: unexpected problem (n_in %d out %d ws %zu)\n", n_in, out_size, ws_size); grid = -1; return; }
        int dev = 0, cus = 0, per_cu = 0;
        if (hipGetDevice(&dev) != hipSuccess || hipDeviceGetAttribute(&cus, hipDeviceAttributeMultiprocessorCount, dev) != hipSuccess) { grid = -1; return; }
        if (hipFuncSetAttribute((const void*)mega_fwd, hipFuncAttributeMaxDynamicSharedMemorySize, LDS_BYTES) != hipSuccess) { fprintf(stderr, "kernel_launch: hipFuncSetAttribute failed\n"); grid = -1; return; }
        if (hipOccupancyMaxActiveBlocksPerMultiprocessor(&per_cu, (const void*)mega_fwd, NTHREADS, LDS_BYTES) != hipSuccess || per_cu < 1) { fprintf(stderr, "kernel_launch: occupancy query says %d\n", per_cu); (void)hipGetLastError(); per_cu = 1; }
        grid = cus;
    }
    if (grid < 0) return;
    (void)hipMemsetAsync((char*)d_ws + WS_CTL, 0, CTL_ZERO_BYTES, stream);
    Args a{};
    for (int i = 0; i < 21; ++i) a.in[i] = (const float*)d_in[i];
    a.out = (float*)d_out; a.ws = (unsigned char*)d_ws;
    void* kargs[] = {&a};
    hipError_t e = hipLaunchCooperativeKernel((const void*)mega_fwd, dim3(grid), dim3(NTHREADS), kargs, LDS_BYTES, stream);
    if (e != hipSuccess) fprintf(stderr, "kernel_launch: cooperative launch failed: %s (grid %d)\n", hipGetErrorString(e), grid);
}
```

```cpp
#include <hip/hip_runtime.h>
#include <hip/hip_cooperative_groups.h>
#include <hip/hip_bf16.h>
#include <cstdio>
#include <cstdint>
#include <cmath>
namespace cg = cooperative_groups;
#define PROBE 0
namespace pg8 {
#define PG8_LAS __attribute__((address_space(3)))
typedef unsigned short bf16_t;
typedef short bf16x8 __attribute__((ext_vector_type(8)));
typedef float f32x4 __attribute__((ext_vector_type(4)));
typedef unsigned u32x4 __attribute__((ext_vector_type(4)));
constexpr int BM = 256, BK = 64, HALF = 128, HTB = HALF * BK * 2  , STAGE_BYTES = 8 * HTB, NXCD = 8, WGM = 8;

__host__ __device__ __forceinline__ int lds_byte(int r, int c) { const int st = (r >> 4) * 2 + (c >> 5), rr = r & 15, cc = c & 31, ob = rr * 64 + cc * 2; return st * 1024 + (ob ^ (((ob >> 9) & 1) << 5)); }
__host__ __device__ __forceinline__ void stage_rc(int b, int& R, int& C) { const int st = b / 1024, sb = b % 1024, swz = sb ^ (((sb >> 9) & 1) << 5); R = (st >> 1) * 16 + swz / 64; C = (st & 1) * 32 + (swz % 64) / 2; }
__host__ __device__ __forceinline__ int perm32(int rho) { const int n = rho >> 4, i = rho & 15; return 8 * (i >> 2) + 4 * n + (i & 3); }

struct Unit { int pm, pn; };
struct Gemm { const bf16_t* A; const bf16_t* Bt; int M, N, K; int ld; };

struct StaticOrder {
    int nM, nN, nwg, G, c;
    __host__ __device__ void init(int M, int N, int G_, int c_) { nM = M / BM; nN = N / BM; nwg = nM * nN; G = G_; c = c_; }
    __host__ __device__ bool next(int i, Unit& u) const {
        const long L = (long)i * G + c; if (L >= nwg) return false;
        int wgid = (int)L; { const int q = nwg / NXCD, r = nwg % NXCD, xcd = wgid % NXCD, off = wgid / NXCD; wgid = (xcd < r ? xcd * (q + 1) : r * (q + 1) + (xcd - r) * q) + off; }
        const int nig = WGM * nN, gid = wgid / nig, fm = gid * WGM, gsz = (nM - fm) < WGM ? (nM - fm) : WGM;
        u.pm = fm + ((wgid % nig) % gsz); u.pn = (wgid % nig) / gsz; return true;
    }
    __device__ __forceinline__ void a_ready(const Unit&) const {}
    __device__ __forceinline__ void done(const Unit&) const {}
};

__device__ __forceinline__ unsigned cvt_pk_bf16(float lo, float hi) { unsigned r; asm volatile("v_cvt_pk_bf16_f32 %0, %1, %2" : "=v"(r) : "v"(lo), "v"(hi)); return r; }
typedef float f32x2 __attribute__((ext_vector_type(2)));
__device__ __forceinline__ f32x2 gelu_pk(f32x2 v) {
    const f32x2 av = __builtin_elementwise_abs(v), d = av * 0.2316418882f + 1.0f;
    f32x2 t; t.x = __builtin_amdgcn_rcpf(d.x); t.y = __builtin_amdgcn_rcpf(d.y);
    f32x2 q = t * 0.5307027145f + (-0.7265760135f); q = q * t + 0.7107068705f; q = q * t + (-0.142248368f); q = q * t + 0.127414796f; q = q * t;
    const f32x2 s = (v * v) * (-0.72134752044f);
    f32x2 e; e.x = __builtin_amdgcn_exp2f(s.x); e.y = __builtin_amdgcn_exp2f(s.y);
    const f32x2 m = v * (q * e), r = v - m;
    f32x2 o; o.x = v.x < 0.f ? m.x : r.x; o.y = v.y < 0.f ? m.y : r.y; return o;
}

template <int ACT  > struct EpiBf16 {
    static constexpr bool PERM = true, AFTER_DRAIN = false; static_assert(ACT == 0 || ACT == 1, "EpiBf16: ACT is 0 (none) or 1 (gelu_pk)");
    bf16_t* O; int ldc; const float* bias; int split_cols; size_t split_stride; float scale0;
    __device__ __forceinline__ void operator()(const f32x4 (&acc)[2][2][4][2], const Unit& u, int wr, int wc, int fr, int fq) const {
        const int row0 = u.pm * BM + wr * 64 + fr; int colt = u.pn * BM; bf16_t* base = O;
        float sc = 1.f; if (split_cols) { const int t = colt / split_cols; base += (size_t)t * split_stride; colt -= t * split_cols; if (t == 0) sc = scale0; }
        const int col0 = colt + wc * 32 + 8 * fq, bcol0 = u.pn * BM + wc * 32 + 8 * fq;
        f32x4 bv[2][2];
#pragma unroll
        for (int bj = 0; bj < 2; ++bj)
#pragma unroll
            for (int n = 0; n < 2; ++n) bv[bj][n] = bias ? *(const f32x4*)(bias + bcol0 + bj * HALF + 4 * n) : (f32x4){0.f, 0.f, 0.f, 0.f};
#pragma unroll
        for (int ai = 0; ai < 2; ++ai)
#pragma unroll
            for (int m = 0; m < 4; ++m) { bf16_t* rowp = base + (size_t)(row0 + ai * HALF + m * 16) * ldc + col0;
#pragma unroll
                for (int bj = 0; bj < 2; ++bj) { f32x4 v0 = acc[ai][bj][m][0] + bv[bj][0], v1 = acc[ai][bj][m][1] + bv[bj][1];
                    if (ACT == 1) { f32x2 a = gelu_pk((f32x2){v0[0], v0[1]}), b = gelu_pk((f32x2){v0[2], v0[3]}), c = gelu_pk((f32x2){v1[0], v1[1]}), d = gelu_pk((f32x2){v1[2], v1[3]});
                        v0 = (f32x4){a.x, a.y, b.x, b.y}; v1 = (f32x4){c.x, c.y, d.x, d.y}; }
                    v0 = v0 * sc; v1 = v1 * sc; u32x4 w; w.x = cvt_pk_bf16(v0[0], v0[1]); w.y = cvt_pk_bf16(v0[2], v0[3]); w.z = cvt_pk_bf16(v1[0], v1[1]); w.w = cvt_pk_bf16(v1[2], v1[3]);
                    *(u32x4*)(rowp + bj * HALF) = w; } }
    }
};

struct EpiRes {
    static constexpr bool PERM = false, AFTER_DRAIN = false;
    const float* base_lat; const float* base_ctx; float* out_lat; float* out_ctx; const float* gvec; int row_off;
    __device__ __forceinline__ void operator()(const f32x4 (&acc)[2][2][4][2], const Unit& u, int wr, int wc, int fr, int fq) const {
        const int grow0 = row_off + u.pm * BM;
        const bool isctx = grow0 >= 32768;
        const int bi = isctx ? 16 : (grow0 >> 11);
        const float* base = isctx ? base_ctx + (size_t)(grow0 - 32768) * 1024 : base_lat + (size_t)grow0 * 1024;
        float* out = isctx ? out_ctx + (size_t)(grow0 - 32768) * 1024 : out_lat + (size_t)grow0 * 1024;
        const int col0 = u.pn * BM + wc * 32 + 4 * fq;
        const float* gv = gvec + bi * 6144 + col0;
        f32x4 g[2][2];
#pragma unroll
        for (int bj = 0; bj < 2; ++bj)
#pragma unroll
            for (int n = 0; n < 2; ++n) g[bj][n] = *(const f32x4*)(gv + bj * HALF + n * 16);
#pragma unroll
        for (int ai = 0; ai < 2; ++ai)
#pragma unroll
            for (int m = 0; m < 4; ++m) { const size_t off = (size_t)(ai * HALF + wr * 64 + m * 16 + fr) * 1024 + col0;
#pragma unroll
                for (int bj = 0; bj < 2; ++bj)
#pragma unroll
                    for (int n = 0; n < 2; ++n) { const f32x4 bs = *(const f32x4*)(base + off + bj * HALF + n * 16);
                        *(f32x4*)(out + off + bj * HALF + n * 16) = bs + g[bj][n] * acc[ai][bj][m][n]; }
                if (m & 1) asm volatile("" ::: "memory"); }
    }
};

template <int CTRL> __device__ __forceinline__ float dppf(float x) { return __builtin_bit_cast(float, __builtin_amdgcn_update_dpp(0, __builtin_bit_cast(int, x), CTRL, 0xf, 0xf, true)); }
template <int CTRL> __device__ __forceinline__ f32x4 dpp4(const f32x4 v) { f32x4 r; r.x = dppf<CTRL>(v.x); r.y = dppf<CTRL>(v.y); r.z = dppf<CTRL>(v.z); r.w = dppf<CTRL>(v.w); return r; }
__device__ __forceinline__ float silu_r(float x) { return x * __builtin_amdgcn_rcpf(1.f + __expf(-x)); }
struct EpiConv {
    static constexpr bool PERM = true, AFTER_DRAIN = false;
    bf16_t* act; float* edge; const float* cw; const float* cb; const float* rowss; const float* shw;
    __device__ __forceinline__ void operator()(const f32x4 (&acc)[2][2][4][2], const Unit& u, int wr, int wc, int fr_in, int fq_in) const {
        int fr = fr_in, fq = fq_in; asm volatile("" : "+v"(fr), "+v"(fq));
        const int f0 = u.pn * 128 + wc * 32 + 8 * fq;
        const int bi = (u.pm * BM >= 32768) ? 16 : ((u.pm * BM) >> 11);
        const float* sp = shw + (size_t)bi * 5632 + u.pn * BM + wc * 32 + 8 * fq;
        const int Rw = u.pm * BM + wr * 64;
        float rs[2][4];
#pragma unroll
        for (int ai = 0; ai < 2; ++ai)
#pragma unroll
            for (int m = 0; m < 4; ++m) rs[ai][m] = __builtin_amdgcn_rsqf(rowss[Rw + ai * HALF + 16 * m + fr] * (1.f / 1024.f) + 1e-6f);
        unsigned pk[2][2][4][2];
#pragma unroll
        for (int n = 0; n < 2; ++n) {
            const int f = f0 + 4 * n;
            const f32x4 w0g = *(const f32x4*)(cw + f), w1g = *(const f32x4*)(cw + 5632 + f), w2g = *(const f32x4*)(cw + 2 * 5632 + f), bg = *(const f32x4*)(cb + f);
            const f32x4 w0v = *(const f32x4*)(cw + 2816 + f), w1v = *(const f32x4*)(cw + 5632 + 2816 + f), w2v = *(const f32x4*)(cw + 2 * 5632 + 2816 + f), bv = *(const f32x4*)(cb + 2816 + f);
            const f32x4 sg = *(const f32x4*)(sp + 4 * n), sv = *(const f32x4*)(sp + HALF + 4 * n);
#pragma unroll
            for (int ai = 0; ai < 2; ++ai) {
                const int R0 = Rw + ai * HALF;
                f32x4 xg[4], xv[4];
#pragma unroll
                for (int m = 0; m < 4; ++m) { xg[m] = acc[ai][0][m][n] * rs[ai][m] + sg; xv[m] = acc[ai][1][m][n] * rs[ai][m] + sv; }
#pragma unroll
                for (int m = 0; m < 4; ++m) {
                    const f32x4 g = xg[m], v = xv[m];
                    f32x4 pg = dpp4<0x111>(g), pv = dpp4<0x111>(v), ng = dpp4<0x101>(g), nv = dpp4<0x101>(v);
                    if (m > 0) { pg += dpp4<0x10F>(xg[m - 1]); pv += dpp4<0x10F>(xv[m - 1]); }
                    if (m < 3) { ng += dpp4<0x11F>(xg[m + 1]); nv += dpp4<0x11F>(xv[m + 1]); }
                    const f32x4 cg = w0g * pg + w1g * g + w2g * ng + bg, cv = w0v * pv + w1v * v + w2v * nv + bv;
                    if ((m == 0 && fr == 0) || (m == 3 && fr == 15)) {
                        float* ep = edge + ((size_t)((R0 >> 6) * 2 + (m == 3 ? 1 : 0)) * 4) * 2816 + f;
                        *(f32x4*)ep = cg; *(f32x4*)(ep + 2816) = cv; *(f32x4*)(ep + 2 * 2816) = g; *(f32x4*)(ep + 3 * 2816) = v;
                    }
                    pk[ai][n][m][0] = cvt_pk_bf16(silu_r(cg.x) * cv.x, silu_r(cg.y) * cv.y); pk[ai][n][m][1] = cvt_pk_bf16(silu_r(cg.z) * cv.z, silu_r(cg.w) * cv.w);
                }
            }
        }
#pragma unroll
        for (int ai = 0; ai < 2; ++ai)
#pragma unroll
            for (int m = 0; m < 4; ++m) { u32x4 w; w.x = pk[ai][0][m][0]; w.y = pk[ai][0][m][1]; w.z = pk[ai][1][m][0]; w.w = pk[ai][1][m][1];
                *(u32x4*)(act + (size_t)(Rw + ai * HALF + 16 * m + fr) * 2816 + f0) = w; }
    }
};

struct EpiProj {
    static constexpr bool PERM = true, AFTER_DRAIN = false;
    bf16_t* O; float* gates; const float* cvec; const float* rowss; const float* gq; const float* gk; const float* rope; float qscale;
    __device__ __forceinline__ void operator()(const f32x4 (&acc)[2][2][4][2], const Unit& u, int wr, int wc, int fr_in, int fq_in) const {
        int fr = fr_in, fq = fq_in; asm volatile("" : "+v"(fr), "+v"(fq));
        const int row0 = u.pm * BM + wr * 64 + fr;
        const int col0 = u.pn * BM + wc * 32 + 8 * fq;
        const bool isctx = u.pm * BM >= 32768;
        const int bi = isctx ? 16 : ((u.pm * BM) >> 11);
        const float* bias = cvec + (size_t)bi * 2560;
        float rs[2][4];
#pragma unroll
        for (int ai = 0; ai < 2; ++ai)
#pragma unroll
            for (int m = 0; m < 4; ++m) rs[ai][m] = __builtin_amdgcn_rsqf(rowss[row0 + ai * HALF + m * 16] * (1.f / 1024.f) + 1e-6f);
        if (u.pn < 9) {
            f32x4 bv[2][2];
#pragma unroll
            for (int bj = 0; bj < 2; ++bj)
#pragma unroll
                for (int n = 0; n < 2; ++n) bv[bj][n] = *(const f32x4*)(bias + col0 + bj * HALF + 4 * n);
            const bool qk = u.pn < 2 || (u.pn == 2 && wc < 2);
            if (qk) {
                const bool isq = u.pn < 2;
                const float* gw_ = isq ? gq : gk;
                const int hoff = isq ? (4 * u.pn + wc) * 64 : 512 + wc * 64;
                const float sc = isq ? qscale : 1.f;
                f32x4 gw[2][2];
#pragma unroll
                for (int bj = 0; bj < 2; ++bj)
#pragma unroll
                    for (int n = 0; n < 2; ++n) gw[bj][n] = *(const f32x4*)(gw_ + 32 * bj + 16 * n + 4 * fq) * sc;
                const int ln_ = fq * 16 + fr;
#pragma unroll
                for (int ai = 0; ai < 2; ++ai)
#pragma unroll
                    for (int m = 0; m < 4; ++m) {
                        const int row = row0 + ai * HALF + m * 16;
                        f32x4 v[2][2]; float ss = 0.f;
#pragma unroll
                        for (int bj = 0; bj < 2; ++bj)
#pragma unroll
                            for (int n = 0; n < 2; ++n) { v[bj][n] = acc[ai][bj][m][n] * rs[ai][m] + bv[bj][n]; ss += (v[bj][n].x * v[bj][n].x + v[bj][n].y * v[bj][n].y) + (v[bj][n].z * v[bj][n].z + v[bj][n].w * v[bj][n].w); }
                        ss += __builtin_bit_cast(float, __builtin_amdgcn_ds_bpermute((ln_ ^ 16) << 2, __builtin_bit_cast(int, ss)));
                        ss += __builtin_bit_cast(float, __builtin_amdgcn_ds_bpermute((ln_ ^ 32) << 2, __builtin_bit_cast(int, ss)));
                        const float rstd = __builtin_amdgcn_rsqf(ss * (1.f / 64.f) + 1e-6f);
                        const int pos = row & 2047;
#pragma unroll
                        for (int bj = 0; bj < 2; ++bj) {
                            f32x4 y1 = v[bj][0] * rstd * gw[bj][0], y2 = v[bj][1] * rstd * gw[bj][1];
                            if (!isctx) { const int pa = bj == 0 ? (pos >> 6) : (pos & 63);
                                const f32x4 c = *(const f32x4*)(rope + pa * 16 + 4 * fq), s = *(const f32x4*)(rope + 1024 + pa * 16 + 4 * fq);
                                const f32x4 o1 = y1 * c - y2 * s, o2 = y2 * c + y1 * s; y1 = o1; y2 = o2; }
                            u32x4 w; w.x = cvt_pk_bf16(y1[0], y1[1]); w.y = cvt_pk_bf16(y1[2], y1[3]); w.z = cvt_pk_bf16(y2[0], y2[1]); w.w = cvt_pk_bf16(y2[2], y2[3]);
                            *(u32x4*)(O + (size_t)row * 2304 + hoff + 32 * bj + 8 * fq) = w;
                        }
                    }
            } else {
                const int ocol = (u.pn == 2) ? 640 + 64 * (wc - 2) + 8 * fq : col0;
                const int ostep = (u.pn == 2) ? 32 : HALF;
#pragma unroll
                for (int ai = 0; ai < 2; ++ai)
#pragma unroll
                    for (int m = 0; m < 4; ++m) { bf16_t* rowp = O + (size_t)(row0 + ai * HALF + m * 16) * 2304 + ocol;
#pragma unroll
                        for (int bj = 0; bj < 2; ++bj) { const f32x4 v0 = acc[ai][bj][m][0] * rs[ai][m] + bv[bj][0], v1 = acc[ai][bj][m][1] * rs[ai][m] + bv[bj][1];
                            u32x4 w; w.x = cvt_pk_bf16(v0[0], v0[1]); w.y = cvt_pk_bf16(v0[2], v0[3]); w.z = cvt_pk_bf16(v1[0], v1[1]); w.w = cvt_pk_bf16(v1[2], v1[3]);
                            *(u32x4*)(rowp + bj * ostep) = w; } }
            }
        } else if (wc == 0 && fq < 2) {
            const f32x4 b0 = *(const f32x4*)(bias + col0), b1 = *(const f32x4*)(bias + col0 + 4);
#pragma unroll
            for (int ai = 0; ai < 2; ++ai)
#pragma unroll
                for (int m = 0; m < 4; ++m) { float* gp = gates + (size_t)(row0 + ai * HALF + m * 16) * 16 + 8 * fq;
                    *(f32x4*)gp = acc[ai][0][m][0] * rs[ai][m] + b0; *(f32x4*)(gp + 4) = acc[ai][0][m][1] * rs[ai][m] + b1; }
        }
    }
};

struct EpiRes2 {
    static constexpr bool PERM = true, AFTER_DRAIN = false;
    const float* base_lat; const float* base_ctx; float* out_lat; float* out_ctx; const float* gvec;
    bf16_t* an; const float* gn; const float* svec; float* rowss;
    __device__ __forceinline__ void operator()(const f32x4 (&acc)[2][2][4][2], const Unit& u, int wr, int wc, int fr_in, int fq_in) const {
        int fr = fr_in, fq = fq_in; asm volatile("" : "+v"(fr), "+v"(fq));
        const int grow0 = u.pm * BM;
        const bool isctx = grow0 >= 32768;
        const int bi = isctx ? 16 : (grow0 >> 11);
        const float* base = isctx ? base_ctx + (size_t)(grow0 - 32768) * 1024 : base_lat + (size_t)grow0 * 1024;
        float* out = isctx ? out_ctx + (size_t)(grow0 - 32768) * 1024 : out_lat + (size_t)grow0 * 1024;
        const int col0 = u.pn * BM + wc * 32 + 8 * fq;
        const float* gv = gvec + bi * 6144 + col0;
        bf16_t* anb = an + (size_t)grow0 * 1024; float* rsb = rowss + grow0;
        f32x4 g[2][2], ns[2][2];
#pragma unroll
        for (int bj = 0; bj < 2; ++bj)
#pragma unroll
            for (int n = 0; n < 2; ++n) { g[bj][n] = *(const f32x4*)(gv + bj * HALF + 4 * n);
                if (an) ns[bj][n] = *(const f32x4*)(gn + col0 + bj * HALF + 4 * n) * (1.f + *(const f32x4*)(svec + bi * 6144 + col0 + bj * HALF + 4 * n)); }
#pragma unroll
        for (int ai = 0; ai < 2; ++ai) {
            f32x4 pre[4][2][2];
#pragma unroll
            for (int m = 0; m < 4; ++m) { const unsigned off = (unsigned)((ai * HALF + wr * 64 + m * 16 + fr) * 1024 + col0);
#pragma unroll
                for (int bj = 0; bj < 2; ++bj) { pre[m][bj][0] = *(const f32x4*)(base + off + bj * HALF); pre[m][bj][1] = *(const f32x4*)(base + off + bj * HALF + 4); } }
#pragma unroll
            for (int m = 0; m < 4; ++m) { const int row = ai * HALF + wr * 64 + m * 16 + fr; const unsigned off = (unsigned)(row * 1024 + col0); float ss = 0.f;
#pragma unroll
                for (int bj = 0; bj < 2; ++bj) {
                    const f32x4 o0 = pre[m][bj][0] + g[bj][0] * acc[ai][bj][m][0], o1 = pre[m][bj][1] + g[bj][1] * acc[ai][bj][m][1];
                    *(f32x4*)(out + off + bj * HALF) = o0; *(f32x4*)(out + off + bj * HALF + 4) = o1;
                    if (an) { ss += (o0.x * o0.x + o0.y * o0.y) + (o0.z * o0.z + o0.w * o0.w) + (o1.x * o1.x + o1.y * o1.y) + (o1.z * o1.z + o1.w * o1.w);
                        const f32x4 a0 = o0 * ns[bj][0], a1 = o1 * ns[bj][1];
                        u32x4 w; w.x = cvt_pk_bf16(a0[0], a0[1]); w.y = cvt_pk_bf16(a0[2], a0[3]); w.z = cvt_pk_bf16(a1[0], a1[1]); w.w = cvt_pk_bf16(a1[2], a1[3]);
                        *(u32x4*)(anb + off + bj * HALF) = w; }
                }
                if (an) { const int ln_ = fq * 16 + fr;
                    ss += __builtin_bit_cast(float, __builtin_amdgcn_ds_bpermute((ln_ ^ 16) << 2, __builtin_bit_cast(int, ss))); ss += __builtin_bit_cast(float, __builtin_amdgcn_ds_bpermute((ln_ ^ 32) << 2, __builtin_bit_cast(int, ss)));
                    if (fq == 0) unsafeAtomicAdd(rsb + row, ss); }
            }
            asm volatile("" ::: "memory");
        }
    }
};


struct SingleUnit {
    int pm, pn;
    __device__ __forceinline__ bool next(int i, Unit& u) const { if (i) return false; u.pm = pm; u.pn = pn; return true; }
    __device__ __forceinline__ void a_ready(const Unit&) const {}
    __device__ __forceinline__ void done(const Unit&) const {}
};
struct EpiSlab {
    static constexpr bool PERM = true, AFTER_DRAIN = false;
    float* O;
    __device__ __forceinline__ void operator()(const f32x4 (&acc)[2][2][4][2], const Unit& u, int wr, int wc, int fr, int fq) const {
        float* base = O + (size_t)(u.pm * BM + wr * 64 + fr) * 1024 + u.pn * BM + wc * 32 + 8 * fq;
#pragma unroll
        for (int ai = 0; ai < 2; ++ai)
#pragma unroll
            for (int m = 0; m < 4; ++m)
#pragma unroll
                for (int bj = 0; bj < 2; ++bj) { float* p = base + (size_t)(ai * HALF + m * 16) * 1024 + bj * HALF; *(f32x4*)p = acc[ai][bj][m][0]; *(f32x4*)(p + 4) = acc[ai][bj][m][1]; }
    }
};

template <class Epi, class Sched, bool ALIGN_EPI = false, bool SP2 = false>
__device__ __forceinline__ void gemm_phase(PG8_LAS unsigned char* lds, const Gemm g, const Sched& S, const Epi& E, const int tid_in) {
    const int tid = tid_in, wid = __builtin_amdgcn_readfirstlane(tid >> 6), lane = tid & 63, wr = wid >> 2, wc = wid & 3, fr = lane & 15, fq = lane >> 4;
    const int K = g.K, nt = K / BK, LD = g.ld ? g.ld : K;
    unsigned voffA[2], voffB[2];
#pragma unroll
    for (int i = 0; i < 2; ++i) { int R, C; stage_rc(tid * 16 + i * 8192, R, C); const int Rb = Epi::PERM ? ((R & ~31) + perm32(R & 31)) : R;
        voffA[i] = (unsigned)(R * LD + C) * 2u; voffB[i] = (unsigned)(Rb * LD + C) * 2u; }
    const size_t kstep = (size_t)(BK * 2);
    const size_t hstep = (size_t)HALF * LD * 2;
    const size_t tstep = 2 * hstep;
    const unsigned ldsw = (unsigned)wid * 1024u;
    const int aoff = lds_byte(wr * 64 + fr, fq * 8), boff = lds_byte(wc * 32 + fr, fq * 8);
#define PG8_SA(b, h) (((b) * 2 + (h)) * HTB)
#define PG8_SB(b, h) ((4 + (b) * 2 + (h)) * HTB)
#define PG8_STAGE(bufoff, gbase, voff) do { _Pragma("unroll") for (int _i = 0; _i < 2; ++_i) \
        __builtin_amdgcn_global_load_lds((const unsigned*)((const char*)(gbase) + (voff)[_i]), (PG8_LAS unsigned*)(lds + (bufoff) + ldsw + _i * 8192), 16, 0, 0); } while (0)
#define PG8_LDA(dst, b, h) do { _Pragma("unroll") for (int m = 0; m < 4; ++m) _Pragma("unroll") for (int k = 0; k < 2; ++k) dst[m][k] = *(const PG8_LAS bf16x8*)(lds + PG8_SA(b, h) + aoff + m * 2048 + k * 1024); } while (0)
#define PG8_LDB(dst, b, h) do { _Pragma("unroll") for (int n = 0; n < 2; ++n) _Pragma("unroll") for (int k = 0; k < 2; ++k) dst[n][k] = *(const PG8_LAS bf16x8*)(lds + PG8_SB(b, h) + boff + n * 2048 + k * 1024); } while (0)
#define PG8_MMA(ai, bj, At, Bt) do { __builtin_amdgcn_s_setprio(1); _Pragma("unroll") for (int m = 0; m < 4; ++m) _Pragma("unroll") for (int n = 0; n < 2; ++n) _Pragma("unroll") for (int k = 0; k < 2; ++k) \
        acc[ai][bj][m][n] = __builtin_amdgcn_mfma_f32_16x16x32_bf16(Bt[n][k], At[m][k], acc[ai][bj][m][n], 0, 0, 0); __builtin_amdgcn_s_setprio(0); } while (0)
#define PG8_WAIT_V(n) asm volatile("s_waitcnt vmcnt(" #n ")" ::: "memory")
#define PG8_WAIT_L(n) asm volatile("s_waitcnt lgkmcnt(" #n ")" ::: "memory")
#define PG8_BAR __builtin_amdgcn_s_barrier()
#define PG8_SCHED __builtin_amdgcn_sched_barrier(0)
    Unit cur, nxt; int ui = 0;
    if (!S.next(0, cur)) return;
    f32x4 acc[2][2][4][2];
#pragma unroll
    for (int a = 0; a < 2; ++a)
#pragma unroll
        for (int b = 0; b < 2; ++b)
#pragma unroll
            for (int m = 0; m < 4; ++m)
#pragma unroll
                for (int n = 0; n < 2; ++n) acc[a][b][m][n] = (f32x4){0.f, 0.f, 0.f, 0.f};
    bf16x8 At[4][2], B0[2][2], B1[2][2];
    const char* cA = (const char*)g.A + (size_t)cur.pm * tstep; const char* cB = (const char*)g.Bt + (size_t)cur.pn * tstep;
    S.a_ready(cur);
    if constexpr (SP2) {
        PG8_STAGE(PG8_SB(0, 0), cB, voffB); PG8_STAGE(PG8_SB(0, 1), cB + hstep, voffB); PG8_STAGE(PG8_SA(0, 0), cA, voffA); PG8_STAGE(PG8_SA(0, 1), cA + hstep, voffA);
        if (wr == 1) PG8_BAR;
        PG8_WAIT_V(2); PG8_BAR;
        PG8_STAGE(PG8_SB(1, 0), cB + kstep, voffB); PG8_STAGE(PG8_SA(1, 0), cA + kstep, voffA); PG8_STAGE(PG8_SB(1, 1), cB + hstep + kstep, voffB);
        PG8_WAIT_V(6); PG8_BAR;
    } else {
        PG8_STAGE(PG8_SB(0, 0), cB, voffB); PG8_STAGE(PG8_SA(0, 0), cA, voffA); PG8_STAGE(PG8_SB(0, 1), cB + hstep, voffB); PG8_STAGE(PG8_SA(0, 1), cA + hstep, voffA);
        if (wr == 1) PG8_BAR;
        PG8_WAIT_V(4); PG8_BAR;
        PG8_STAGE(PG8_SB(1, 0), cB + kstep, voffB); PG8_STAGE(PG8_SA(1, 0), cA + kstep, voffA); PG8_STAGE(PG8_SB(1, 1), cB + hstep + kstep, voffB);
        PG8_WAIT_V(6); PG8_BAR;
    }
    for (;;) {
        const bool has_next = S.next(ui + 1, nxt);
        const char* nA = has_next ? (const char*)g.A + (size_t)nxt.pm * tstep : cA; const char* nB = has_next ? (const char*)g.Bt + (size_t)nxt.pn * tstep : cB;
        for (int t = 0; t < nt; t += 2) {
            const bool last = (t == nt - 2);
            const char* a1 = cA + (size_t)(t + 1) * kstep;
            const char* a2 = last ? nA : cA + (size_t)(t + 2) * kstep; const char* b2 = last ? nB : cB + (size_t)(t + 2) * kstep;
            const char* a3 = a2 + kstep; const char* b3 = b2 + kstep;
            if (last && has_next) S.a_ready(nxt);
            if constexpr (SP2) {
            PG8_LDB(B0, 0, 0); PG8_LDB(B1, 0, 1); PG8_SCHED; PG8_LDA(At, 0, 0); PG8_STAGE(PG8_SA(1, 1), a1 + hstep, voffA);
            PG8_WAIT_V(8); PG8_WAIT_L(0); PG8_BAR; PG8_MMA(0, 0, At, B0); PG8_MMA(0, 1, At, B1); PG8_BAR; PG8_SCHED;
            PG8_LDA(At, 0, 1); PG8_STAGE(PG8_SB(0, 0), b2, voffB); PG8_STAGE(PG8_SB(0, 1), b2 + hstep, voffB); PG8_STAGE(PG8_SA(0, 0), a2, voffA);
            PG8_WAIT_V(8); PG8_WAIT_L(0); PG8_BAR; PG8_MMA(1, 0, At, B0); PG8_MMA(1, 1, At, B1); PG8_BAR; PG8_SCHED;
            PG8_LDB(B0, 1, 0); PG8_LDB(B1, 1, 1); PG8_SCHED; PG8_LDA(At, 1, 0); PG8_STAGE(PG8_SA(0, 1), a2 + hstep, voffA);
            PG8_WAIT_V(8); PG8_WAIT_L(0); PG8_BAR; PG8_MMA(0, 0, At, B0); PG8_MMA(0, 1, At, B1); PG8_BAR; PG8_SCHED;
            PG8_LDA(At, 1, 1); PG8_STAGE(PG8_SB(1, 0), b3, voffB); PG8_STAGE(PG8_SB(1, 1), b3 + hstep, voffB); PG8_STAGE(PG8_SA(1, 0), a3, voffA);
            PG8_WAIT_V(8); PG8_WAIT_L(0); PG8_BAR; PG8_MMA(1, 0, At, B0); PG8_MMA(1, 1, At, B1); PG8_BAR; PG8_SCHED;
            } else {
            PG8_LDB(B0, 0, 0); PG8_SCHED; PG8_LDA(At, 0, 0); PG8_STAGE(PG8_SA(1, 1), a1 + hstep, voffA);
            PG8_WAIT_L(8); PG8_BAR; PG8_WAIT_L(0); PG8_MMA(0, 0, At, B0); PG8_BAR; PG8_SCHED;
            PG8_LDB(B1, 0, 1); PG8_STAGE(PG8_SB(0, 0), b2, voffB);
            PG8_BAR; PG8_WAIT_L(0); PG8_MMA(0, 1, At, B1); PG8_BAR;
            PG8_LDA(At, 0, 1); PG8_STAGE(PG8_SA(0, 0), a2, voffA);
            PG8_BAR; PG8_WAIT_L(0); PG8_MMA(1, 0, At, B0); PG8_BAR; PG8_SCHED;
            PG8_STAGE(PG8_SB(0, 1), b2 + hstep, voffB);
            PG8_WAIT_V(6); PG8_BAR; PG8_MMA(1, 1, At, B1); PG8_BAR;
            PG8_LDB(B0, 1, 0); PG8_SCHED; PG8_LDA(At, 1, 0); PG8_STAGE(PG8_SA(0, 1), a2 + hstep, voffA);
            PG8_WAIT_L(8); PG8_BAR; PG8_WAIT_L(0); PG8_MMA(0, 0, At, B0); PG8_BAR; PG8_SCHED;
            PG8_LDB(B1, 1, 1); PG8_STAGE(PG8_SB(1, 0), b3, voffB);
            PG8_BAR; PG8_WAIT_L(0); PG8_MMA(0, 1, At, B1); PG8_BAR;
            PG8_LDA(At, 1, 1); PG8_STAGE(PG8_SA(1, 0), a3, voffA);
            PG8_BAR; PG8_WAIT_L(0); PG8_MMA(1, 0, At, B0); PG8_BAR; PG8_SCHED;
            PG8_STAGE(PG8_SB(1, 1), b3 + hstep, voffB);
            PG8_WAIT_V(6); PG8_BAR; PG8_MMA(1, 1, At, B1); PG8_BAR;
            }
        }
        if constexpr (ALIGN_EPI) { if (wr == 0) PG8_BAR; }
        if constexpr (!Epi::AFTER_DRAIN) { E(acc, cur, wr, wc, fr, fq); S.done(cur); }
        if (!has_next) break;
#pragma unroll
        for (int a = 0; a < 2; ++a)
#pragma unroll
            for (int b = 0; b < 2; ++b)
#pragma unroll
                for (int m = 0; m < 4; ++m)
#pragma unroll
                    for (int n = 0; n < 2; ++n) acc[a][b][m][n] = (f32x4){0.f, 0.f, 0.f, 0.f};
        cur = nxt; cA = nA; cB = nB; ++ui;
        if constexpr (ALIGN_EPI) { if (wr == 1) PG8_BAR; }
    }
    PG8_WAIT_V(0);
    if constexpr (!ALIGN_EPI) { if (wr == 0) PG8_BAR; }
    PG8_BAR;
    if constexpr (Epi::AFTER_DRAIN) { E.fused(acc, cur, wr, wc, fr, fq, lds, wid, lane); S.done(cur); }
#undef PG8_SA
#undef PG8_SB
#undef PG8_STAGE
#undef PG8_LDA
#undef PG8_LDB
#undef PG8_MMA
#undef PG8_WAIT_V
#undef PG8_WAIT_L
#undef PG8_BAR
#undef PG8_SCHED
}
}
namespace attn_body {
using bf16=__hip_bfloat16;
using bf16x8=__attribute__((ext_vector_type(8)))short;
using s16x4=__attribute__((ext_vector_type(4)))short;
using f32x16=__attribute__((ext_vector_type(16)))float;
using u32x4=__attribute__((ext_vector_type(4)))unsigned;
constexpr int D=64,QP=2304,KP=2304,OP=1024;
constexpr int NW=8,QBLK=32,QB=QBLK*NW,KVBLK=64;
__device__ __forceinline__ int crow(int r,int hi){return (r&3)+8*(r>>2)+4*hi;}
#define SBAR() __builtin_amdgcn_sched_barrier(0)
__device__ __forceinline__ void cmask(f32x16&p0,f32x16&p1,int jb,int qrel,int hi){
  const float NEG=-INFINITY; int kb=64*jb+4*hi;
  #pragma unroll
  for(int r=0;r<16;++r){int kv=kb+(r&3)+8*(r>>2); if(kv>qrel)p0[r]=NEG; if(kv+32>qrel)p1[r]=NEG;}
}

constexpr int NSLOT=3, SLOTB=8192;
constexpr int LDS_K=0, LDS_V=NSLOT*SLOTB, LDS_WS=2*NSLOT*SLOTB, LDS_OST=LDS_WS+NW*64*4, LDS_BYTES=LDS_OST+NW*4096;
constexpr float C2=0.125f*1.4426950408889634f;
__device__ __forceinline__ void glds16(const void*gsrc,unsigned lds_dst){unsigned keep;
  asm volatile("s_mov_b32 %0, m0\n\ts_mov_b32 m0, %2\n\ts_nop 0\n\tglobal_load_lds_dwordx4 %1, off\n\ts_mov_b32 m0, %0":"=&s"(keep):"v"(gsrc),"s"(lds_dst):"memory");}
__device__ __forceinline__ float max3f(float a,float b,float c){float r;asm("v_max3_f32 %0, %1, %2, %3":"=v"(r):"v"(a),"v"(b),"v"(c));return r;}
__device__ __forceinline__ float max2f(float a,float b){float r;asm("v_max_f32_e32 %0, %1, %2":"=v"(r):"v"(a),"v"(b));return r;}
__device__ __forceinline__ float fadd_s(float a,float b){float r;asm("v_add_f32_e32 %0, %1, %2":"=v"(r):"v"(a),"v"(b));return r;}
__device__ __forceinline__ float fsub_s(float a,float b){float r;asm("v_sub_f32_e32 %0, %1, %2":"=v"(r):"v"(a),"v"(b));return r;}
typedef float f32x2_t __attribute__((ext_vector_type(2))); typedef __bf16 bf16x2_t __attribute__((ext_vector_type(2)));
__device__ __forceinline__ unsigned cvtpk_s(float lo,float hi){f32x2_t v={lo,hi};bf16x2_t b=__builtin_convertvector(v,bf16x2_t);return __builtin_bit_cast(unsigned,b);}
#define WAIT_BAR(N) asm volatile("s_waitcnt vmcnt(" #N ") lgkmcnt(0)\n\ts_barrier":::"memory")

__device__ __forceinline__ void qkt(f32x16&p0,f32x16&p1,const char*Kslot,const bf16x8*qr,const f32x16&negm,int r32,int hi){
  const char*kb=Kslot+hi*1024+r32*16;
  #pragma unroll
  for(int d0=0;d0<4;++d0){
    const bf16x8 b0=*reinterpret_cast<const bf16x8*>(kb+d0*2048);
    const bf16x8 b1=*reinterpret_cast<const bf16x8*>(kb+d0*2048+512);
    if(d0==0){p0=__builtin_amdgcn_mfma_f32_32x32x16_bf16(b0,qr[0],negm,0,0,0);p1=__builtin_amdgcn_mfma_f32_32x32x16_bf16(b1,qr[0],negm,0,0,0);}
    else{p0=__builtin_amdgcn_mfma_f32_32x32x16_bf16(b0,qr[d0],p0,0,0,0);p1=__builtin_amdgcn_mfma_f32_32x32x16_bf16(b1,qr[d0],p1,0,0,0);}}
}
typedef __attribute__((address_space(3))) const char* lds_cptr;
typedef short v4i16_t __attribute__((ext_vector_type(4)));
__device__ __forceinline__ void kload8(bf16x8*kf,lds_cptr kp){
  kf[0]=*(const __attribute__((address_space(3))) bf16x8*)(kp);      kf[1]=*(const __attribute__((address_space(3))) bf16x8*)(kp+512);
  kf[2]=*(const __attribute__((address_space(3))) bf16x8*)(kp+2048); kf[3]=*(const __attribute__((address_space(3))) bf16x8*)(kp+2560);
  kf[4]=*(const __attribute__((address_space(3))) bf16x8*)(kp+4096); kf[5]=*(const __attribute__((address_space(3))) bf16x8*)(kp+4608);
  kf[6]=*(const __attribute__((address_space(3))) bf16x8*)(kp+6144); kf[7]=*(const __attribute__((address_space(3))) bf16x8*)(kp+6656);
}
__device__ __forceinline__ void kload2(bf16x8*kf,lds_cptr kp,int j){ kf[2*j]=*(const __attribute__((address_space(3))) bf16x8*)(kp+j*2048); kf[2*j+1]=*(const __attribute__((address_space(3))) bf16x8*)(kp+j*2048+512); }
__device__ __forceinline__ s16x4 vtr(lds_cptr p){ return __builtin_bit_cast(s16x4,__builtin_amdgcn_ds_read_tr16_b64_v4i16((__attribute__((address_space(3))) v4i16_t*)p)); }
__device__ __forceinline__ float rowmax(const f32x16&p0,const f32x16&p1){
  float a=max3f(p0[0],p0[1],p1[0]),b=max3f(p0[2],p0[3],p1[1]);a=max3f(a,p1[2],p1[3]);
  #pragma unroll
  for(int r=4;r<16;r+=4){a=max3f(a,p0[r],p0[r+1]);b=max3f(b,p0[r+2],p0[r+3]);a=max3f(a,p1[r],p1[r+1]);b=max3f(b,p1[r+2],p1[r+3]);}
  const float m=max2f(a,b);
  auto rr=__builtin_amdgcn_permlane32_swap(__float_as_uint(m),__float_as_uint(m),false,false);
  return max2f(__uint_as_float(rr[0]),__uint_as_float(rr[1]));
}
__device__ __forceinline__ void pv(f32x16*o,int vb,bf16x8 pa0,bf16x8 pa1,bf16x8 pa2,bf16x8 pa3){
  #pragma unroll
  for(int d0=0;d0<2;++d0){s16x4 lo[4],hi[4];
    #pragma unroll
    for(int ks=0;ks<4;++ks){
      asm volatile("ds_read_b64_tr_b16 %0,%1 offset:%c2":"=&v"(lo[ks]):"v"(vb),"i"(d0*4096+ks*1024):"memory");
      asm volatile("ds_read_b64_tr_b16 %0,%1 offset:%c2":"=&v"(hi[ks]):"v"(vb),"i"(d0*4096+ks*1024+512):"memory");}
    asm volatile("s_waitcnt lgkmcnt(0)":::"memory");SBAR();
    #define PK(k) (bf16x8){lo[k][0],lo[k][1],lo[k][2],lo[k][3],hi[k][0],hi[k][1],hi[k][2],hi[k][3]}
    o[d0]=__builtin_amdgcn_mfma_f32_32x32x16_bf16(pa0,PK(0),o[d0],0,0,0);
    o[d0]=__builtin_amdgcn_mfma_f32_32x32x16_bf16(pa1,PK(1),o[d0],0,0,0);
    o[d0]=__builtin_amdgcn_mfma_f32_32x32x16_bf16(pa2,PK(2),o[d0],0,0,0);
    o[d0]=__builtin_amdgcn_mfma_f32_32x32x16_bf16(pa3,PK(3),o[d0],0,0,0);
    #undef PK
  }
}

#ifndef ATTN_STORE16
#define ATTN_STORE16(p,v) (*(u32x4*)(p)=(v))
#endif
template<int THRL> __device__ __forceinline__ void attn_unit(const bf16*Qu,const bf16*__restrict__ Kc,const bf16*__restrict__ Vc,const bf16*__restrict__ Kl,const bf16*__restrict__ Vl,const int NT,bf16*Ou,char*shm,const int tid_in){
  const int tid=tid_in,lane=tid&63,r32=lane&31,hi=lane>>5; const int wid=__builtin_amdgcn_readfirstlane(tid>>6);
  const bf16*Qw=Qu+(long)(wid*QBLK)*QP;
  const unsigned lds0=(unsigned)(uintptr_t)shm;
  float*wsf=(float*)(shm+LDS_WS)+wid*64;
  const long koff=(long)lane*KP+wid*8;
  const long voff=(long)(16*(wid&3)+(lane>>2))*KP+(wid>>2)*32+(lane&3)*8;
  const unsigned kdst=lds0+LDS_K+wid*1024, vdst=lds0+LDS_V+wid*1024;
  #define DMA_K(t,slot) glds16((((t)<4)?(Kc+(long)(t)*KVBLK*KP):(Kl+(long)((t)-4)*KVBLK*KP))+koff,(unsigned)__builtin_amdgcn_readfirstlane(kdst+(slot)))
  #define DMA_V(t,slot) glds16((((t)<4)?(Vc+(long)(t)*KVBLK*KP):(Vl+(long)((t)-4)*KVBLK*KP))+voff,(unsigned)__builtin_amdgcn_readfirstlane(vdst+(slot)))
  const int vb0=(int)(lds0+LDS_V)+((lane>>4)&1)*32+(lane&3)*8+(4*hi+((lane&15)>>2))*64;
  const char*Kbase=shm+LDS_K; bf16x8 kf[8];
  const lds_cptr shm3=(lds_cptr)shm; const lds_cptr kp0=shm3+LDS_K+hi*1024+r32*16; const lds_cptr vp0=shm3+LDS_V+((lane>>4)&1)*32+(lane&3)*8+(4*hi+((lane&15)>>2))*64;
  DMA_K(0,0);DMA_V(0,0);DMA_K(1,SLOTB);
  bf16x8 qr[4];
  #pragma unroll
  for(int d0=0;d0<4;++d0)qr[d0]=*reinterpret_cast<const bf16x8*>(&Qw[(long)r32*QP+d0*16+hi*8]);
  float mhat=0.f,l_reg=0.f;f32x16 o[2];o[0]=f32x16{};o[1]=f32x16{};f32x16 negm=f32x16{};asm volatile("":"+v"(negm));
  #define CMASK(P0,P1,t) do{}while(0)
  bool resc=false;
  #define START(P0,P1) do{ const float rm=rowmax(P0,P1); resc=false; \
    { const float dl=rm; mhat=fadd_s(mhat,dl); \
      _Pragma("unroll") for(int r=0;r<16;++r){P0[r]=fsub_s(P0[r],dl);P1[r]=fsub_s(P1[r],dl);} \
      _Pragma("unroll") for(int r=0;r<16;++r)negm[r]=-mhat; asm volatile("":"+v"(negm)); } \
    _Pragma("unroll") for(int r=0;r<16;++r)P0[r]=__builtin_amdgcn_exp2f(P0[r]); }while(0)
  #define RESC() do{ if(resc){ asm volatile("s_waitcnt lgkmcnt(0)":::"memory"); \
      _Pragma("unroll") for(int d_=0;d_<2;++d_) _Pragma("unroll") for(int r=0;r<16;++r)o[d_][r]*=wsf[crow(r,hi)]; } }while(0)
  f32x16 pA0,pA1,pB0,pB1;
  int sl_prev=0,sl_cur=0,sl_next=SLOTB;
  #define ROT() do{sl_prev=sl_cur;sl_cur=sl_next;sl_next=(sl_next==(NSLOT-1)*SLOTB)?0:sl_next+SLOTB;}while(0)
  DMA_K(2,2*SLOTB);
  WAIT_BAR(3);
  qkt(pA0,pA1,Kbase,qr,negm,r32,hi);asm volatile("s_nop 15\n\ts_nop 7":"+v"(pA0),"+v"(pA1));CMASK(pA0,pA1,0);
  START(pA0,pA1);
  _Pragma("unroll") for(int r=0;r<16;++r)pA1[r]=__builtin_amdgcn_exp2f(pA1[r]);
  WAIT_BAR(0);
  DMA_K(3,0);DMA_V(1,SLOTB);
  ROT();
  kload8(kf,kp0+sl_cur);
  WAIT_BAR(2);
  s16x4 vlo[8],vhi[8]; u32x4 pw0,pw1,pw2,pw3;
  #define PKW(P,B) cvtpk_s(P[B],P[B+1])
  #define PAF(k) __builtin_bit_cast(bf16x8,pw##k)
  #define VFR(i) (bf16x8){vlo[i][0],vlo[i][1],vlo[i][2],vlo[i][3],vhi[i][0],vhi[i][1],vhi[i][2],vhi[i][3]}
  #define PIN(x) asm volatile("":"+v"(x))
  #define MX3(a,b,c) __builtin_fmaxf(__builtin_fmaxf((a),(b)),(c))
  #define GAPA(MF,A0,A1,A2,A3,W0,W1,PW) do{ MF; sacc+=A0; sacc+=A1; sacc+=A2; sacc+=A3; PIN(sacc); W0; W1; PIN(PW); SBAR(); }while(0)
  #define EX(v) __builtin_amdgcn_exp2f(v)
  #define GAPB(MF,X,B) do{ MF; X[B]=EX(X[B]); X[B+1]=EX(X[B+1]); X[B+2]=EX(X[B+2]); X[B+3]=EX(X[B+3]); PIN(X); SBAR(); }while(0)
  #define VRD(i) do{ vlo[i]=vtr(vp_+(((i)>>2)*4096+((i)&3)*1024)); vhi[i]=vtr(vp_+(((i)>>2)*4096+((i)&3)*1024+512)); }while(0)
  #define KRD(G,j) do{ if(G){ kload2(kf,kp0+sl_next,j); SBAR(); } }while(0)
  #define STEP(C0,C1,P0,P1,t,GK,GV,GL) do{ SBAR(); \
    const lds_cptr vp_=vp0+sl_prev; \
    VRD(0); SBAR(); float sacc=(P0[0]+P0[1]); \
    GAPA(C0=__builtin_amdgcn_mfma_f32_32x32x16_bf16(kf[0],qr[0],negm,0,0,0), P0[2],P0[3],P0[4],P0[5],     pw0[0]=PKW(P0,0), pw0[1]=PKW(P0,2), pw0); \
    VRD(4); SBAR(); GAPA(C1=__builtin_amdgcn_mfma_f32_32x32x16_bf16(kf[1],qr[0],negm,0,0,0), P0[6],P0[7],P0[8],P0[9],     pw0[2]=PKW(P0,4), pw0[3]=PKW(P0,6), pw0); \
    VRD(1); SBAR(); GAPA(C0=__builtin_amdgcn_mfma_f32_32x32x16_bf16(kf[2],qr[1],C0,0,0,0),   P0[10],P0[11],P0[12],P0[13], pw1[0]=PKW(P0,8), pw1[1]=PKW(P0,10), pw1); \
    VRD(5); SBAR(); GAPA(C1=__builtin_amdgcn_mfma_f32_32x32x16_bf16(kf[3],qr[1],C1,0,0,0),   P0[14],P0[15],P1[0],P1[1],   pw1[2]=PKW(P0,12),pw1[3]=PKW(P0,14), pw1); \
    VRD(2); SBAR(); GAPA(C0=__builtin_amdgcn_mfma_f32_32x32x16_bf16(kf[4],qr[2],C0,0,0,0),   P1[2],P1[3],P1[4],P1[5],     pw2[0]=PKW(P1,0), pw2[1]=PKW(P1,2), pw2); \
    VRD(6); SBAR(); GAPA(C1=__builtin_amdgcn_mfma_f32_32x32x16_bf16(kf[5],qr[2],C1,0,0,0),   P1[6],P1[7],P1[8],P1[9],     pw2[2]=PKW(P1,4), pw2[3]=PKW(P1,6), pw2); \
    VRD(3); SBAR(); GAPA(C0=__builtin_amdgcn_mfma_f32_32x32x16_bf16(kf[6],qr[3],C0,0,0,0),   P1[10],P1[11],P1[12],P1[13], pw3[0]=PKW(P1,8), pw3[1]=PKW(P1,10), pw3); \
    VRD(7); SBAR(); GAPA(C1=__builtin_amdgcn_mfma_f32_32x32x16_bf16(kf[7],qr[3],C1,0,0,0),   P1[14],P1[15],0.f,0.f,       pw3[2]=PKW(P1,12),pw3[3]=PKW(P1,14), pw3); \
    l_reg+=sacc; \
    if(GK){DMA_K((t)+3,sl_cur);} if(GV){DMA_V((t)+1,sl_next);} \
    CMASK(C0,C1,t); \
    { float a=MX3(C0[0],C0[1],C1[0]),b=MX3(C0[2],C0[3],C1[1]); a=MX3(a,C1[2],C1[3]); \
      _Pragma("unroll") for(int r=4;r<16;r+=4){a=MX3(a,C0[r],C0[r+1]);b=MX3(b,C0[r+2],C0[r+3]);a=MX3(a,C1[r],C1[r+1]);b=MX3(b,C1[r+2],C1[r+3]);} \
      float rm=__builtin_fmaxf(a,b); { auto rr=__builtin_amdgcn_permlane32_swap(__float_as_uint(rm),__float_as_uint(rm),false,false); rm=__builtin_fmaxf(__uint_as_float(rr[0]),__uint_as_float(rr[1])); } \
      resc=false; \
      if(__builtin_expect(__any(rm>(float)THRL),0)){ const float dl=__builtin_fmaxf(rm,0.f); mhat+=dl; \
        _Pragma("unroll") for(int r=0;r<16;++r){C0[r]-=dl;C1[r]-=dl;} \
        _Pragma("unroll") for(int r=0;r<16;++r)negm[r]=-mhat; asm volatile("":"+v"(negm)); \
        const float f=__builtin_amdgcn_exp2f(-dl); l_reg*=f; if(hi==0)wsf[r32]=f; resc=true; } } \
    SBAR(); \
    GAPB(o[0]=__builtin_amdgcn_mfma_f32_32x32x16_bf16(PAF(0),VFR(0),o[0],0,0,0), C0,0); \
    GAPB(o[1]=__builtin_amdgcn_mfma_f32_32x32x16_bf16(PAF(0),VFR(4),o[1],0,0,0), C0,4); \
    KRD(GL,0); GAPB(o[0]=__builtin_amdgcn_mfma_f32_32x32x16_bf16(PAF(1),VFR(1),o[0],0,0,0), C0,8); \
    KRD(GL,1); GAPB(o[1]=__builtin_amdgcn_mfma_f32_32x32x16_bf16(PAF(1),VFR(5),o[1],0,0,0), C0,12); \
    KRD(GL,2); GAPB(o[0]=__builtin_amdgcn_mfma_f32_32x32x16_bf16(PAF(2),VFR(2),o[0],0,0,0), C1,0); \
    KRD(GL,3); GAPB(o[1]=__builtin_amdgcn_mfma_f32_32x32x16_bf16(PAF(2),VFR(6),o[1],0,0,0), C1,4); \
    GAPB(o[0]=__builtin_amdgcn_mfma_f32_32x32x16_bf16(PAF(3),VFR(3),o[0],0,0,0), C1,8); \
    GAPB(o[1]=__builtin_amdgcn_mfma_f32_32x32x16_bf16(PAF(3),VFR(7),o[1],0,0,0), C1,12); \
    }while(0)
  int t=1;
  #undef CMASK
  #define CMASK(P0,P1,t) do{}while(0)
  for(;t+5<NT;t+=2){
    STEP(pB0,pB1,pA0,pA1,t,true,true,true);     WAIT_BAR(2); RESC(); ROT();
    STEP(pA0,pA1,pB0,pB1,t+1,true,true,true);   WAIT_BAR(2); RESC(); ROT();
  }
  #undef CMASK
  #define CMASK(P0,P1,t) do{}while(0)
  #define ENDW(tt) do{ if((tt)+3<NT){WAIT_BAR(2);} else if((tt)+2<NT){WAIT_BAR(1);} else {WAIT_BAR(0);} }while(0)
  for(;t+1<NT;t+=2){
    STEP(pB0,pB1,pA0,pA1,t,(t+3<NT),(t+1<NT),(t+1<NT));       ENDW(t);   RESC(); ROT();
    STEP(pA0,pA1,pB0,pB1,t+1,(t+4<NT),(t+2<NT),(t+2<NT));     ENDW(t+1); RESC(); ROT();
  }
  STEP(pB0,pB1,pA0,pA1,NT-1,false,false,false); RESC();
  { float sacc=pB0[0]+pB0[1]; _Pragma("unroll") for(int r=2;r<16;++r)sacc+=pB0[r]; _Pragma("unroll") for(int r=0;r<16;++r)sacc+=pB1[r]; l_reg+=sacc;
    pw0=(u32x4){PKW(pB0,0),PKW(pB0,2),PKW(pB0,4),PKW(pB0,6)};pw1=(u32x4){PKW(pB0,8),PKW(pB0,10),PKW(pB0,12),PKW(pB0,14)};pw2=(u32x4){PKW(pB1,0),PKW(pB1,2),PKW(pB1,4),PKW(pB1,6)};pw3=(u32x4){PKW(pB1,8),PKW(pB1,10),PKW(pB1,12),PKW(pB1,14)};
    SBAR(); pv(o,vb0+sl_cur,PAF(0),PAF(1),PAF(2),PAF(3)); }
  #undef PKW
  #undef PAF
  #undef VFR
  #undef PIN
  #undef MX3
  #undef GAPA
  #undef GAPB
  #undef EX
  #undef VRD
  #undef KRD
  #undef STEP
  #undef ENDW
  {auto rr=__builtin_amdgcn_permlane32_swap(__float_as_uint(l_reg),__float_as_uint(l_reg),false,false);l_reg=__uint_as_float(rr[0])+__uint_as_float(rr[1]);}
  if(hi==0)wsf[32+r32]=l_reg;asm volatile("s_waitcnt lgkmcnt(0)":::"memory");
  float rli[16];
  #pragma unroll
  for(int r=0;r<16;++r)rli[r]=__builtin_amdgcn_rcpf(wsf[32+crow(r,hi)]);
  bf16*Ow=Ou+(long)(wid*QBLK)*OP;
  { bf16*stg=(bf16*)(shm+LDS_OST)+wid*2048;
    #pragma unroll
    for(int r=0;r<16;++r){const int orow=crow(r,hi);
      #pragma unroll
      for(int d0=0;d0<2;++d0)stg[orow*64+d0*32+r32]=__float2bfloat16(o[d0][r]*rli[r]);}
    asm volatile("s_waitcnt lgkmcnt(0)":::"memory");
    #pragma unroll
    for(int i=0;i<4;++i){const int row=i*8+(lane>>3),ch=lane&7; const u32x4 v=*(const u32x4*)(stg+row*64+ch*8); ATTN_STORE16(Ow+(long)row*OP+ch*8,v);} }
  asm volatile("s_waitcnt lgkmcnt(0)\n\ts_barrier":::"memory");
  #undef DMA_K
  #undef DMA_V
  #undef CMASK
  #undef START
  #undef RESC
  #undef ROT
}
constexpr int ATTN_LDS_BYTES=LDS_BYTES;
#undef SBAR
#undef WAIT_BAR
}
#define GAS __attribute__((address_space(1)))
#define LAS __attribute__((address_space(3)))
typedef GAS unsigned gu32;
typedef GAS unsigned long long gu64;
#define RLX_AGENT __ATOMIC_RELAXED, __HIP_MEMORY_SCOPE_AGENT
#define LDS_WAIT() asm volatile("s_waitcnt lgkmcnt(0)" ::: "memory")
#define VM_WAIT() asm volatile("s_waitcnt vmcnt(0)" ::: "memory")
__device__ __forceinline__ unsigned long long rt() { return __builtin_amdgcn_s_memrealtime(); }
#define XB_TMO      128
#define XB_XCNT(j)  (256  + 64 * (j))
#define XB_XSUB(j)  (1280 + 64 * (j))
#define XB_XGEN(j)  (2304 + 64 * (j))
#define XB_TOP      3328
#define XB_TOPGEN   3392
#define XCD_BAR_WORDS 3456
#define XB_SPIN_CAP (1u << 18)

__device__ __forceinline__ unsigned xb_ld(unsigned* p)              { return __hip_atomic_load(p, __ATOMIC_RELAXED, __HIP_MEMORY_SCOPE_AGENT); }
__device__ __forceinline__ unsigned xb_add(unsigned* p, unsigned v) { return __hip_atomic_fetch_add(p, v, __ATOMIC_RELAXED, __HIP_MEMORY_SCOPE_AGENT); }
__device__ __forceinline__ unsigned xb_xcc_id() { return (unsigned)__builtin_amdgcn_s_getreg((3 << 11) | 20) & 0xFu; }
#define XB_SPIN(cond, bar) do { unsigned _sp = 0; while (cond) { __builtin_amdgcn_s_sleep(1); \
    if ((++_sp & 255u) == 0u) { if (xb_ld(&(bar)[XB_TMO])) break; if (_sp > XB_SPIN_CAP) { atomicAdd(&(bar)[XB_TMO], 1u); break; } } } } while (0)

struct XcdBarrier {
    unsigned* bar; unsigned x;
    volatile LAS unsigned* st;
};

__device__ __forceinline__ XcdBarrier xcd_barrier_post(unsigned* bar, volatile LAS unsigned* st) {
    XcdBarrier b; b.bar = bar; b.x = xb_xcc_id(); b.st = st;
    if (threadIdx.x == 0) (void)xb_add(&bar[XB_XCNT(b.x)], 1u);
    return b;
}
__device__ __forceinline__ void xcd_barrier_complete(unsigned* bar, unsigned x, unsigned& nloc, unsigned& nx) {
    const unsigned G = gridDim.x * gridDim.y * gridDim.z;
    unsigned sum, cnt, mine, sp = 0u;
    for (;;) {
        sum = 0u; cnt = 0u; mine = 0u;
#pragma unroll
        for (unsigned j = 0; j < 16; ++j) { const unsigned c = xb_ld(&bar[XB_XCNT(j)]); sum += c; cnt += (c > 0u) ? 1u : 0u; mine = (j == x) ? c : mine; }
        if (sum == G) break;
        __builtin_amdgcn_s_sleep(1);
        if ((++sp & 255u) == 0u) { if (xb_ld(&bar[XB_TMO])) break; if (sp > XB_SPIN_CAP) { atomicAdd(&bar[XB_TMO], 1u); break; } }
    }
    nloc = mine > 0u ? mine : 1u; nx = cnt > 0u ? cnt : 1u;
}

__device__ __forceinline__ void xcd_barrier(const XcdBarrier& b) {
    asm volatile("s_waitcnt vmcnt(0)" ::: "memory");
    __syncthreads();
    if (threadIdx.x == 0) {
        unsigned* bar = b.bar;
        __builtin_amdgcn_s_waitcnt(0);
        unsigned nloc = b.st[0], nx = b.st[1];
        if (nloc == 0u) { xcd_barrier_complete(bar, b.x, nloc, nx); b.st[0] = nloc; b.st[1] = nx; }
        const unsigned old = xb_add(&bar[XB_XSUB(b.x)], 1u);
        const unsigned gen = old / nloc;
        if (old + 1u == (gen + 1u) * nloc) {
            __builtin_amdgcn_fence(__ATOMIC_RELEASE, "agent");
            asm volatile("s_waitcnt vmcnt(0)" ::: "memory");
            const unsigned og = xb_add(&bar[XB_TOP], 1u);
            const unsigned tg = og / nx;
            if (og + 1u == (tg + 1u) * nx) xb_add(&bar[XB_TOPGEN], 1u);
            else XB_SPIN(xb_ld(&bar[XB_TOPGEN]) == tg, bar);
            __builtin_amdgcn_fence(__ATOMIC_ACQUIRE, "agent");
            xb_add(&bar[XB_XGEN(b.x)], 1u);
            asm volatile("s_waitcnt vmcnt(0)" ::: "memory");
        } else {
            XB_SPIN(xb_ld(&bar[XB_XGEN(b.x)]) == gen, bar);
            __builtin_amdgcn_fence(__ATOMIC_ACQUIRE, "agent");
            asm volatile("s_waitcnt vmcnt(0)" ::: "memory");
        }
    }
    __syncthreads();
}


constexpr int NB = 16, SEQ = 2048, CTXL = 256, DM = 1024, DEPTH = 4, DFF = 2816, DIN = 2320, NPROJ = 2304, NPROJP = 2560;
constexpr int ML = NB * SEQ, MC = NB * CTXL, MT = ML + MC;
constexpr int NCHUNK = 36;
constexpr float EPS = 1e-6f;
constexpr float QSCALE = 0.125f * 1.4426950408889634f;
constexpr int PC_Q = 0, PC_K = 512, PC_V = 640, PC_QM = 768, PC_KM = 1024, PC_VM = 1280, PC_OM = 1536, PC_UC = 1792, PC_VC = 2048;
constexpr size_t MiB = 1u << 20;
constexpr size_t WS_CTL = 0, CTL_ZERO_BYTES = 65536, WS_ROPE = 32768, WS_SHW1 = 65536, WS_ROWSS = 2816 * 1024, WS_SHW2 = 3328 * 1024;
constexpr size_t WS_MOD = 1 * MiB, WS_WIN = 6 * MiB, WS_WOUT = 26 * MiB, WS_WUP = 34 * MiB, WS_WDOWN = 78 * MiB;
constexpr size_t WS_XC = 100 * MiB, WS_H = 116 * MiB, WS_PROJ = 188 * MiB, WS_GATES = 350 * MiB, WS_MIX = 353 * MiB;
constexpr size_t WS_MSC = 425 * MiB, WS_MSN = 497 * MiB, WS_MSS = 499 * MiB, WS_END = 500 * MiB;
constexpr size_t WS_ACT = 188 * MiB, WS_EDGE = 386 * MiB;
static_assert(WS_ACT + (size_t)MT * DFF * 2 <= WS_EDGE && WS_EDGE + (size_t)(MT / 64) * 2 * 4 * DFF * 4 <= WS_MSN, "ffn overlay");
static_assert(WS_SHW1 + (size_t)4 * 17 * 2560 * 4 <= WS_MOD && WS_MOD + (size_t)4 * 17 * 6144 * 4 <= WS_ROWSS && WS_ROWSS + (size_t)2 * 36864 * 4 <= WS_SHW2 && WS_SHW2 + (size_t)4 * 17 * 5632 * 4 <= WS_WIN, "ws map lo");
static_assert(WS_PROJ + (size_t)MT * NPROJ * 2 <= WS_GATES && WS_MIX + (size_t)MT * DM * 2 <= WS_MSC && WS_MSC + (size_t)128 * NCHUNK * 4096 * 4 <= WS_MSN, "ws map");

constexpr int NWAVES = 8, NTHREADS = 512;
constexpr int RING_BYTES = 131072, LDS_BYTES = 147456;

typedef unsigned short bf16;
typedef float f32x4 __attribute__((ext_vector_type(4)));
typedef float f32x2 __attribute__((ext_vector_type(2)));
typedef short bf16x8 __attribute__((ext_vector_type(8)));
typedef unsigned u32x4 __attribute__((ext_vector_type(4)));
typedef unsigned u32x2 __attribute__((ext_vector_type(2)));

__device__ __forceinline__ unsigned f2bf(float f) { unsigned u = __builtin_bit_cast(unsigned, f); return (u + 0x7fffu + ((u >> 16) & 1u)) >> 16; }
__device__ __forceinline__ unsigned pk2(float lo, float hi) { return f2bf(lo) | (f2bf(hi) << 16); }
__device__ __forceinline__ float bf2f(unsigned u16) { return __uint_as_float(u16 << 16); }
__device__ __forceinline__ float bflo(unsigned w) { return __uint_as_float(w << 16); }
__device__ __forceinline__ float bfhi(unsigned w) { return __uint_as_float(w & 0xffff0000u); }
__device__ __forceinline__ float silu_f(float x) { return x / (1.f + __expf(-x)); }
__device__ __forceinline__ float sigmoid_f(float x) { return 1.f / (1.f + __expf(-x)); }
__device__ __forceinline__ float gelu_tanh(float x) { const float u = 0.7978845608028654f * (x + 0.044715f * x * x * x); const float e = __expf(2.f * u); const float t = 1.f - 2.f / (e + 1.f); return 0.5f * x * (1.f + t); }
__device__ __forceinline__ float logsig(float x) { return fminf(x, 0.f) - log1pf(__expf(-fabsf(x))); }
__device__ __forceinline__ float bperm(float v, int src) { return __builtin_bit_cast(float, __builtin_amdgcn_ds_bpermute(src << 2, __builtin_bit_cast(int, v))); }
__device__ __forceinline__ float wave_sum(float v, int lane) {
#pragma unroll
    for (int o = 1; o < 64; o <<= 1) v += bperm(v, lane ^ o);
    return v;
}
__device__ __forceinline__ float wave_max(float v, int lane) {
#pragma unroll
    for (int o = 1; o < 64; o <<= 1) v = fmaxf(v, bperm(v, lane ^ o));
    return v;
}
__device__ __forceinline__ float scan_add_fwd(float v, int lane) {
#pragma unroll
    for (int o = 1; o < 64; o <<= 1) { const float t = bperm(v, lane >= o ? lane - o : lane); if (lane >= o) v += t; }
    return v;
}
__device__ __forceinline__ float scan_add_bwd(float v, int lane) {
#pragma unroll
    for (int o = 1; o < 64; o <<= 1) { const float t = bperm(v, lane + o < 64 ? lane + o : lane); if (lane + o < 64) v += t; }
    return v;
}
__device__ __forceinline__ float scan_max_fwd(float v, int lane) {
#pragma unroll
    for (int o = 1; o < 64; o <<= 1) { const float t = bperm(v, lane >= o ? lane - o : lane); if (lane >= o) v = fmaxf(v, t); }
    return v;
}
__device__ __forceinline__ float scan_max_bwd(float v, int lane) {
#pragma unroll
    for (int o = 1; o < 64; o <<= 1) { const float t = bperm(v, lane + o < 64 ? lane + o : lane); if (lane + o < 64) v = fmaxf(v, t); }
    return v;
}
__device__ __forceinline__ f32x4 mma16(const bf16* A, int lda, const bf16* Bt, int ldb, int K, int mt, int nt, int lane, f32x4 acc) {
    const bf16* ap = A + (16 * mt + (lane & 15)) * lda + (lane >> 4) * 8;
    const bf16* bp = Bt + (16 * nt + (lane & 15)) * ldb + (lane >> 4) * 8;
    for (int k0 = 0; k0 < K; k0 += 32) {
        const bf16x8 a = *(const bf16x8*)(ap + k0), b = *(const bf16x8*)(bp + k0);
        acc = __builtin_amdgcn_mfma_f32_16x16x32_bf16(a, b, acc, 0, 0, 0);
    }
    return acc;
}

__device__ __forceinline__ int launder(int v) { asm volatile("" : "+v"(v)); return v; }
__device__ __forceinline__ int fresh_lane() { int l; asm volatile("v_mbcnt_lo_u32_b32 %0, -1, 0\n\tv_mbcnt_hi_u32_b32 %0, -1, %0" : "=v"(l)); return l; }
__device__ __forceinline__ int launder_s(int v) { asm volatile("" : "+s"(v)); return v; }
struct Args { const float* in[21]; float* out; unsigned char* ws; };
enum { I_X = 0, I_C, I_CTX, I_CCTX, I_WADA, I_BADA, I_GN1, I_WIN, I_BIN, I_GQ, I_GK, I_GMH, I_GV, I_WSP, I_BSP, I_WOUT, I_GN2, I_WUP, I_CONVW, I_CONVB, I_WDOWN };

__device__ __forceinline__ int win_src_col(int n) {
    if (n >= NPROJ) return n < NPROJ + 16 ? 1792 + (n - NPROJ) : -1;
    const int pn = n >> 8, c = n & 255, bj = c >> 7, wc = (c >> 5) & 3, j = c & 31;
    if (pn < 2 || (pn == 2 && wc < 2)) { const int hb = pn < 2 ? (4 * pn + wc) * 64 : 512 + wc * 64; return hb + 32 * bj + 16 * ((j >> 2) & 1) + 4 * (j >> 3) + (j & 3); }
    if (pn == 2) return 640 + 64 * (wc - 2) + 32 * bj + j;
    return n + (n >= 1792 ? 16 : 0);
}
__device__ __forceinline__ void p0_transpose_item(const float* W, int ldw, int K, bf16* WT, int k0, int src_col_lane, int dst_row0, float* scr, int lane) {
#pragma unroll 16
    for (int i = 0; i < 32; ++i) { const int kk = 2 * i + (lane >> 5); scr[kk * 33 + (lane & 31)] = W[(size_t)(k0 + kk) * ldw + src_col_lane]; }
    asm volatile("s_waitcnt lgkmcnt(0)" ::: "memory");
    const int c = lane & 7;
#pragma unroll
    for (int j = 0; j < 4; ++j) { const int n = (lane >> 3) + 8 * j; const float* s = scr + (8 * c) * 33 + n;
        u32x4 o; o.x = pk2(s[0 * 33], s[1 * 33]); o.y = pk2(s[2 * 33], s[3 * 33]); o.z = pk2(s[4 * 33], s[5 * 33]); o.w = pk2(s[6 * 33], s[7 * 33]);
        *(u32x4*)(WT + (size_t)(dst_row0 + n) * K + k0 + 8 * c) = o; }
    asm volatile("s_waitcnt lgkmcnt(0)" ::: "memory");
}

__device__ __forceinline__ void p0_prologue(const Args& a, unsigned char* lds, int tid, int lane, int wave, int G) {
    unsigned char* ws = a.ws;
    {
        float* scr = (float*)(lds + wave * 16384);
        const int gw = blockIdx.x * NWAVES + wave, NGW = G * NWAVES;
        constexpr int I_IN = 16 * 73, I_OUT = 16 * 32, I_UP = 16 * 176, I_DN = 44 * 32, I_L = I_IN + I_OUT + I_UP + I_DN;
        for (int it = gw; it < DEPTH * I_L; it += NGW) {
            const int l = it / I_L; int r = it % I_L;
            if (r < I_IN) { const int kb = r / 73, nb = r % 73, n0 = 32 * nb;
                p0_transpose_item(a.in[I_WIN] + (size_t)l * DM * DIN, DIN, DM, (bf16*)(ws + WS_WIN) + (size_t)l * NPROJP * DM, 64 * kb, max(win_src_col(n0 + (lane & 31)), 0), n0, scr, lane); continue; } r -= I_IN;
            if (r < I_OUT) { const int kb = r / 32, nb = r % 32;
                p0_transpose_item(a.in[I_WOUT] + (size_t)l * DM * DM, DM, DM, (bf16*)(ws + WS_WOUT) + (size_t)l * DM * DM, 64 * kb, 32 * nb + (lane & 31), 32 * nb, scr, lane); continue; } r -= I_OUT;
            if (r < I_UP) { const int kb = r / 176, nb = r % 176;
                const int n0 = 32 * nb, src = ((n0 >> 7) & 1) * DFF + (n0 >> 8) * 128 + (n0 & 127);
                p0_transpose_item(a.in[I_WUP] + (size_t)l * DM * 2 * DFF, 2 * DFF, DM, (bf16*)(ws + WS_WUP) + (size_t)l * 2 * DFF * DM, 64 * kb, src + (lane & 31), n0, scr, lane); continue; } r -= I_UP;
            { const int kb = r / 32, nb = r % 32;
                p0_transpose_item(a.in[I_WDOWN] + (size_t)l * DFF * DM, DM, DFF, (bf16*)(ws + WS_WDOWN) + (size_t)l * DM * DFF, 64 * kb, 32 * nb + (lane & 31), 32 * nb, scr, lane); }
        }
        for (int i = blockIdx.x * NTHREADS + tid; i < 1024; i += G * NTHREADS) { const int pos = i >> 4, f = i & 15; const float inv = powf(10000.f, -(float)f / 16.f); float sn_, cs_; sincosf((float)pos * inv, &sn_, &cs_);
            ((float*)(ws + WS_ROPE))[i] = cs_; ((float*)(ws + WS_ROPE))[1024 + i] = sn_; }
        for (int i = blockIdx.x * NTHREADS + tid; i < DEPTH * 224 * (DM / 8); i += G * NTHREADS) { const int l = i / (224 * 128), r2 = (i / 128) % 224, c8 = (i % 128) * 8;
            *(u32x4*)((bf16*)(ws + WS_WIN) + ((size_t)l * NPROJP + 2336 + r2) * DM + c8) = (u32x4){0u, 0u, 0u, 0u}; }
    }
    __syncthreads();
    {
        float* sc = (float*)lds;
        float* red = (float*)(lds + 73728);
        for (int i = tid; i < 17 * DM; i += NTHREADS) { const int bi = i >> 10, k = i & 1023; const float v = bi < 16 ? a.in[I_C][bi * DM + k] : a.in[I_CCTX][k]; sc[i] = silu_f(v); }
        __syncthreads();
        float* mod = (float*)(ws + WS_MOD);
        const int cl = tid & 31, kp = tid >> 5;
        for (int grp = blockIdx.x; grp < DEPTH * 192; grp += G) {
            const int l = grp / 192, col = (grp % 192) * 32 + cl;
            const float* w = a.in[I_WADA] + (size_t)l * DM * 6144 + col;
            float acc[17];
#pragma unroll
            for (int b = 0; b < 17; ++b) acc[b] = 0.f;
#pragma unroll 4
            for (int k = kp * 64; k < kp * 64 + 64; ++k) { const float wv = w[(size_t)k * 6144];
#pragma unroll
                for (int b = 0; b < 17; ++b) acc[b] += sc[b * DM + k] * wv; }
#pragma unroll
            for (int b = 0; b < 17; ++b) red[(kp * 17 + b) * 32 + cl] = acc[b];
            __syncthreads();
            for (int i = tid; i < 17 * 32; i += NTHREADS) { const int b = i >> 5, c2 = i & 31; float s = 0.f;
#pragma unroll
                for (int p = 0; p < 16; ++p) s += red[(p * 17 + b) * 32 + c2];
                const int cc = (grp % 192) * 32 + c2; mod[((size_t)l * 17 + b) * 6144 + cc] = s + a.in[I_BADA][l * 6144 + cc]; }
            __syncthreads();
        }
    }
}

template <bool GATES>
__device__ __forceinline__ void norm_phase(const float* xl, const float* xc, const float* gnorm, const float* modl, int sh_off, int s_off, bf16* H, int nrows,
                                           const float* w_in_l, const float* b_in_l, float* gates, unsigned char* lds, int tid, int lane, int wave, int G) {
    float* wg = (float*)lds;
    if (GATES) {
        for (int idx = tid; idx < 16384; idx += NTHREADS) { const int k = idx >> 4, g = idx & 15; const int slot = ((k & 255) >> 2) + 64 * (4 * (k >> 8) + (k & 3));
            wg[slot * 20 + g] = w_in_l[(size_t)k * DIN + 1792 + g]; }
        __syncthreads();
    }
    const int gw = blockIdx.x * NWAVES + wave, NGW = G * NWAVES;
    f32x4 gn[4];
#pragma unroll
    for (int j = 0; j < 4; ++j) gn[j] = *(const f32x4*)(gnorm + 4 * lane + 256 * j);
    for (int r = gw; r < nrows; r += NGW) {
        const bool isctx = r >= ML; const int bi = isctx ? 16 : (r >> 11);
        const float* xr = isctx ? xc + (size_t)(r - ML) * DM : xl + (size_t)r * DM;
        f32x4 v[4]; float ss = 0.f;
#pragma unroll
        for (int j = 0; j < 4; ++j) { v[j] = *(const f32x4*)(xr + 4 * lane + 256 * j); ss += (v[j].x * v[j].x + v[j].y * v[j].y) + (v[j].z * v[j].z + v[j].w * v[j].w); }
        const float rstd = rsqrtf(wave_sum(ss, lane) * (1.f / DM) + EPS);
        const float* mv = modl + bi * 6144;
        bf16* hr = H + (size_t)r * DM;
#pragma unroll
        for (int j = 0; j < 4; ++j) {
            const f32x4 sv = *(const f32x4*)(mv + s_off + 4 * lane + 256 * j), sh = *(const f32x4*)(mv + sh_off + 4 * lane + 256 * j);
            v[j] = v[j] * rstd * gn[j] * (1.f + sv) + sh;
            u32x2 o; o.x = pk2(v[j].x, v[j].y); o.y = pk2(v[j].z, v[j].w);
            *(u32x2*)(hr + 4 * lane + 256 * j) = o;
        }
        if (GATES) {
            f32x4 ga[4];
#pragma unroll
            for (int q = 0; q < 4; ++q) ga[q] = (f32x4){0.f, 0.f, 0.f, 0.f};
#pragma unroll
            for (int j = 0; j < 4; ++j)
#pragma unroll
                for (int e = 0; e < 4; ++e) { const float hv = v[j][e]; const float* wp = wg + (lane + 64 * (4 * j + e)) * 20;
#pragma unroll
                    for (int q = 0; q < 4; ++q) ga[q] += hv * *(const f32x4*)(wp + 4 * q);
                    if (e & 1) asm volatile("" ::: "memory"); }
#pragma unroll
            for (int q = 0; q < 4; ++q)
#pragma unroll
                for (int e = 0; e < 4; ++e) ga[q][e] = wave_sum(ga[q][e], lane);
            if (lane == 0) {
#pragma unroll
                for (int q = 0; q < 4; ++q) *(f32x4*)(gates + (size_t)r * 16 + 4 * q) = ga[q] + *(const f32x4*)(b_in_l + 1792 + 4 * q);
            }
        }
    }
}

__device__ __forceinline__ void shw_phase(const Args& a, unsigned char* lds, int tid, int G) {
    unsigned char* ws = a.ws;
    float* sc = (float*)lds;
    float* red = (float*)(lds + 73728);
    const float* mod = (const float*)(ws + WS_MOD);
    const int cl = tid & 31, kp = tid >> 5;
    for (int grp = blockIdx.x; grp < DEPTH * 256; grp += G) {
        const int l = grp >> 8, r = grp & 255, which = r >= 80 ? 1 : 0, n0 = (which ? r - 80 : r) * 32;
        for (int i = tid; i < 17 * DM; i += NTHREADS) sc[i] = mod[((size_t)l * 17 + (i >> 10)) * 6144 + (which ? 3072 : 0) + (i & 1023)];
        __syncthreads();
        const float* W; int ldw, src; bool live = true;
        if (which == 0) { W = a.in[I_WIN] + (size_t)l * DM * DIN; ldw = DIN; src = win_src_col(n0 + cl); live = src >= 0; }
        else { W = a.in[I_WUP] + (size_t)l * DM * 2 * DFF; ldw = 2 * DFF; src = ((n0 >> 7) & 1) * DFF + (n0 >> 8) * 128 + (n0 & 127) + cl; }
        float acc[17];
#pragma unroll
        for (int b = 0; b < 17; ++b) acc[b] = 0.f;
        if (live) {
            const float* w = W + src;
#pragma unroll 4
            for (int k = kp * 64; k < kp * 64 + 64; ++k) { const float wv = w[(size_t)k * ldw];
#pragma unroll
                for (int b = 0; b < 17; ++b) acc[b] += sc[b * DM + k] * wv; }
        }
#pragma unroll
        for (int b = 0; b < 17; ++b) red[(kp * 17 + b) * 32 + cl] = acc[b];
        __syncthreads();
        for (int i = tid; i < 17 * 32; i += NTHREADS) { const int b = i >> 5, c2 = i & 31; float sum = 0.f;
#pragma unroll
            for (int p = 0; p < 16; ++p) sum += red[(p * 17 + b) * 32 + c2];
            const int n = n0 + c2;
            if (which == 0) { const int sc_ = win_src_col(n); const float bias = sc_ >= 0 ? a.in[I_BIN][l * DIN + sc_] : 0.f;
                ((float*)(ws + WS_SHW1))[((size_t)l * 17 + b) * NPROJP + n] = sum + bias; }
            else ((float*)(ws + WS_SHW2))[((size_t)l * 17 + b) * 2 * DFF + n] = sum; }
        __syncthreads();
    }
}

__device__ __forceinline__ void norm0_phase(const float* xl, const float* xc, const float* gnorm, const float* modl, int s_off, bf16* H, float* rowss, int tid, int lane, int wave, int G) {
    const int gw = blockIdx.x * NWAVES + wave, NGW = G * NWAVES;
    f32x4 gn[4];
#pragma unroll
    for (int j = 0; j < 4; ++j) gn[j] = *(const f32x4*)(gnorm + 4 * lane + 256 * j);
    for (int r = gw; r < MT; r += NGW) {
        const bool isctx = r >= ML; const int bi = isctx ? 16 : (r >> 11);
        const float* xr = isctx ? xc + (size_t)(r - ML) * DM : xl + (size_t)r * DM;
        f32x4 v[4]; float ss = 0.f;
#pragma unroll
        for (int j = 0; j < 4; ++j) { v[j] = *(const f32x4*)(xr + 4 * lane + 256 * j); ss += (v[j].x * v[j].x + v[j].y * v[j].y) + (v[j].z * v[j].z + v[j].w * v[j].w); }
        ss = wave_sum(ss, lane);
        const float* mv = modl + bi * 6144;
        bf16* hr = H + (size_t)r * DM;
#pragma unroll
        for (int j = 0; j < 4; ++j) {
            const f32x4 sv = *(const f32x4*)(mv + s_off + 4 * lane + 256 * j);
            v[j] = v[j] * gn[j] * (1.f + sv);
            u32x2 o; o.x = pk2(v[j].x, v[j].y); o.y = pk2(v[j].z, v[j].w);
            *(u32x2*)(hr + 4 * lane + 256 * j) = o;
        }
        if (lane == 0) rowss[r] = ss;
    }
}

__device__ __forceinline__ void ctxfin_phase(const float* xbase, float* xc, const float* slab, const float* g2c, const float* gn1n, const float* s1cn, bf16* Hctx, float* rowss_ctx, int lane, int wave, int G) {
    const int gw = blockIdx.x * NWAVES + wave, NGW = G * NWAVES;
    for (int r = gw; r < MC; r += NGW) {
        float* xr = xc + (size_t)r * DM; const float* xb = xbase + (size_t)r * DM; f32x4 v[4]; float ss = 0.f;
#pragma unroll
        for (int j = 0; j < 4; ++j) { const int c = 4 * lane + 256 * j; const float* sp = slab + (size_t)r * DM + c;
            const f32x4 sum = (*(const f32x4*)sp + *(const f32x4*)(sp + (size_t)MC * DM)) + (*(const f32x4*)(sp + (size_t)2 * MC * DM) + *(const f32x4*)(sp + (size_t)3 * MC * DM));
            v[j] = *(const f32x4*)(xb + c) + *(const f32x4*)(g2c + c) * sum; *(f32x4*)(xr + c) = v[j];
            ss += (v[j].x * v[j].x + v[j].y * v[j].y) + (v[j].z * v[j].z + v[j].w * v[j].w); }
        ss = wave_sum(ss, lane);
#pragma unroll
        for (int j = 0; j < 4; ++j) { const int c = 4 * lane + 256 * j; const f32x4 a = v[j] * *(const f32x4*)(gn1n + c) * (1.f + *(const f32x4*)(s1cn + c));
            u32x2 o; o.x = pk2(a.x, a.y); o.y = pk2(a.z, a.w); *(u32x2*)(Hctx + (size_t)r * DM + c) = o; }
        if (lane == 0) rowss_ctx[r] = ss;
    }
}

__device__ __forceinline__ int chunk_row(int b, int cf, int t) { return cf < 4 ? ML + b * CTXL + cf * 64 + t : b * SEQ + (cf - 4) * 64 + t; }

__device__ __forceinline__ void postproj_phase(bf16* proj, const float* gq, const float* gk, unsigned char* lds, int tid, int G, bf16* dryb = nullptr) {
    float* cs = (float*)lds; float* sn = cs + 1024;
    for (int i = tid; i < 1024; i += NTHREADS) { const int pos = i >> 4, f = i & 15; const float inv = powf(10000.f, -(float)f / 16.f); float s, c; sincosf((float)pos * inv, &s, &c); cs[i] = c; sn[i] = s; }
    __syncthreads();
    const int nth = G * NTHREADS, lane = tid & 63;
    for (int idx = blockIdx.x * NTHREADS + tid; idx < MT * 40; idx += nth) {
        const int j = idx & 3, hh = (idx >> 2) % 10, row = (idx >> 2) / 10;
        const int axis = j >> 1, fh = j & 1;
        const bool isq = hh < 8;
        bf16* p = proj + (size_t)row * NPROJ + (isq ? PC_Q + hh * 64 : PC_K + (hh - 8) * 64) + axis * 32 + fh * 8;
        const u32x4 r1 = *(const u32x4*)p, r2 = *(const u32x4*)(p + 16);
        float x1[8], x2[8];
#pragma unroll
        for (int e = 0; e < 4; ++e) { x1[2 * e] = bflo(r1[e]); x1[2 * e + 1] = bfhi(r1[e]); x2[2 * e] = bflo(r2[e]); x2[2 * e + 1] = bfhi(r2[e]); }
        float ss = 0.f;
#pragma unroll
        for (int e = 0; e < 8; ++e) ss += x1[e] * x1[e] + x2[e] * x2[e];
        ss += bperm(ss, lane ^ 1); ss += bperm(ss, lane ^ 2);
        const float rstd = rsqrtf(ss * (1.f / 64.f) + EPS);
        const float* g = isq ? gq : gk;
        const bool lat = row < ML;
        const int pos = row & (SEQ - 1); const int pa = axis == 0 ? (pos >> 6) : (pos & 63);
        const float sc = isq ? QSCALE : 1.f;
        float o1[8], o2[8];
#pragma unroll
        for (int e = 0; e < 8; ++e) {
            const float y1 = x1[e] * rstd * g[axis * 32 + fh * 8 + e], y2 = x2[e] * rstd * g[axis * 32 + 16 + fh * 8 + e];
            float c = 1.f, s = 0.f; if (lat) { c = cs[pa * 16 + fh * 8 + e]; s = sn[pa * 16 + fh * 8 + e]; }
            o1[e] = (y1 * c - y2 * s) * sc; o2[e] = (y2 * c + y1 * s) * sc;
        }
        u32x4 w1, w2;
#pragma unroll
        for (int e = 0; e < 4; ++e) { w1[e] = pk2(o1[2 * e], o1[2 * e + 1]); w2[e] = pk2(o2[2 * e], o2[2 * e + 1]); }
        bf16* pd = dryb ? dryb + (((size_t)idx * 32) & ((32u << 20) - 1)) : p;
        *(u32x4*)pd = w1; *(u32x4*)(pd + 16) = w2;
    }
    __syncthreads();
}

__device__ __forceinline__ void mlstm_local_phase(const bf16* proj, const float* gates, float* msc, float* msn, float* mss, unsigned char* lds, int tid, int lane, int wave, int G) {
    bf16* VT = (bf16*)lds;
    bf16* KF = VT + 64 * 72;
    bf16* KB_ = KF + 64 * 72;
    float* wv = (float*)(lds + 3 * 64 * 72 * 2);
    u32x4 pkr, pvr; float pig = 0.f, pfg = 0.f;
#define M1_ISSUE(T) do { const int cf_ = (T) % NCHUNK, h_ = ((T) / NCHUNK) & 3, b_ = (T) / (NCHUNK * 4); \
        const bf16* rp_ = proj + (size_t)chunk_row(b_, cf_, tid >> 3) * NPROJ + h_ * 64 + (tid & 7) * 8; pkr = *(const u32x4*)(rp_ + PC_KM); pvr = *(const u32x4*)(rp_ + PC_VM); \
        if (wave < 2) { const int row_ = chunk_row(b_, cf_, lane); pig = gates[(size_t)row_ * 16 + wave * 8 + h_]; pfg = gates[(size_t)row_ * 16 + wave * 8 + 4 + h_]; } } while (0)
    if ((int)blockIdx.x < NB * 4 * NCHUNK) M1_ISSUE((int)blockIdx.x);
    for (int task = blockIdx.x; task < NB * 4 * NCHUNK; task += G) {
        const int cf = task % NCHUNK, h = (task / NCHUNK) & 3, b = task / (NCHUNK * 4);
        const int sid0 = (b * 4 + h) * 2;
        if (wave < 2) {
            const float ig = pig, fg = pfg;
            const float ls = logsig(fg);
            float g, tot;
            if (wave == 0) { const float inc = scan_add_fwd(ls, lane); tot = bperm(inc, 63); g = tot - inc + ig; }
            else { const float inc = scan_add_bwd(ls, lane); tot = bperm(inc, 0); g = tot - inc + ig; }
            const float ml = wave_max(g, lane);
            wv[wave * 64 + lane] = __expf(g - ml) * 0.125f;
            if (lane == 0) { const int c = wave == 0 ? cf : (cf < 4 ? 3 - cf : 39 - cf); const int si = (sid0 + wave) * NCHUNK + c; mss[si] = ml; mss[128 * NCHUNK + si] = tot; }
        }
        const int s = tid >> 3, d8 = (tid & 7) * 8;
        const u32x4 kr = pkr, vr = pvr;
        __syncthreads();
        if (task + G < NB * 4 * NCHUNK) M1_ISSUE(task + G);
        const float wf = wv[s], wb = wv[64 + s];
#pragma unroll
        for (int e = 0; e < 4; ++e) {
            const float k0 = bflo(kr[e]), k1 = bfhi(kr[e]);
            VT[(d8 + 2 * e) * 72 + s] = (bf16)(vr[e] & 0xffffu); VT[(d8 + 2 * e + 1) * 72 + s] = (bf16)(vr[e] >> 16);
            KF[(d8 + 2 * e) * 72 + s] = (bf16)f2bf(k0 * wf); KF[(d8 + 2 * e + 1) * 72 + s] = (bf16)f2bf(k1 * wf);
            KB_[(d8 + 2 * e) * 72 + s] = (bf16)f2bf(k0 * wb); KB_[(d8 + 2 * e + 1) * 72 + s] = (bf16)f2bf(k1 * wb);
        }
        __syncthreads();
        const int cb = cf < 4 ? 3 - cf : 39 - cf;
        if (tid < 128) { const int dk = tid & 63, dir = tid >> 6; const bf16* kp = (dir ? KB_ : KF) + dk * 72; float sum = 0.f;
#pragma unroll 8
            for (int ss = 0; ss < 64; ++ss) sum += bf2f(kp[ss]);
            msn[((size_t)(sid0 + dir) * NCHUNK + (dir ? cb : cf)) * 64 + dk] = sum; }
        const int mt = wave >> 1, nt0 = 2 * (wave & 1);
#pragma unroll
        for (int dir = 0; dir < 2; ++dir) {
            bf16* dst = (bf16*)msc + ((size_t)(sid0 + dir) * NCHUNK + (dir ? cb : cf)) * 4096;
#pragma unroll
            for (int j = 0; j < 2; ++j) {
                const f32x4 acc = mma16(dir ? KB_ : KF, 72, VT, 72, 64, mt, nt0 + j, lane, (f32x4){0.f, 0.f, 0.f, 0.f});
                u32x2 o; o.x = pk2(acc[0], acc[1]); o.y = pk2(acc[2], acc[3]);
                *(u32x2*)(dst + (16 * (nt0 + j) + (lane & 15)) * 64 + 16 * mt + 4 * (lane >> 4)) = o;
            }
        }
        __syncthreads();
    }
}

__device__ __forceinline__ void mlstm_scan_phase(float* msc, float* msn, float* mss, bf16* dstc, float* dstn, float* dstm, int tid, int G) {
    const float* mloc = mss; const float* Gd = mss + 128 * NCHUNK; float* mprev = dstm;
    for (int w = blockIdx.x * NTHREADS + tid; w < 128 * 1024; w += G * NTHREADS) {
        const int sid = w >> 10, e4 = w & 1023;
        const u32x2* cp = (const u32x2*)((const bf16*)msc + (size_t)sid * NCHUNK * 4096) + e4;
        f32x4* np = (f32x4*)(msn + (size_t)sid * NCHUNK * 64) + (e4 & 15);
        u32x2* cpd = (u32x2*)(dstc + (size_t)sid * NCHUNK * 4096) + e4; f32x4* npd = (f32x4*)(dstn + (size_t)sid * NCHUNK * 64) + (e4 & 15);
        const bool don = e4 < 16;
        float m = 0.f; f32x4 C = (f32x4){0.f, 0.f, 0.f, 0.f}, N = C;
#pragma unroll 12
        for (int c = 0; c < NCHUNK; ++c) {
            const u32x2 sw_ = cp[(size_t)c * 1024]; const f32x4 S = (f32x4){bflo(sw_.x), bfhi(sw_.x), bflo(sw_.y), bfhi(sw_.y)};
            f32x4 nl = (f32x4){0.f, 0.f, 0.f, 0.f}; if (don) nl = np[c * 16];
            const float gd = Gd[sid * NCHUNK + c], ml = mloc[sid * NCHUNK + c];
            { u32x2 cw_; cw_.x = pk2(C.x, C.y); cw_.y = pk2(C.z, C.w); cpd[(size_t)c * 1024] = cw_; }
            if (don) npd[c * 16] = N;
            if (e4 == 0) mprev[sid * NCHUNK + c] = m;
            const float mn = fmaxf(gd + m, ml); const float aa = __expf(gd + m - mn), bb = __expf(ml - mn);
            C = aa * C + bb * S; N = aa * N + bb * nl; m = mn;
        }
    }
}

__device__ __forceinline__ void mlstm_out_phase(const bf16* proj, const float* gates, const bf16* cpb, const float* msn, const float* mss, const float* gmh, bf16* mix, bool need_ctx,
                                                unsigned char* lds, int tid, int lane, int wave, int G) {
    bf16* QS = (bf16*)lds;
    bf16* KS = QS + 64 * 72;
    bf16* AX = (bf16*)(lds + 18432);
    bf16* BX = (bf16*)(lds + 44032);
    float* vec = (float*)(lds + 69632);
    float* HS = (float*)lds;
    float* bm = vec, *us = vec + 128, *wi = vec + 256, *emt = vec + 384, *qn = vec + 512, *dsum = vec + 640, *rr = vec + 768, *al = vec + 896, *nv = vec + 1024;
    const float* mprev = mss + 2 * 128 * NCHUNK;
    const int c0 = need_ctx ? 0 : 4, nper = NCHUNK - c0;
    u32x4 pq, pk, pv, po, pcf, pcb; float pig = 0.f, pfg = 0.f, pmp = 0.f, pn0 = 0.f, pn1 = 0.f;
#define M3_ISSUE(T) do { const int cf_ = c0 + (T) % nper, h_ = ((T) / nper) & 3, b_ = (T) / (nper * 4); const int cb2_ = cf_ < 4 ? 3 - cf_ : 39 - cf_; const int s_ = tid >> 3, d8_ = (tid & 7) * 8; \
        const bf16* rp_ = proj + (size_t)chunk_row(b_, cf_, s_) * NPROJ + h_ * 64 + d8_; pq = *(const u32x4*)(rp_ + PC_QM); pk = *(const u32x4*)(rp_ + PC_KM); pv = *(const u32x4*)(rp_ + PC_VM); po = *(const u32x4*)(rp_ + PC_OM); \
        { const size_t stf_ = (size_t)((b_ * 4 + h_) * 2) * NCHUNK + cf_, stb_ = (size_t)((b_ * 4 + h_) * 2 + 1) * NCHUNK + cb2_; \
          if (wave < 2) { const int row_ = chunk_row(b_, cf_, lane); pig = gates[(size_t)row_ * 16 + wave * 8 + h_]; pfg = gates[(size_t)row_ * 16 + wave * 8 + 4 + h_]; pmp = mprev[wave == 0 ? stf_ : stb_]; } \
          else if (wave == 3) { pn0 = msn[stf_ * 64 + lane]; pn1 = msn[stb_ * 64 + lane]; } } \
        pcf = *(const u32x4*)(cpb + ((size_t)((b_ * 4 + h_) * 2) * NCHUNK + cf_) * 4096 + s_ * 64 + d8_); pcb = *(const u32x4*)(cpb + ((size_t)((b_ * 4 + h_) * 2 + 1) * NCHUNK + cb2_) * 4096 + s_ * 64 + d8_); } while (0)
    if ((int)blockIdx.x < NB * 4 * nper) M3_ISSUE((int)blockIdx.x);
    for (int task = blockIdx.x; task < NB * 4 * nper; task += G) {
        const int cf = c0 + task % nper, h = (task / nper) & 3, b = task / (nper * 4);
        const int cb = cf < 4 ? 3 - cf : 39 - cf;
        const int sid0 = (b * 4 + h) * 2;
        const size_t stf = (size_t)sid0 * NCHUNK + cf, stb = (size_t)(sid0 + 1) * NCHUNK + cb;
        if (wave < 2) {
            const float ig = pig, fg = pfg;
            const float ls = logsig(fg);
            float inc, rmax; const float mp = pmp;
            if (wave == 0) { inc = scan_add_fwd(ls, lane); rmax = scan_max_fwd(ig - inc, lane); }
            else { inc = scan_add_bwd(ls, lane); rmax = scan_max_bwd(ig - inc, lane); }
            const float minter = inc + mp, mt_ = fmaxf(minter, inc + rmax);
            bm[wave * 64 + lane] = inc - mt_; us[wave * 64 + lane] = ig - inc; wi[wave * 64 + lane] = __expf(minter - mt_); emt[wave * 64 + lane] = __expf(-mt_);
        } else if (wave == 2) { dsum[lane] = 0.f; dsum[64 + lane] = 0.f; }
        else if (wave == 3) { nv[lane] = pn0; nv[64 + lane] = pn1; }
        const u32x4 ov = po;
        {
            const int s = tid >> 3, d8 = (tid & 7) * 8;
            const u32x4 qr = pq, kr = pk, vr = pv;
            *(u32x4*)(QS + s * 72 + d8) = qr; *(u32x4*)(KS + s * 72 + d8) = kr;
#pragma unroll
            for (int e = 0; e < 4; ++e) { BX[(d8 + 2 * e) * 200 + s] = (bf16)(vr[e] & 0xffffu); BX[(d8 + 2 * e + 1) * 200 + s] = (bf16)(vr[e] >> 16); }
            *(u32x4*)(BX + s * 200 + 64 + d8) = pcf; *(u32x4*)(BX + s * 200 + 128 + d8) = pcb;
        }
        __syncthreads();
        if (task + G < NB * 4 * nper) M3_ISSUE(task + G);
        if (tid < 128) { const int t = tid & 63, dir = tid >> 6; const bf16* qp = QS + t * 72; const float* np = nv + dir * 64; float sum = 0.f;
#pragma unroll 8
            for (int d = 0; d < 64; ++d) sum += bf2f(qp[d]) * np[d];
            qn[dir * 64 + t] = sum; }
        const int mt = wave >> 1, nt0 = 2 * (wave & 1);
        float Af[2][4], Ab[2][4];
#pragma unroll
        for (int j = 0; j < 2; ++j) {
            const f32x4 acc = mma16(QS, 72, KS, 72, 64, mt, nt0 + j, lane, (f32x4){0.f, 0.f, 0.f, 0.f});
            const int s = 16 * (nt0 + j) + (lane & 15);
            const float usf = us[s], usb = us[64 + s];
#pragma unroll
            for (int i = 0; i < 4; ++i) { const int t = 16 * mt + 4 * (lane >> 4) + i; const float sv = acc[i] * 0.125f;
                Af[j][i] = (s <= t) ? sv * __expf(bm[t] + usf) : 0.f;
                Ab[j][i] = (s >= t) ? sv * __expf(bm[64 + t] + usb) : 0.f; }
        }
#pragma unroll
        for (int i = 0; i < 4; ++i) {
            float pf = Af[0][i] + Af[1][i], pb = Ab[0][i] + Ab[1][i];
#pragma unroll
            for (int o = 1; o < 16; o <<= 1) { pf += bperm(pf, lane ^ o); pb += bperm(pb, lane ^ o); }
            if ((lane & 15) == 0) { const int t = 16 * mt + 4 * (lane >> 4) + i; atomicAdd(&dsum[t], pf); atomicAdd(&dsum[64 + t], pb); }
        }
        __syncthreads();
        if (tid < 128) { const float den = wi[tid] * qn[tid] + dsum[tid]; const float r = 1.f / fmaxf(fabsf(den), emt[tid]); rr[tid] = r; al[tid] = wi[tid] * r; }
        __syncthreads();
#pragma unroll
        for (int j = 0; j < 2; ++j) { const int s = 16 * (nt0 + j) + (lane & 15);
#pragma unroll
            for (int i = 0; i < 4; ++i) { const int t = 16 * mt + 4 * (lane >> 4) + i; AX[t * 200 + s] = (bf16)f2bf(Af[j][i] * rr[t] + Ab[j][i] * rr[64 + t]); } }
        {
            const int t = tid >> 3, d8 = (tid & 7) * 8; const u32x4 qv = *(const u32x4*)(QS + t * 72 + d8); const float af = al[t], ab = al[64 + t];
            u32x4 of, ob;
#pragma unroll
            for (int e = 0; e < 4; ++e) { const float lo = bflo(qv[e]), hi = bfhi(qv[e]); of[e] = pk2(lo * af, hi * af); ob[e] = pk2(lo * ab, hi * ab); }
            *(u32x4*)(AX + t * 200 + 64 + d8) = of; *(u32x4*)(AX + t * 200 + 128 + d8) = ob;
        }
        __syncthreads();
#pragma unroll
        for (int j = 0; j < 2; ++j) {
            const f32x4 acc = mma16(AX, 200, BX, 200, 192, mt, nt0 + j, lane, (f32x4){0.f, 0.f, 0.f, 0.f});
#pragma unroll
            for (int i = 0; i < 4; ++i) HS[(16 * mt + 4 * (lane >> 4) + i) * 68 + 16 * (nt0 + j) + (lane & 15)] = acc[i];
        }
        __syncthreads();
        {
            const int t = tid >> 3, c8 = (tid & 7) * 8; const int row = chunk_row(b, cf, t);
            const f32x4 v0 = *(const f32x4*)(HS + t * 68 + c8), v1 = *(const f32x4*)(HS + t * 68 + c8 + 4);
            float ss = (v0.x * v0.x + v0.y * v0.y) + (v0.z * v0.z + v0.w * v0.w) + (v1.x * v1.x + v1.y * v1.y) + (v1.z * v1.z + v1.w * v1.w);
            ss += bperm(ss, lane ^ 1); ss += bperm(ss, lane ^ 2); ss += bperm(ss, lane ^ 4);
            const float rstd = rsqrtf(ss * (1.f / 64.f) + EPS);
            const f32x4 g0 = *(const f32x4*)(gmh + h * 64 + c8), g1 = *(const f32x4*)(gmh + h * 64 + c8 + 4);
            u32x4 w;
            w.x = pk2(sigmoid_f(bflo(ov.x)) * v0.x * rstd * g0.x, sigmoid_f(bfhi(ov.x)) * v0.y * rstd * g0.y);
            w.y = pk2(sigmoid_f(bflo(ov.y)) * v0.z * rstd * g0.z, sigmoid_f(bfhi(ov.y)) * v0.w * rstd * g0.w);
            w.z = pk2(sigmoid_f(bflo(ov.z)) * v1.x * rstd * g1.x, sigmoid_f(bfhi(ov.z)) * v1.y * rstd * g1.y);
            w.w = pk2(sigmoid_f(bflo(ov.w)) * v1.z * rstd * g1.z, sigmoid_f(bfhi(ov.w)) * v1.w * rstd * g1.w);
            *(u32x4*)(mix + (size_t)row * DM + 512 + h * 64 + c8) = w;
        }
        __syncthreads();
    }
}

__device__ __forceinline__ void cmlp_phase(const bf16* proj, const float* wsp, const float* bsp, const float* gv, bf16* mix, bool need_ctx, unsigned char* lds, int tid, int lane, int wave, int G) {
    bf16* WS_ = (bf16*)lds;
    bf16* VT = WS_ + 128 * 136;
    float* ZS = (float*)(lds + 52224);
    const int nsc = NB * 16 + (need_ctx ? NB * 2 : 0);
    const int g = blockIdx.x & 3;
    {
        const float* wp = wsp + (size_t)g * 128 * 128;
#pragma unroll 4
        for (int i = 0; i < 8; ++i) { const int idx4 = tid + NTHREADS * i; const int p = idx4 >> 5, q4 = (idx4 & 31) * 4; const f32x4 wv = *(const f32x4*)(wp + p * 128 + q4);
            u32x2 o; o.x = pk2(wv.x, wv.y); o.y = pk2(wv.z, wv.w); *(u32x2*)(WS_ + p * 136 + q4) = o; }
    }
    u32x4 pr0, pr1, pu0, pu1;
#define CM_ISSUE(SC) do { const int row0_ = (SC) < NB * 16 ? (SC) * 128 : ML + ((SC) - NB * 16) * 128; const bf16* bp_ = proj + (size_t)(row0_ + (tid >> 2)) * NPROJ + g * 64 + (tid & 3) * 16; \
        pr0 = *(const u32x4*)(bp_ + PC_VC); pr1 = *(const u32x4*)(bp_ + PC_VC + 8); pu0 = *(const u32x4*)(bp_ + PC_UC); pu1 = *(const u32x4*)(bp_ + PC_UC + 8); } while (0)
    if ((int)(blockIdx.x >> 2) < nsc) CM_ISSUE((int)(blockIdx.x >> 2));
    for (int sc = blockIdx.x >> 2; sc < nsc; sc += G >> 2) {
        const int row0 = sc < NB * 16 ? sc * 128 : ML + (sc - NB * 16) * 128;
        const u32x4 u0 = pu0, u1 = pu1;
        {
            const int q = tid >> 2, part = tid & 3;
            const u32x4 r0 = pr0, r1 = pr1;
            float x[16];
#pragma unroll
            for (int e = 0; e < 4; ++e) { x[2 * e] = gelu_tanh(bflo(r0[e])); x[2 * e + 1] = gelu_tanh(bfhi(r0[e])); x[8 + 2 * e] = gelu_tanh(bflo(r1[e])); x[8 + 2 * e + 1] = gelu_tanh(bfhi(r1[e])); }
            float ss = 0.f;
#pragma unroll
            for (int e = 0; e < 16; ++e) ss += x[e] * x[e];
            ss += bperm(ss, lane ^ 1); ss += bperm(ss, lane ^ 2);
            const float rstd = rsqrtf(ss * (1.f / 64.f) + EPS);
#pragma unroll
            for (int e = 0; e < 16; ++e) VT[(part * 16 + e) * 136 + q] = (bf16)f2bf(x[e] * rstd * gv[g * 64 + part * 16 + e]);
        }
        __syncthreads();
        if (sc + (G >> 2) < nsc) CM_ISSUE(sc + (G >> 2));
#pragma unroll
        for (int nt = 0; nt < 4; ++nt) {
            const f32x4 acc = mma16(WS_, 136, VT, 136, 128, wave, nt, lane, (f32x4){0.f, 0.f, 0.f, 0.f});
            const int d = 16 * nt + (lane & 15);
#pragma unroll
            for (int i = 0; i < 4; ++i) { const int p = 16 * wave + 4 * (lane >> 4) + i; ZS[p * 68 + d] = acc[i] + bsp[g * 128 + p]; }
        }
        __syncthreads();
        {
            const int p = tid >> 2, part = tid & 3;
            const float* zp = ZS + p * 68 + part * 16;
            const f32x4 z0 = *(const f32x4*)zp, z1 = *(const f32x4*)(zp + 4), z2 = *(const f32x4*)(zp + 8), z3 = *(const f32x4*)(zp + 12);
            u32x4 o0, o1;
            o0.x = pk2(gelu_tanh(bflo(u0.x)) * z0.x, gelu_tanh(bfhi(u0.x)) * z0.y); o0.y = pk2(gelu_tanh(bflo(u0.y)) * z0.z, gelu_tanh(bfhi(u0.y)) * z0.w);
            o0.z = pk2(gelu_tanh(bflo(u0.z)) * z1.x, gelu_tanh(bfhi(u0.z)) * z1.y); o0.w = pk2(gelu_tanh(bflo(u0.w)) * z1.z, gelu_tanh(bfhi(u0.w)) * z1.w);
            o1.x = pk2(gelu_tanh(bflo(u1.x)) * z2.x, gelu_tanh(bfhi(u1.x)) * z2.y); o1.y = pk2(gelu_tanh(bflo(u1.y)) * z2.z, gelu_tanh(bfhi(u1.y)) * z2.w);
            o1.z = pk2(gelu_tanh(bflo(u1.z)) * z3.x, gelu_tanh(bfhi(u1.z)) * z3.y); o1.w = pk2(gelu_tanh(bflo(u1.w)) * z3.z, gelu_tanh(bfhi(u1.w)) * z3.w);
            bf16* op = mix + (size_t)(row0 + p) * DM + 768 + g * 64 + part * 16;
            *(u32x4*)op = o0; *(u32x4*)(op + 8) = o1;
        }
    }
    __syncthreads();
}

__device__ __forceinline__ void convfix_items(const float* edge, bf16* act, const float* cw, const float* cb, int i_begin, int i_end, int i_stride) {
    for (int idx = i_begin; idx < i_end; idx += i_stride) {
        const int ei = idx / 704, f = (idx % 704) * 4, side = ei & 1, row = (ei >> 1) * 64 + (side ? 63 : 0);
        const int pos = row < ML ? (row & (SEQ - 1)) : ((row - ML) & (CTXL - 1)), slen = row < ML ? SEQ : CTXL;
        const float* ep = edge + (size_t)ei * 4 * DFF + f;
        f32x4 g = *(const f32x4*)ep, v = *(const f32x4*)(ep + DFF);
        if (side == 0 && pos != 0) { const float* nb = edge + (size_t)(ei - 1) * 4 * DFF + f;
            g += *(const f32x4*)(cw + f) * *(const f32x4*)(nb + 2 * DFF); v += *(const f32x4*)(cw + DFF + f) * *(const f32x4*)(nb + 3 * DFF); }
        if (side == 1 && pos != slen - 1) { const float* nb = edge + (size_t)(ei + 1) * 4 * DFF + f;
            g += *(const f32x4*)(cw + 4 * DFF + f) * *(const f32x4*)(nb + 2 * DFF); v += *(const f32x4*)(cw + 5 * DFF + f) * *(const f32x4*)(nb + 3 * DFF); }
        u32x2 o; o.x = pk2(silu_f(g.x) * v.x, silu_f(g.y) * v.y); o.y = pk2(silu_f(g.z) * v.z, silu_f(g.w) * v.w);
        *(u32x2*)(act + (size_t)row * DFF + f) = o;
    }
}

typedef const Args __attribute__((address_space(4)))* KArgsP;
__device__ __forceinline__ KArgsP kargs() { KArgsP p = (KArgsP)__builtin_amdgcn_kernarg_segment_ptr(); asm volatile("" : "+s"(p)); return p; }
constexpr int MISC_OFF = RING_BYTES + 320;
#define GRID_BAR() do { XcdBarrier xb_; xb_.bar = (unsigned*)(kargs()->ws + WS_CTL) + 4096; xb_.x = xb_xcc_id(); xb_.st = (volatile LAS unsigned*)((PG8_LAS unsigned char*)lds + MISC_OFF) + 8; xcd_barrier(xb_); if (PROBE & 1024) xcd_barrier(xb_); } while (0)
#ifndef PROBE
#define PROBE 0
#endif
#define NDUP(bit) ((PROBE & (bit)) ? 2 : 1)
#define FRESH() const int lane = fresh_lane(), wave = launder_s(wave0), tid = (wave << 6) | lane, G = launder_s(G0); (void)lane; (void)wave; (void)tid; (void)G
#define ENV() KArgsP ap = kargs(); unsigned char* const ws = ap->ws; float* const out = ap->out; \
    float* const mod = (float*)(ws + WS_MOD); float* const xc = (float*)(ws + WS_XC); bf16* const Hb = (bf16*)(ws + WS_H); bf16* const proj = (bf16*)(ws + WS_PROJ); \
    float* const gates = (float*)(ws + WS_GATES); float* const rowss1 = (float*)(ws + WS_ROWSS); float* const rowss2 = rowss1 + MT; bf16* const mix = (bf16*)(ws + WS_MIX); \
    float* const msc = (float*)(ws + WS_MSC); float* const msn = (float*)(ws + WS_MSN); float* const mss = (float*)(ws + WS_MSS); bf16* const act = (bf16*)(ws + WS_ACT); float* const edge = (float*)(ws + WS_EDGE); \
    (void)out; (void)mod; (void)xc; (void)Hb; (void)proj; (void)gates; (void)rowss1; (void)rowss2; (void)mix; (void)msc; (void)msn; (void)mss; (void)act; (void)edge
#define IN(k) (ap->in[k])

__device__ __forceinline__ void layer_fwd(const int l, unsigned char* lds, PG8_LAS unsigned char* ldsl, const int wave0, const int G0) {
        const bool last = (l == DEPTH - 1);
        for (int rep_ = 0; rep_ < NDUP(2); ++rep_) {
            ENV();
            pg8::Gemm g{Hb, (const bf16*)(ws + WS_WIN) + (size_t)l * NPROJP * DM, MT, NPROJP, DM}; pg8::StaticOrder S; S.init(MT, NPROJP, launder_s(G0), (int)blockIdx.x);
            pg8::EpiProj E{proj, gates, (const float*)(ws + WS_SHW1) + (size_t)l * 17 * NPROJP, rowss1, IN(I_GQ) + l * 64, IN(I_GK) + l * 64, (const float*)(ws + WS_ROPE), QSCALE};
            { FRESH(); pg8::gemm_phase<pg8::EpiProj, pg8::StaticOrder, true, true>(ldsl, g, S, E, tid); }
        }
        GRID_BAR();
        { ENV(); FRESH(); for (int i = blockIdx.x * NTHREADS + tid; i < 2 * MT; i += G * NTHREADS) rowss1[i] = 0.f; }
        for (int rep_ = 0; rep_ < NDUP(4); ++rep_) { ENV(); FRESH(); mlstm_local_phase(proj, gates, msc, msn, mss, lds, tid, lane, wave, G); }
        GRID_BAR();
#if PROBE & 2048
        { ENV(); FRESH(); mlstm_scan_phase(msc, msn, mss, Hb, (float*)Hb + 16 * 1024 * 1024, (float*)Hb + 16 * 1024 * 1024, tid, G); }
#endif
        { ENV(); FRESH(); mlstm_scan_phase(msc, msn, mss, Hb, msn, mss + 2 * 128 * NCHUNK, tid, G); }
        for (int rep_ = 0; rep_ < NDUP(8); ++rep_) {
            ENV();
            FRESH();
            const int vcu = (G % 8 == 0) ? ((int)blockIdx.x % 8) * (G / 8) + (int)blockIdx.x / 8 : (int)blockIdx.x;
            const attn_body::bf16* P = (const attn_body::bf16*)proj; attn_body::bf16* O = (attn_body::bf16*)mix;
            for (int u = vcu; u < 1024; u += G) {
                const int b = u >> 6, hq = (u >> 3) & 7, qb = u & 7, kvh = hq >> 2;
                const size_t qrow = (size_t)b * SEQ + qb * 256, crow0 = (size_t)ML + b * CTXL, lrow0 = (size_t)b * SEQ;
                attn_body::attn_unit<8>(P + qrow * NPROJ + PC_Q + hq * 64, P + crow0 * NPROJ + PC_K + kvh * 64, P + crow0 * NPROJ + PC_V + kvh * 64,
                                        P + lrow0 * NPROJ + PC_K + kvh * 64, P + lrow0 * NPROJ + PC_V + kvh * 64, 36, O + qrow * DM + hq * 64, (char*)lds, tid);
            }
            if (!last) {
                for (int v = (G >= 128) ? (int)blockIdx.x - (G - 128) : (int)blockIdx.x; v < 128; v += G) {
                    if (v < 0) continue;
                    const int b = v >> 3, hq = v & 7, kvh = hq >> 2; const size_t crow0 = (size_t)ML + b * CTXL;
                    attn_body::attn_unit<8>(P + crow0 * NPROJ + PC_Q + hq * 64, P + crow0 * NPROJ + PC_K + kvh * 64, P + crow0 * NPROJ + PC_V + kvh * 64,
                                            P + crow0 * NPROJ + PC_K + kvh * 64, P + crow0 * NPROJ + PC_V + kvh * 64, 4, O + crow0 * DM + hq * 64, (char*)lds, tid);
                }
            }
            asm volatile("s_waitcnt vmcnt(0) lgkmcnt(0)" ::: "memory"); __syncthreads();
        }
        for (int rep_ = 0; rep_ < NDUP(16); ++rep_) { ENV(); FRESH(); cmlp_phase(proj, IN(I_WSP) + (size_t)l * 4 * 128 * 128, IN(I_BSP) + l * 4 * 128, IN(I_GV) + l * 256, mix, !last, lds, tid, lane, wave, G); }
        GRID_BAR();
        for (int rep_ = 0; rep_ < NDUP(32); ++rep_) { ENV(); FRESH(); mlstm_out_phase(proj, gates, Hb, msn, mss, IN(I_GMH) + l * 256, mix, !last, lds, tid, lane, wave, G); }
        GRID_BAR();
        {
            ENV();
            const float* modl = mod + (size_t)l * 17 * 6144;
            pg8::Gemm g{mix, (const bf16*)(ws + WS_WOUT) + (size_t)l * DM * DM, ML, DM, DM, 0}; pg8::StaticOrder S; S.init(ML, DM, launder_s(G0), (int)blockIdx.x);
            pg8::EpiRes2 E{l == 0 ? IN(I_X) : out, xc, out, xc, modl + 2048, Hb, IN(I_GN2) + l * DM, modl + 4096, rowss2};
            { FRESH(); pg8::gemm_phase<pg8::EpiRes2, pg8::StaticOrder, true, true>(ldsl, g, S, E, tid); }
#if PROBE & 1
            { pg8::EpiRes2 E2{out, xc, (float*)proj, (float*)proj + (size_t)ML * DM, modl + 2048, nullptr, nullptr, nullptr, nullptr}; FRESH(); pg8::gemm_phase<pg8::EpiRes2, pg8::StaticOrder, true, true>(ldsl, g, S, E2, tid); }
#endif
            if (!last) {
                FRESH();
                for (int v = blockIdx.x; v < 256; v += G) {
                    const int part = v >> 6, un = v & 63;
                    pg8::Gemm gc{mix + (size_t)ML * DM + part * 256, (const bf16*)(ws + WS_WOUT) + (size_t)l * DM * DM + part * 256, MC, DM, 256, DM};
                    pg8::SingleUnit Sc{un >> 2, un & 3};
                    pg8::EpiSlab Ec{(float*)proj + (size_t)part * MC * DM};
                    pg8::gemm_phase<pg8::EpiSlab, pg8::SingleUnit, true, true>(ldsl, gc, Sc, Ec, tid);
                }
            }
        }
        GRID_BAR();
        if (!last) {
            { ENV(); FRESH(); const float* modl = mod + (size_t)l * 17 * 6144;
              ctxfin_phase(l == 0 ? IN(I_CTX) : xc, xc, (const float*)proj, modl + 16 * 6144 + 2048, IN(I_GN2) + l * DM, modl + 16 * 6144 + 4096, Hb + (size_t)ML * DM, rowss2 + ML, lane, wave, G); }
            GRID_BAR();
        }
        for (int rep_ = 0; rep_ < NDUP(128); ++rep_) {
            ENV();
            const int Mo = last ? ML : MT;
            pg8::Gemm g{Hb, (const bf16*)(ws + WS_WUP) + (size_t)l * 2 * DFF * DM, Mo, 2 * DFF, DM}; pg8::StaticOrder S; S.init(Mo, 2 * DFF, launder_s(G0), (int)blockIdx.x);
            pg8::EpiConv E{act, edge, IN(I_CONVW) + (size_t)l * 3 * 2 * DFF, IN(I_CONVB) + (size_t)l * 2 * DFF, rowss2, (const float*)(ws + WS_SHW2) + (size_t)l * 17 * 2 * DFF};
            { FRESH(); pg8::gemm_phase<pg8::EpiConv, pg8::StaticOrder, true, true>(ldsl, g, S, E, tid); }
        }
        GRID_BAR();
        { ENV(); FRESH(); const int nit = ((last ? ML : MT) / 64) * 2 * 704; convfix_items(edge, act, IN(I_CONVW) + (size_t)l * 3 * 2 * DFF, IN(I_CONVB) + (size_t)l * 2 * DFF, blockIdx.x * NTHREADS + tid, nit, G * NTHREADS); }
        GRID_BAR();
        {
            ENV();
            const float* modl = mod + (size_t)l * 17 * 6144;
            pg8::Gemm g{act, (const bf16*)(ws + WS_WDOWN) + (size_t)l * DM * DFF, ML, DM, DFF, 0}; pg8::StaticOrder S; S.init(ML, DM, launder_s(G0), (int)blockIdx.x);
            pg8::EpiRes2 E{out, xc, out, xc, modl + 5120, last ? nullptr : Hb, IN(I_GN1) + (last ? 0 : (l + 1) * DM), modl + 17 * 6144 + 1024, rowss1};
            { FRESH(); pg8::gemm_phase<pg8::EpiRes2, pg8::StaticOrder, true, true>(ldsl, g, S, E, tid); }
#if PROBE & 64
            { pg8::EpiBf16<0> E2{(bf16*)(ws + WS_EDGE), 1024, nullptr, 0, 0, 1.f}; FRESH(); pg8::gemm_phase<pg8::EpiBf16<0>, pg8::StaticOrder, true, true>(ldsl, g, S, E2, tid); }
#endif
            if (!last) {
                FRESH();
                for (int v = blockIdx.x; v < 256; v += G) {
                    const int part = v >> 6, un = v & 63, kt0 = part == 0 ? 0 : (part == 1 ? 12 : (part == 2 ? 22 : 34)), ktn = (part & 1) ? 10 : 12;
                    pg8::Gemm gc{act + (size_t)ML * DFF + kt0 * 64, (const bf16*)(ws + WS_WDOWN) + (size_t)l * DM * DFF + kt0 * 64, MC, DM, ktn * 64, DFF};
                    pg8::SingleUnit Sc{un >> 2, un & 3};
                    pg8::EpiSlab Ec{(float*)(ws + WS_EDGE) + (size_t)part * MC * DM};
                    pg8::gemm_phase<pg8::EpiSlab, pg8::SingleUnit, true, true>(ldsl, gc, Sc, Ec, tid);
                }
            }
        }
        GRID_BAR();
        if (!last) {
            { ENV(); FRESH(); const float* modl = mod + (size_t)l * 17 * 6144;
              ctxfin_phase(xc, xc, (const float*)(ws + WS_EDGE), modl + 16 * 6144 + 5120, IN(I_GN1) + (l + 1) * DM, modl + 17 * 6144 + 16 * 6144 + 1024, Hb + (size_t)ML * DM, rowss1 + ML, lane, wave, G); }
            GRID_BAR();
        }
}

__global__ void __launch_bounds__(NTHREADS, 2) mega_fwd(Args args) {
    extern __shared__ __attribute__((aligned(16))) unsigned char lds[];
    cg::grid_group grid = cg::this_grid();
    int wave0_ = __builtin_amdgcn_readfirstlane((int)threadIdx.x >> 6); asm volatile("" : "+s"(wave0_)); const int wave0 = wave0_; const int G0 = gridDim.x;
    PG8_LAS unsigned char* ldsl = (PG8_LAS unsigned char*)lds;
    for (int u = threadIdx.x; u < 64; u += NTHREADS) ((LAS unsigned*)(ldsl + MISC_OFF))[u] = 0u;
    __syncthreads();
    (void)xcd_barrier_post((unsigned*)(args.ws + WS_CTL) + 4096, (volatile LAS unsigned*)(ldsl + MISC_OFF) + 8);

    { FRESH(); p0_prologue(args, lds, tid, lane, wave, G); }
#if PROBE & 256
    __syncthreads();
    { FRESH(); p0_prologue(args, lds, tid, lane, wave, G); }
#endif
    grid.sync();
    { FRESH(); shw_phase(args, lds, tid, G); }
#if PROBE & 512
    { FRESH(); shw_phase(args, lds, tid, G); }
#endif
    { ENV(); FRESH(); norm0_phase(IN(I_X), IN(I_CTX), IN(I_GN1), mod, 1024, Hb, rowss1, tid, lane, wave, G); }
    GRID_BAR();

#pragma nounroll
    for (int l = 0; l < DEPTH; ++l) layer_fwd(launder_s(l), lds, ldsl, wave0, G0);
}

extern "C" void kernel_launch(void* const* d_in, const int* in_sizes, int n_in, void* d_out, int out_size, void* d_ws, size_t ws_size, hipStream_t stream) {
    static int grid = 0;
    if (grid == 0) {
        if (n_in != 21 || out_size != ML * DM || ws_size < WS_END) { fprintf(stderr, "kernel_launch: unexpected problem (n_in %d out %d ws %zu)\n", n_in, out_size, ws_size); grid = -1; return; }
        int dev = 0, cus = 0, per_cu = 0;
        if (hipGetDevice(&dev) != hipSuccess || hipDeviceGetAttribute(&cus, hipDeviceAttributeMultiprocessorCount, dev) != hipSuccess) { grid = -1; return; }
        if (hipFuncSetAttribute((const void*)mega_fwd, hipFuncAttributeMaxDynamicSharedMemorySize, LDS_BYTES) != hipSuccess) { fprintf(stderr, "kernel_launch: hipFuncSetAttribute failed\n"); grid = -1; return; }
        if (hipOccupancyMaxActiveBlocksPerMultiprocessor(&per_cu, (const void*)mega_fwd, NTHREADS, LDS_BYTES) != hipSuccess || per_cu < 1) { fprintf(stderr, "kernel_launch: occupancy query says %d\n", per_cu); (void)hipGetLastError(); per_cu = 1; }
        grid = cus;
    }
    if (grid < 0) return;
    (void)hipMemsetAsync((char*)d_ws + WS_CTL, 0, CTL_ZERO_BYTES, stream);
    Args a{};
    for (int i = 0; i < 21; ++i) a.in[i] = (const float*)d_in[i];
    a.out = (float*)d_out; a.ws = (unsigned char*)d_ws;
    void* kargs[] = {&a};
    hipError_t e = hipLaunchCooperativeKernel((const void*)mega_fwd, dim3(grid), dim3(NTHREADS), kargs, LDS_BYTES, stream);
    if (e != hipSuccess) fprintf(stderr, "kernel_launch: cooperative launch failed: %s (grid %d)\n", hipGetErrorString(e), grid);
}
```

```cpp
#include <hip/hip_runtime.h>
#include <hip/hip_cooperative_groups.h>
#include <hip/hip_bf16.h>
#include <cstdio>
#include <cstdint>
#include <cmath>
namespace cg = cooperative_groups;
#define PROBE 0
namespace pg8 {
#define PG8_LAS __attribute__((address_space(3)))
typedef unsigned short bf16_t;
typedef short bf16x8 __attribute__((ext_vector_type(8)));
typedef float f32x4 __attribute__((ext_vector_type(4)));
typedef unsigned u32x4 __attribute__((ext_vector_type(4)));
constexpr int BM = 256, BK = 64, HALF = 128, HTB = HALF * BK * 2  , STAGE_BYTES = 8 * HTB, NXCD = 8, WGM = 8;

__host__ __device__ __forceinline__ int lds_byte(int r, int c) { const int st = (r >> 4) * 2 + (c >> 5), rr = r & 15, cc = c & 31, ob = rr * 64 + cc * 2; return st * 1024 + (ob ^ (((ob >> 9) & 1) << 5)); }
__host__ __device__ __forceinline__ void stage_rc(int b, int& R, int& C) { const int st = b / 1024, sb = b % 1024, swz = sb ^ (((sb >> 9) & 1) << 5); R = (st >> 1) * 16 + swz / 64; C = (st & 1) * 32 + (swz % 64) / 2; }
__host__ __device__ __forceinline__ int perm32(int rho) { const int n = rho >> 4, i = rho & 15; return 8 * (i >> 2) + 4 * n + (i & 3); }

struct Unit { int pm, pn; };
struct Gemm { const bf16_t* A; const bf16_t* Bt; int M, N, K; int ld; };

struct StaticOrder {
    int nM, nN, nwg, G, c;
    __host__ __device__ void init(int M, int N, int G_, int c_) { nM = M / BM; nN = N / BM; nwg = nM * nN; G = G_; c = c_; }
    __host__ __device__ bool next(int i, Unit& u) const {
        const long L = (long)i * G + c; if (L >= nwg) return false;
        int wgid = (int)L; { const int q = nwg / NXCD, r = nwg % NXCD, xcd = wgid % NXCD, off = wgid / NXCD; wgid = (xcd < r ? xcd * (q + 1) : r * (q + 1) + (xcd - r) * q) + off; }
        const int nig = WGM * nN, gid = wgid / nig, fm = gid * WGM, gsz = (nM - fm) < WGM ? (nM - fm) : WGM;
        u.pm = fm + ((wgid % nig) % gsz); u.pn = (wgid % nig) / gsz; return true;
    }
    __device__ __forceinline__ void a_ready(const Unit&) const {}
    __device__ __forceinline__ void done(const Unit&) const {}
};

__device__ __forceinline__ unsigned cvt_pk_bf16(float lo, float hi) { unsigned r; asm volatile("v_cvt_pk_bf16_f32 %0, %1, %2" : "=v"(r) : "v"(lo), "v"(hi)); return r; }
typedef float f32x2 __attribute__((ext_vector_type(2)));
__device__ __forceinline__ f32x2 gelu_pk(f32x2 v) {
    const f32x2 av = __builtin_elementwise_abs(v), d = av * 0.2316418882f + 1.0f;
    f32x2 t; t.x = __builtin_amdgcn_rcpf(d.x); t.y = __builtin_amdgcn_rcpf(d.y);
    f32x2 q = t * 0.5307027145f + (-0.7265760135f); q = q * t + 0.7107068705f; q = q * t + (-0.142248368f); q = q * t + 0.127414796f; q = q * t;
    const f32x2 s = (v * v) * (-0.72134752044f);
    f32x2 e; e.x = __builtin_amdgcn_exp2f(s.x); e.y = __builtin_amdgcn_exp2f(s.y);
    const f32x2 m = v * (q * e), r = v - m;
    f32x2 o; o.x = v.x < 0.f ? m.x : r.x; o.y = v.y < 0.f ? m.y : r.y; return o;
}

template <int ACT  > struct EpiBf16 {
    static constexpr bool PERM = true, AFTER_DRAIN = false; static_assert(ACT == 0 || ACT == 1, "EpiBf16: ACT is 0 (none) or 1 (gelu_pk)");
    bf16_t* O; int ldc; const float* bias; int split_cols; size_t split_stride; float scale0;
    __device__ __forceinline__ void operator()(const f32x4 (&acc)[2][2][4][2], const Unit& u, int wr, int wc, int fr, int fq) const {
        const int row0 = u.pm * BM + wr * 64 + fr; int colt = u.pn * BM; bf16_t* base = O;
        float sc = 1.f; if (split_cols) { const int t = colt / split_cols; base += (size_t)t * split_stride; colt -= t * split_cols; if (t == 0) sc = scale0; }
        const int col0 = colt + wc * 32 + 8 * fq, bcol0 = u.pn * BM + wc * 32 + 8 * fq;
        f32x4 bv[2][2];
#pragma unroll
        for (int bj = 0; bj < 2; ++bj)
#pragma unroll
            for (int n = 0; n < 2; ++n) bv[bj][n] = bias ? *(const f32x4*)(bias + bcol0 + bj * HALF + 4 * n) : (f32x4){0.f, 0.f, 0.f, 0.f};
#pragma unroll
        for (int ai = 0; ai < 2; ++ai)
#pragma unroll
            for (int m = 0; m < 4; ++m) { bf16_t* rowp = base + (size_t)(row0 + ai * HALF + m * 16) * ldc + col0;
#pragma unroll
                for (int bj = 0; bj < 2; ++bj) { f32x4 v0 = acc[ai][bj][m][0] + bv[bj][0], v1 = acc[ai][bj][m][1] + bv[bj][1];
                    if (ACT == 1) { f32x2 a = gelu_pk((f32x2){v0[0], v0[1]}), b = gelu_pk((f32x2){v0[2], v0[3]}), c = gelu_pk((f32x2){v1[0], v1[1]}), d = gelu_pk((f32x2){v1[2], v1[3]});
                        v0 = (f32x4){a.x, a.y, b.x, b.y}; v1 = (f32x4){c.x, c.y, d.x, d.y}; }
                    v0 = v0 * sc; v1 = v1 * sc; u32x4 w; w.x = cvt_pk_bf16(v0[0], v0[1]); w.y = cvt_pk_bf16(v0[2], v0[3]); w.z = cvt_pk_bf16(v1[0], v1[1]); w.w = cvt_pk_bf16(v1[2], v1[3]);
                    *(u32x4*)(rowp + bj * HALF) = w; } }
    }
};

struct EpiRes {
    static constexpr bool PERM = false, AFTER_DRAIN = false;
    const float* base_lat; const float* base_ctx; float* out_lat; float* out_ctx; const float* gvec; int row_off;
    __device__ __forceinline__ void operator()(const f32x4 (&acc)[2][2][4][2], const Unit& u, int wr, int wc, int fr, int fq) const {
        const int grow0 = row_off + u.pm * BM;
        const bool isctx = grow0 >= 32768;
        const int bi = isctx ? 16 : (grow0 >> 11);
        const float* base = isctx ? base_ctx + (size_t)(grow0 - 32768) * 1024 : base_lat + (size_t)grow0 * 1024;
        float* out = isctx ? out_ctx + (size_t)(grow0 - 32768) * 1024 : out_lat + (size_t)grow0 * 1024;
        const int col0 = u.pn * BM + wc * 32 + 4 * fq;
        const float* gv = gvec + bi * 6144 + col0;
        f32x4 g[2][2];
#pragma unroll
        for (int bj = 0; bj < 2; ++bj)
#pragma unroll
            for (int n = 0; n < 2; ++n) g[bj][n] = *(const f32x4*)(gv + bj * HALF + n * 16);
#pragma unroll
        for (int ai = 0; ai < 2; ++ai)
#pragma unroll
            for (int m = 0; m < 4; ++m) { const size_t off = (size_t)(ai * HALF + wr * 64 + m * 16 + fr) * 1024 + col0;
#pragma unroll
                for (int bj = 0; bj < 2; ++bj)
#pragma unroll
                    for (int n = 0; n < 2; ++n) { const f32x4 bs = *(const f32x4*)(base + off + bj * HALF + n * 16);
                        *(f32x4*)(out + off + bj * HALF + n * 16) = bs + g[bj][n] * acc[ai][bj][m][n]; }
                if (m & 1) asm volatile("" ::: "memory"); }
    }
};

template <int CTRL> __device__ __forceinline__ float dppf(float x) { return __builtin_bit_cast(float, __builtin_amdgcn_update_dpp(0, __builtin_bit_cast(int, x), CTRL, 0xf, 0xf, true)); }
template <int CTRL> __device__ __forceinline__ f32x4 dpp4(const f32x4 v) { f32x4 r; r.x = dppf<CTRL>(v.x); r.y = dppf<CTRL>(v.y); r.z = dppf<CTRL>(v.z); r.w = dppf<CTRL>(v.w); return r; }
__device__ __forceinline__ float silu_r(float x) { return x * __builtin_amdgcn_rcpf(1.f + __expf(-x)); }
struct EpiConv {
    static constexpr bool PERM = true, AFTER_DRAIN = false;
    bf16_t* act; float* edge; const float* cw; const float* cb; const float* rowss; const float* shw;
    __device__ __forceinline__ void operator()(const f32x4 (&acc)[2][2][4][2], const Unit& u, int wr, int wc, int fr_in, int fq_in) const {
        int fr = fr_in, fq = fq_in; asm volatile("" : "+v"(fr), "+v"(fq));
        const int f0 = u.pn * 128 + wc * 32 + 8 * fq;
        const int bi = (u.pm * BM >= 32768) ? 16 : ((u.pm * BM) >> 11);
        const float* sp = shw + (size_t)bi * 5632 + u.pn * BM + wc * 32 + 8 * fq;
        const int Rw = u.pm * BM + wr * 64;
        float rs[2][4];
#pragma unroll
        for (int ai = 0; ai < 2; ++ai)
#pragma unroll
            for (int m = 0; m < 4; ++m) rs[ai][m] = __builtin_amdgcn_rsqf(rowss[Rw + ai * HALF + 16 * m + fr] * (1.f / 1024.f) + 1e-6f);
        unsigned pk[2][2][4][2];
#pragma unroll
        for (int n = 0; n < 2; ++n) {
            const int f = f0 + 4 * n;
            const f32x4 w0g = *(const f32x4*)(cw + f), w1g = *(const f32x4*)(cw + 5632 + f), w2g = *(const f32x4*)(cw + 2 * 5632 + f), bg = *(const f32x4*)(cb + f);
            const f32x4 w0v = *(const f32x4*)(cw + 2816 + f), w1v = *(const f32x4*)(cw + 5632 + 2816 + f), w2v = *(const f32x4*)(cw + 2 * 5632 + 2816 + f), bv = *(const f32x4*)(cb + 2816 + f);
            const f32x4 sg = *(const f32x4*)(sp + 4 * n), sv = *(const f32x4*)(sp + HALF + 4 * n);
#pragma unroll
            for (int ai = 0; ai < 2; ++ai) {
                const int R0 = Rw + ai * HALF;
                f32x4 xg[4], xv[4];
#pragma unroll
                for (int m = 0; m < 4; ++m) { xg[m] = acc[ai][0][m][n] * rs[ai][m] + sg; xv[m] = acc[ai][1][m][n] * rs[ai][m] + sv; }
#pragma unroll
                for (int m = 0; m < 4; ++m) {
                    const f32x4 g = xg[m], v = xv[m];
                    f32x4 pg = dpp4<0x111>(g), pv = dpp4<0x111>(v), ng = dpp4<0x101>(g), nv = dpp4<0x101>(v);
                    if (m > 0) { pg += dpp4<0x10F>(xg[m - 1]); pv += dpp4<0x10F>(xv[m - 1]); }
                    if (m < 3) { ng += dpp4<0x11F>(xg[m + 1]); nv += dpp4<0x11F>(xv[m + 1]); }
                    const f32x4 cg = w0g * pg + w1g * g + w2g * ng + bg, cv = w0v * pv + w1v * v + w2v * nv + bv;
                    if ((m == 0 && fr == 0) || (m == 3 && fr == 15)) {
                        float* ep = edge + (size_t)((R0 >> 6) * 2 + (m == 3 ? 1 : 0)) * 8448 + f;
                        *(f32x4*)ep = cg; *(f32x4*)(ep + 2816) = cv;
                        bf16_t* rp = (bf16_t*)(ep - f + 2 * 2816) + f;
                        typedef unsigned u32x2e __attribute__((ext_vector_type(2))); u32x2e rg, rv; rg.x = cvt_pk_bf16(g.x, g.y); rg.y = cvt_pk_bf16(g.z, g.w); rv.x = cvt_pk_bf16(v.x, v.y); rv.y = cvt_pk_bf16(v.z, v.w);
                        *(u32x2e*)rp = rg; *(u32x2e*)(rp + 2816) = rv;
                    }
                    pk[ai][n][m][0] = cvt_pk_bf16(silu_r(cg.x) * cv.x, silu_r(cg.y) * cv.y); pk[ai][n][m][1] = cvt_pk_bf16(silu_r(cg.z) * cv.z, silu_r(cg.w) * cv.w);
                }
            }
        }
#pragma unroll
        for (int ai = 0; ai < 2; ++ai)
#pragma unroll
            for (int m = 0; m < 4; ++m) { u32x4 w; w.x = pk[ai][0][m][0]; w.y = pk[ai][0][m][1]; w.z = pk[ai][1][m][0]; w.w = pk[ai][1][m][1];
                *(u32x4*)(act + (size_t)(Rw + ai * HALF + 16 * m + fr) * 2816 + f0) = w; }
    }
};

struct EpiProj {
    static constexpr bool PERM = true, AFTER_DRAIN = false;
    bf16_t* O; float* gates; const float* cvec; const float* rowss; const float* gq; const float* gk; const float* rope; float qscale;
    __device__ __forceinline__ void operator()(const f32x4 (&acc)[2][2][4][2], const Unit& u, int wr, int wc, int fr_in, int fq_in) const {
        int fr = fr_in, fq = fq_in; asm volatile("" : "+v"(fr), "+v"(fq));
        const int row0 = u.pm * BM + wr * 64 + fr;
        const int col0 = u.pn * BM + wc * 32 + 8 * fq;
        const bool isctx = u.pm * BM >= 32768;
        const int bi = isctx ? 16 : ((u.pm * BM) >> 11);
        const float* bias = cvec + (size_t)bi * 2560;
        float rs[2][4];
#pragma unroll
        for (int ai = 0; ai < 2; ++ai)
#pragma unroll
            for (int m = 0; m < 4; ++m) rs[ai][m] = __builtin_amdgcn_rsqf(rowss[row0 + ai * HALF + m * 16] * (1.f / 1024.f) + 1e-6f);
        if (u.pn < 9) {
            f32x4 bv[2][2];
#pragma unroll
            for (int bj = 0; bj < 2; ++bj)
#pragma unroll
                for (int n = 0; n < 2; ++n) bv[bj][n] = *(const f32x4*)(bias + col0 + bj * HALF + 4 * n);
            const bool qk = u.pn < 2 || (u.pn == 2 && wc < 2);
            if (qk) {
                const bool isq = u.pn < 2;
                const float* gw_ = isq ? gq : gk;
                const int hoff = isq ? (4 * u.pn + wc) * 64 : 512 + wc * 64;
                const float sc = isq ? qscale : 1.f;
                f32x4 gw[2][2];
#pragma unroll
                for (int bj = 0; bj < 2; ++bj)
#pragma unroll
                    for (int n = 0; n < 2; ++n) gw[bj][n] = *(const f32x4*)(gw_ + 32 * bj + 16 * n + 4 * fq) * sc;
                const int ln_ = fq * 16 + fr;
#pragma unroll
                for (int ai = 0; ai < 2; ++ai)
#pragma unroll
                    for (int m = 0; m < 4; ++m) {
                        const int row = row0 + ai * HALF + m * 16;
                        f32x4 v[2][2]; float ss = 0.f;
#pragma unroll
                        for (int bj = 0; bj < 2; ++bj)
#pragma unroll
                            for (int n = 0; n < 2; ++n) { v[bj][n] = acc[ai][bj][m][n] * rs[ai][m] + bv[bj][n]; ss += (v[bj][n].x * v[bj][n].x + v[bj][n].y * v[bj][n].y) + (v[bj][n].z * v[bj][n].z + v[bj][n].w * v[bj][n].w); }
                        ss += __builtin_bit_cast(float, __builtin_amdgcn_ds_bpermute((ln_ ^ 16) << 2, __builtin_bit_cast(int, ss)));
                        ss += __builtin_bit_cast(float, __builtin_amdgcn_ds_bpermute((ln_ ^ 32) << 2, __builtin_bit_cast(int, ss)));
                        const float rstd = __builtin_amdgcn_rsqf(ss * (1.f / 64.f) + 1e-6f);
                        const int pos = row & 2047;
#pragma unroll
                        for (int bj = 0; bj < 2; ++bj) {
                            f32x4 y1 = v[bj][0] * rstd * gw[bj][0], y2 = v[bj][1] * rstd * gw[bj][1];
                            if (!isctx) { const int pa = bj == 0 ? (pos >> 6) : (pos & 63);
                                const f32x4 c = *(const f32x4*)(rope + pa * 16 + 4 * fq), s = *(const f32x4*)(rope + 1024 + pa * 16 + 4 * fq);
                                const f32x4 o1 = y1 * c - y2 * s, o2 = y2 * c + y1 * s; y1 = o1; y2 = o2; }
                            u32x4 w; w.x = cvt_pk_bf16(y1[0], y1[1]); w.y = cvt_pk_bf16(y1[2], y1[3]); w.z = cvt_pk_bf16(y2[0], y2[1]); w.w = cvt_pk_bf16(y2[2], y2[3]);
                            *(u32x4*)(O + (size_t)row * 2304 + hoff + 32 * bj + 8 * fq) = w;
                        }
                    }
            } else {
                const int ocol = (u.pn == 2) ? 640 + 64 * (wc - 2) + 8 * fq : col0;
                const int ostep = (u.pn == 2) ? 32 : HALF;
#pragma unroll
                for (int ai = 0; ai < 2; ++ai)
#pragma unroll
                    for (int m = 0; m < 4; ++m) { bf16_t* rowp = O + (size_t)(row0 + ai * HALF + m * 16) * 2304 + ocol;
#pragma unroll
                        for (int bj = 0; bj < 2; ++bj) { const f32x4 v0 = acc[ai][bj][m][0] * rs[ai][m] + bv[bj][0], v1 = acc[ai][bj][m][1] * rs[ai][m] + bv[bj][1];
                            u32x4 w; w.x = cvt_pk_bf16(v0[0], v0[1]); w.y = cvt_pk_bf16(v0[2], v0[3]); w.z = cvt_pk_bf16(v1[0], v1[1]); w.w = cvt_pk_bf16(v1[2], v1[3]);
                            *(u32x4*)(rowp + bj * ostep) = w; } }
            }
        } else if (wc == 0 && fq < 2) {
            const f32x4 b0 = *(const f32x4*)(bias + col0), b1 = *(const f32x4*)(bias + col0 + 4);
#pragma unroll
            for (int ai = 0; ai < 2; ++ai)
#pragma unroll
                for (int m = 0; m < 4; ++m) { float* gp = gates + (size_t)(row0 + ai * HALF + m * 16) * 16 + 8 * fq;
                    *(f32x4*)gp = acc[ai][0][m][0] * rs[ai][m] + b0; *(f32x4*)(gp + 4) = acc[ai][0][m][1] * rs[ai][m] + b1; }
        }
    }
};

struct EpiRes2 {
    static constexpr bool PERM = true, AFTER_DRAIN = false;
    const float* base_lat; const float* base_ctx; float* out_lat; float* out_ctx; const float* gvec;
    bf16_t* an; const float* gn; const float* svec; float* rowss;
    __device__ __forceinline__ void operator()(const f32x4 (&acc)[2][2][4][2], const Unit& u, int wr, int wc, int fr_in, int fq_in) const {
        int fr = fr_in, fq = fq_in; asm volatile("" : "+v"(fr), "+v"(fq));
        const int grow0 = u.pm * BM;
        const bool isctx = grow0 >= 32768;
        const int bi = isctx ? 16 : (grow0 >> 11);
        const float* base = isctx ? base_ctx + (size_t)(grow0 - 32768) * 1024 : base_lat + (size_t)grow0 * 1024;
        float* out = isctx ? out_ctx + (size_t)(grow0 - 32768) * 1024 : out_lat + (size_t)grow0 * 1024;
        const int col0 = u.pn * BM + wc * 32 + 8 * fq;
        const float* gv = gvec + bi * 6144 + col0;
        bf16_t* anb = an + (size_t)grow0 * 1024; float* rsb = rowss + grow0;
        f32x4 g[2][2], ns[2][2];
#pragma unroll
        for (int bj = 0; bj < 2; ++bj)
#pragma unroll
            for (int n = 0; n < 2; ++n) { g[bj][n] = *(const f32x4*)(gv + bj * HALF + 4 * n);
                if (an) ns[bj][n] = *(const f32x4*)(gn + col0 + bj * HALF + 4 * n) * (1.f + *(const f32x4*)(svec + bi * 6144 + col0 + bj * HALF + 4 * n)); }
#pragma unroll
        for (int ai = 0; ai < 2; ++ai) {
            f32x4 pre[4][2][2];
#pragma unroll
            for (int m = 0; m < 4; ++m) { const unsigned off = (unsigned)((ai * HALF + wr * 64 + m * 16 + fr) * 1024 + col0);
#pragma unroll
                for (int bj = 0; bj < 2; ++bj) { pre[m][bj][0] = *(const f32x4*)(base + off + bj * HALF); pre[m][bj][1] = *(const f32x4*)(base + off + bj * HALF + 4); } }
#pragma unroll
            for (int m = 0; m < 4; ++m) { const int row = ai * HALF + wr * 64 + m * 16 + fr; const unsigned off = (unsigned)(row * 1024 + col0); float ss = 0.f;
#pragma unroll
                for (int bj = 0; bj < 2; ++bj) {
                    const f32x4 o0 = pre[m][bj][0] + g[bj][0] * acc[ai][bj][m][0], o1 = pre[m][bj][1] + g[bj][1] * acc[ai][bj][m][1];
                    *(f32x4*)(out + off + bj * HALF) = o0; *(f32x4*)(out + off + bj * HALF + 4) = o1;
                    if (an) { ss += (o0.x * o0.x + o0.y * o0.y) + (o0.z * o0.z + o0.w * o0.w) + (o1.x * o1.x + o1.y * o1.y) + (o1.z * o1.z + o1.w * o1.w);
                        const f32x4 a0 = o0 * ns[bj][0], a1 = o1 * ns[bj][1];
                        u32x4 w; w.x = cvt_pk_bf16(a0[0], a0[1]); w.y = cvt_pk_bf16(a0[2], a0[3]); w.z = cvt_pk_bf16(a1[0], a1[1]); w.w = cvt_pk_bf16(a1[2], a1[3]);
                        *(u32x4*)(anb + off + bj * HALF) = w; }
                }
                if (an) { const int ln_ = fq * 16 + fr;
                    ss += __builtin_bit_cast(float, __builtin_amdgcn_ds_bpermute((ln_ ^ 16) << 2, __builtin_bit_cast(int, ss))); ss += __builtin_bit_cast(float, __builtin_amdgcn_ds_bpermute((ln_ ^ 32) << 2, __builtin_bit_cast(int, ss)));
                    if (fq == 0) unsafeAtomicAdd(rsb + row, ss); }
            }
            asm volatile("" ::: "memory");
        }
    }
};


struct SingleUnit {
    int pm, pn;
    __device__ __forceinline__ bool next(int i, Unit& u) const { if (i) return false; u.pm = pm; u.pn = pn; return true; }
    __device__ __forceinline__ void a_ready(const Unit&) const {}
    __device__ __forceinline__ void done(const Unit&) const {}
};
struct EpiSlab {
    static constexpr bool PERM = true, AFTER_DRAIN = false;
    float* O;
    __device__ __forceinline__ void operator()(const f32x4 (&acc)[2][2][4][2], const Unit& u, int wr, int wc, int fr, int fq) const {
        float* base = O + (size_t)(u.pm * BM + wr * 64 + fr) * 1024 + u.pn * BM + wc * 32 + 8 * fq;
#pragma unroll
        for (int ai = 0; ai < 2; ++ai)
#pragma unroll
            for (int m = 0; m < 4; ++m)
#pragma unroll
                for (int bj = 0; bj < 2; ++bj) { float* p = base + (size_t)(ai * HALF + m * 16) * 1024 + bj * HALF; *(f32x4*)p = acc[ai][bj][m][0]; *(f32x4*)(p + 4) = acc[ai][bj][m][1]; }
    }
};

template <class Epi, class Sched, bool ALIGN_EPI = false, bool SP2 = false>
__device__ __forceinline__ void gemm_phase(PG8_LAS unsigned char* lds, const Gemm g, const Sched& S, const Epi& E, const int tid_in) {
    const int tid = tid_in, wid = __builtin_amdgcn_readfirstlane(tid >> 6), lane = tid & 63, wr = wid >> 2, wc = wid & 3, fr = lane & 15, fq = lane >> 4;
    const int K = g.K, nt = K / BK, LD = g.ld ? g.ld : K;
    unsigned voffA[2], voffB[2];
#pragma unroll
    for (int i = 0; i < 2; ++i) { int R, C; stage_rc(tid * 16 + i * 8192, R, C); const int Rb = Epi::PERM ? ((R & ~31) + perm32(R & 31)) : R;
        voffA[i] = (unsigned)(R * LD + C) * 2u; voffB[i] = (unsigned)(Rb * LD + C) * 2u; }
    const size_t kstep = (size_t)(BK * 2);
    const size_t hstep = (size_t)HALF * LD * 2;
    const size_t tstep = 2 * hstep;
    const unsigned ldsw = (unsigned)wid * 1024u;
    const int aoff = lds_byte(wr * 64 + fr, fq * 8), boff = lds_byte(wc * 32 + fr, fq * 8);
#define PG8_SA(b, h) (((b) * 2 + (h)) * HTB)
#define PG8_SB(b, h) ((4 + (b) * 2 + (h)) * HTB)
#define PG8_STAGE(bufoff, gbase, voff) do { _Pragma("unroll") for (int _i = 0; _i < 2; ++_i) \
        __builtin_amdgcn_global_load_lds((const unsigned*)((const char*)(gbase) + (voff)[_i]), (PG8_LAS unsigned*)(lds + (bufoff) + ldsw + _i * 8192), 16, 0, 0); } while (0)
#define PG8_LDA(dst, b, h) do { _Pragma("unroll") for (int m = 0; m < 4; ++m) _Pragma("unroll") for (int k = 0; k < 2; ++k) dst[m][k] = *(const PG8_LAS bf16x8*)(lds + PG8_SA(b, h) + aoff + m * 2048 + k * 1024); } while (0)
#define PG8_LDB(dst, b, h) do { _Pragma("unroll") for (int n = 0; n < 2; ++n) _Pragma("unroll") for (int k = 0; k < 2; ++k) dst[n][k] = *(const PG8_LAS bf16x8*)(lds + PG8_SB(b, h) + boff + n * 2048 + k * 1024); } while (0)
#define PG8_MMA(ai, bj, At, Bt) do { __builtin_amdgcn_s_setprio(1); _Pragma("unroll") for (int m = 0; m < 4; ++m) _Pragma("unroll") for (int n = 0; n < 2; ++n) _Pragma("unroll") for (int k = 0; k < 2; ++k) \
        acc[ai][bj][m][n] = __builtin_amdgcn_mfma_f32_16x16x32_bf16(Bt[n][k], At[m][k], acc[ai][bj][m][n], 0, 0, 0); __builtin_amdgcn_s_setprio(0); } while (0)
#define PG8_WAIT_V(n) asm volatile("s_waitcnt vmcnt(" #n ")" ::: "memory")
#define PG8_WAIT_L(n) asm volatile("s_waitcnt lgkmcnt(" #n ")" ::: "memory")
#define PG8_BAR __builtin_amdgcn_s_barrier()
#define PG8_SCHED __builtin_amdgcn_sched_barrier(0)
    Unit cur, nxt; int ui = 0;
    if (!S.next(0, cur)) return;
    f32x4 acc[2][2][4][2];
#pragma unroll
    for (int a = 0; a < 2; ++a)
#pragma unroll
        for (int b = 0; b < 2; ++b)
#pragma unroll
            for (int m = 0; m < 4; ++m)
#pragma unroll
                for (int n = 0; n < 2; ++n) acc[a][b][m][n] = (f32x4){0.f, 0.f, 0.f, 0.f};
    bf16x8 At[4][2], B0[2][2], B1[2][2];
    const char* cA = (const char*)g.A + (size_t)cur.pm * tstep; const char* cB = (const char*)g.Bt + (size_t)cur.pn * tstep;
    S.a_ready(cur);
    if constexpr (SP2) {
        PG8_STAGE(PG8_SB(0, 0), cB, voffB); PG8_STAGE(PG8_SB(0, 1), cB + hstep, voffB); PG8_STAGE(PG8_SA(0, 0), cA, voffA); PG8_STAGE(PG8_SA(0, 1), cA + hstep, voffA);
        if (wr == 1) PG8_BAR;
        PG8_WAIT_V(2); PG8_BAR;
        PG8_STAGE(PG8_SB(1, 0), cB + kstep, voffB); PG8_STAGE(PG8_SA(1, 0), cA + kstep, voffA); PG8_STAGE(PG8_SB(1, 1), cB + hstep + kstep, voffB);
        PG8_WAIT_V(6); PG8_BAR;
    } else {
        PG8_STAGE(PG8_SB(0, 0), cB, voffB); PG8_STAGE(PG8_SA(0, 0), cA, voffA); PG8_STAGE(PG8_SB(0, 1), cB + hstep, voffB); PG8_STAGE(PG8_SA(0, 1), cA + hstep, voffA);
        if (wr == 1) PG8_BAR;
        PG8_WAIT_V(4); PG8_BAR;
        PG8_STAGE(PG8_SB(1, 0), cB + kstep, voffB); PG8_STAGE(PG8_SA(1, 0), cA + kstep, voffA); PG8_STAGE(PG8_SB(1, 1), cB + hstep + kstep, voffB);
        PG8_WAIT_V(6); PG8_BAR;
    }
    for (;;) {
        const bool has_next = S.next(ui + 1, nxt);
        const char* nA = has_next ? (const char*)g.A + (size_t)nxt.pm * tstep : cA; const char* nB = has_next ? (const char*)g.Bt + (size_t)nxt.pn * tstep : cB;
        for (int t = 0; t < nt; t += 2) {
            const bool last = (t == nt - 2);
            const char* a1 = cA + (size_t)(t + 1) * kstep;
            const char* a2 = last ? nA : cA + (size_t)(t + 2) * kstep; const char* b2 = last ? nB : cB + (size_t)(t + 2) * kstep;
            const char* a3 = a2 + kstep; const char* b3 = b2 + kstep;
            if (last && has_next) S.a_ready(nxt);
            if constexpr (SP2) {
            PG8_LDB(B0, 0, 0); PG8_LDB(B1, 0, 1); PG8_SCHED; PG8_LDA(At, 0, 0); PG8_STAGE(PG8_SA(1, 1), a1 + hstep, voffA);
            PG8_WAIT_V(8); PG8_WAIT_L(0); PG8_BAR; PG8_MMA(0, 0, At, B0); PG8_MMA(0, 1, At, B1); PG8_BAR; PG8_SCHED;
            PG8_LDA(At, 0, 1); PG8_STAGE(PG8_SB(0, 0), b2, voffB); PG8_STAGE(PG8_SB(0, 1), b2 + hstep, voffB); PG8_STAGE(PG8_SA(0, 0), a2, voffA);
            PG8_WAIT_V(8); PG8_WAIT_L(0); PG8_BAR; PG8_MMA(1, 0, At, B0); PG8_MMA(1, 1, At, B1); PG8_BAR; PG8_SCHED;
            PG8_LDB(B0, 1, 0); PG8_LDB(B1, 1, 1); PG8_SCHED; PG8_LDA(At, 1, 0); PG8_STAGE(PG8_SA(0, 1), a2 + hstep, voffA);
            PG8_WAIT_V(8); PG8_WAIT_L(0); PG8_BAR; PG8_MMA(0, 0, At, B0); PG8_MMA(0, 1, At, B1); PG8_BAR; PG8_SCHED;
            PG8_LDA(At, 1, 1); PG8_STAGE(PG8_SB(1, 0), b3, voffB); PG8_STAGE(PG8_SB(1, 1), b3 + hstep, voffB); PG8_STAGE(PG8_SA(1, 0), a3, voffA);
            PG8_WAIT_V(8); PG8_WAIT_L(0); PG8_BAR; PG8_MMA(1, 0, At, B0); PG8_MMA(1, 1, At, B1); PG8_BAR; PG8_SCHED;
            } else {
            PG8_LDB(B0, 0, 0); PG8_SCHED; PG8_LDA(At, 0, 0); PG8_STAGE(PG8_SA(1, 1), a1 + hstep, voffA);
            PG8_WAIT_L(8); PG8_BAR; PG8_WAIT_L(0); PG8_MMA(0, 0, At, B0); PG8_BAR; PG8_SCHED;
            PG8_LDB(B1, 0, 1); PG8_STAGE(PG8_SB(0, 0), b2, voffB);
            PG8_BAR; PG8_WAIT_L(0); PG8_MMA(0, 1, At, B1); PG8_BAR;
            PG8_LDA(At, 0, 1); PG8_STAGE(PG8_SA(0, 0), a2, voffA);
            PG8_BAR; PG8_WAIT_L(0); PG8_MMA(1, 0, At, B0); PG8_BAR; PG8_SCHED;
            PG8_STAGE(PG8_SB(0, 1), b2 + hstep, voffB);
            PG8_WAIT_V(6); PG8_BAR; PG8_MMA(1, 1, At, B1); PG8_BAR;
            PG8_LDB(B0, 1, 0); PG8_SCHED; PG8_LDA(At, 1, 0); PG8_STAGE(PG8_SA(0, 1), a2 + hstep, voffA);
            PG8_WAIT_L(8); PG8_BAR; PG8_WAIT_L(0); PG8_MMA(0, 0, At, B0); PG8_BAR; PG8_SCHED;
            PG8_LDB(B1, 1, 1); PG8_STAGE(PG8_SB(1, 0), b3, voffB);
            PG8_BAR; PG8_WAIT_L(0); PG8_MMA(0, 1, At, B1); PG8_BAR;
            PG8_LDA(At, 1, 1); PG8_STAGE(PG8_SA(1, 0), a3, voffA);
            PG8_BAR; PG8_WAIT_L(0); PG8_MMA(1, 0, At, B0); PG8_BAR; PG8_SCHED;
            PG8_STAGE(PG8_SB(1, 1), b3 + hstep, voffB);
            PG8_WAIT_V(6); PG8_BAR; PG8_MMA(1, 1, At, B1); PG8_BAR;
            }
        }
        if constexpr (ALIGN_EPI) { if (wr == 0) PG8_BAR; }
        if constexpr (!Epi::AFTER_DRAIN) { E(acc, cur, wr, wc, fr, fq); S.done(cur); }
        if (!has_next) break;
#pragma unroll
        for (int a = 0; a < 2; ++a)
#pragma unroll
            for (int b = 0; b < 2; ++b)
#pragma unroll
                for (int m = 0; m < 4; ++m)
#pragma unroll
                    for (int n = 0; n < 2; ++n) acc[a][b][m][n] = (f32x4){0.f, 0.f, 0.f, 0.f};
        cur = nxt; cA = nA; cB = nB; ++ui;
        if constexpr (ALIGN_EPI) { if (wr == 1) PG8_BAR; }
    }
    PG8_WAIT_V(0);
    if constexpr (!ALIGN_EPI) { if (wr == 0) PG8_BAR; }
    PG8_BAR;
    if constexpr (Epi::AFTER_DRAIN) { E.fused(acc, cur, wr, wc, fr, fq, lds, wid, lane); S.done(cur); }
#undef PG8_SA
#undef PG8_SB
#undef PG8_STAGE
#undef PG8_LDA
#undef PG8_LDB
#undef PG8_MMA
#undef PG8_WAIT_V
#undef PG8_WAIT_L
#undef PG8_BAR
#undef PG8_SCHED
}
}
namespace attn_body {
using bf16=__hip_bfloat16;
using bf16x8=__attribute__((ext_vector_type(8)))short;
using s16x4=__attribute__((ext_vector_type(4)))short;
using f32x16=__attribute__((ext_vector_type(16)))float;
using u32x4=__attribute__((ext_vector_type(4)))unsigned;
constexpr int D=64,QP=2304,KP=2304,OP=1024;
constexpr int NW=8,QBLK=32,QB=QBLK*NW,KVBLK=64;
__device__ __forceinline__ int crow(int r,int hi){return (r&3)+8*(r>>2)+4*hi;}
#define SBAR() __builtin_amdgcn_sched_barrier(0)
__device__ __forceinline__ void cmask(f32x16&p0,f32x16&p1,int jb,int qrel,int hi){
  const float NEG=-INFINITY; int kb=64*jb+4*hi;
  #pragma unroll
  for(int r=0;r<16;++r){int kv=kb+(r&3)+8*(r>>2); if(kv>qrel)p0[r]=NEG; if(kv+32>qrel)p1[r]=NEG;}
}

constexpr int NSLOT=3, SLOTB=8192;
constexpr int LDS_K=0, LDS_V=NSLOT*SLOTB, LDS_WS=2*NSLOT*SLOTB, LDS_OST=LDS_WS+NW*64*4, LDS_BYTES=LDS_OST+NW*4096;
constexpr float C2=0.125f*1.4426950408889634f;
__device__ __forceinline__ void glds16(const void*gsrc,unsigned lds_dst){unsigned keep;
  asm volatile("s_mov_b32 %0, m0\n\ts_mov_b32 m0, %2\n\ts_nop 0\n\tglobal_load_lds_dwordx4 %1, off\n\ts_mov_b32 m0, %0":"=&s"(keep):"v"(gsrc),"s"(lds_dst):"memory");}
__device__ __forceinline__ float max3f(float a,float b,float c){float r;asm("v_max3_f32 %0, %1, %2, %3":"=v"(r):"v"(a),"v"(b),"v"(c));return r;}
__device__ __forceinline__ float max2f(float a,float b){float r;asm("v_max_f32_e32 %0, %1, %2":"=v"(r):"v"(a),"v"(b));return r;}
__device__ __forceinline__ float fadd_s(float a,float b){float r;asm("v_add_f32_e32 %0, %1, %2":"=v"(r):"v"(a),"v"(b));return r;}
__device__ __forceinline__ float fsub_s(float a,float b){float r;asm("v_sub_f32_e32 %0, %1, %2":"=v"(r):"v"(a),"v"(b));return r;}
typedef float f32x2_t __attribute__((ext_vector_type(2))); typedef __bf16 bf16x2_t __attribute__((ext_vector_type(2)));
__device__ __forceinline__ unsigned cvtpk_s(float lo,float hi){f32x2_t v={lo,hi};bf16x2_t b=__builtin_convertvector(v,bf16x2_t);return __builtin_bit_cast(unsigned,b);}
#define WAIT_BAR(N) asm volatile("s_waitcnt vmcnt(" #N ") lgkmcnt(0)\n\ts_barrier":::"memory")

__device__ __forceinline__ void qkt(f32x16&p0,f32x16&p1,const char*Kslot,const bf16x8*qr,const f32x16&negm,int r32,int hi){
  const char*kb=Kslot+hi*1024+r32*16;
  #pragma unroll
  for(int d0=0;d0<4;++d0){
    const bf16x8 b0=*reinterpret_cast<const bf16x8*>(kb+d0*2048);
    const bf16x8 b1=*reinterpret_cast<const bf16x8*>(kb+d0*2048+512);
    if(d0==0){p0=__builtin_amdgcn_mfma_f32_32x32x16_bf16(b0,qr[0],negm,0,0,0);p1=__builtin_amdgcn_mfma_f32_32x32x16_bf16(b1,qr[0],negm,0,0,0);}
    else{p0=__builtin_amdgcn_mfma_f32_32x32x16_bf16(b0,qr[d0],p0,0,0,0);p1=__builtin_amdgcn_mfma_f32_32x32x16_bf16(b1,qr[d0],p1,0,0,0);}}
}
typedef __attribute__((address_space(3))) const char* lds_cptr;
typedef short v4i16_t __attribute__((ext_vector_type(4)));
__device__ __forceinline__ void kload8(bf16x8*kf,lds_cptr kp){
  kf[0]=*(const __attribute__((address_space(3))) bf16x8*)(kp);      kf[1]=*(const __attribute__((address_space(3))) bf16x8*)(kp+512);
  kf[2]=*(const __attribute__((address_space(3))) bf16x8*)(kp+2048); kf[3]=*(const __attribute__((address_space(3))) bf16x8*)(kp+2560);
  kf[4]=*(const __attribute__((address_space(3))) bf16x8*)(kp+4096); kf[5]=*(const __attribute__((address_space(3))) bf16x8*)(kp+4608);
  kf[6]=*(const __attribute__((address_space(3))) bf16x8*)(kp+6144); kf[7]=*(const __attribute__((address_space(3))) bf16x8*)(kp+6656);
}
__device__ __forceinline__ void kload2(bf16x8*kf,lds_cptr kp,int j){ kf[2*j]=*(const __attribute__((address_space(3))) bf16x8*)(kp+j*2048); kf[2*j+1]=*(const __attribute__((address_space(3))) bf16x8*)(kp+j*2048+512); }
__device__ __forceinline__ s16x4 vtr(lds_cptr p){ return __builtin_bit_cast(s16x4,__builtin_amdgcn_ds_read_tr16_b64_v4i16((__attribute__((address_space(3))) v4i16_t*)p)); }
__device__ __forceinline__ float rowmax(const f32x16&p0,const f32x16&p1){
  float a=max3f(p0[0],p0[1],p1[0]),b=max3f(p0[2],p0[3],p1[1]);a=max3f(a,p1[2],p1[3]);
  #pragma unroll
  for(int r=4;r<16;r+=4){a=max3f(a,p0[r],p0[r+1]);b=max3f(b,p0[r+2],p0[r+3]);a=max3f(a,p1[r],p1[r+1]);b=max3f(b,p1[r+2],p1[r+3]);}
  const float m=max2f(a,b);
  auto rr=__builtin_amdgcn_permlane32_swap(__float_as_uint(m),__float_as_uint(m),false,false);
  return max2f(__uint_as_float(rr[0]),__uint_as_float(rr[1]));
}
__device__ __forceinline__ void pv(f32x16*o,int vb,bf16x8 pa0,bf16x8 pa1,bf16x8 pa2,bf16x8 pa3){
  #pragma unroll
  for(int d0=0;d0<2;++d0){s16x4 lo[4],hi[4];
    #pragma unroll
    for(int ks=0;ks<4;++ks){
      asm volatile("ds_read_b64_tr_b16 %0,%1 offset:%c2":"=&v"(lo[ks]):"v"(vb),"i"(d0*4096+ks*1024):"memory");
      asm volatile("ds_read_b64_tr_b16 %0,%1 offset:%c2":"=&v"(hi[ks]):"v"(vb),"i"(d0*4096+ks*1024+512):"memory");}
    asm volatile("s_waitcnt lgkmcnt(0)":::"memory");SBAR();
    #define PK(k) (bf16x8){lo[k][0],lo[k][1],lo[k][2],lo[k][3],hi[k][0],hi[k][1],hi[k][2],hi[k][3]}
    o[d0]=__builtin_amdgcn_mfma_f32_32x32x16_bf16(pa0,PK(0),o[d0],0,0,0);
    o[d0]=__builtin_amdgcn_mfma_f32_32x32x16_bf16(pa1,PK(1),o[d0],0,0,0);
    o[d0]=__builtin_amdgcn_mfma_f32_32x32x16_bf16(pa2,PK(2),o[d0],0,0,0);
    o[d0]=__builtin_amdgcn_mfma_f32_32x32x16_bf16(pa3,PK(3),o[d0],0,0,0);
    #undef PK
  }
}

#ifndef ATTN_STORE16
#define ATTN_STORE16(p,v) (*(u32x4*)(p)=(v))
#endif
template<int THRL> __device__ __forceinline__ void attn_unit(const bf16*Qu,const bf16*__restrict__ Kc,const bf16*__restrict__ Vc,const bf16*__restrict__ Kl,const bf16*__restrict__ Vl,const int NT,bf16*Ou,char*shm,const int tid_in){
  const int tid=tid_in,lane=tid&63,r32=lane&31,hi=lane>>5; const int wid=__builtin_amdgcn_readfirstlane(tid>>6);
  const bf16*Qw=Qu+(long)(wid*QBLK)*QP;
  const unsigned lds0=(unsigned)(uintptr_t)shm;
  float*wsf=(float*)(shm+LDS_WS)+wid*64;
  const long koff=(long)lane*KP+wid*8;
  const long voff=(long)(16*(wid&3)+(lane>>2))*KP+(wid>>2)*32+(lane&3)*8;
  const unsigned kdst=lds0+LDS_K+wid*1024, vdst=lds0+LDS_V+wid*1024;
  #define DMA_K(t,slot) glds16((((t)<4)?(Kc+(long)(t)*KVBLK*KP):(Kl+(long)((t)-4)*KVBLK*KP))+koff,(unsigned)__builtin_amdgcn_readfirstlane(kdst+(slot)))
  #define DMA_V(t,slot) glds16((((t)<4)?(Vc+(long)(t)*KVBLK*KP):(Vl+(long)((t)-4)*KVBLK*KP))+voff,(unsigned)__builtin_amdgcn_readfirstlane(vdst+(slot)))
  const int vb0=(int)(lds0+LDS_V)+((lane>>4)&1)*32+(lane&3)*8+(4*hi+((lane&15)>>2))*64;
  const char*Kbase=shm+LDS_K; bf16x8 kf[8];
  const lds_cptr shm3=(lds_cptr)shm; const lds_cptr kp0=shm3+LDS_K+hi*1024+r32*16; const lds_cptr vp0=shm3+LDS_V+((lane>>4)&1)*32+(lane&3)*8+(4*hi+((lane&15)>>2))*64;
  DMA_K(0,0);DMA_V(0,0);DMA_K(1,SLOTB);
  bf16x8 qr[4];
  #pragma unroll
  for(int d0=0;d0<4;++d0)qr[d0]=*reinterpret_cast<const bf16x8*>(&Qw[(long)r32*QP+d0*16+hi*8]);
  float mhat=0.f,l_reg=0.f;f32x16 o[2];o[0]=f32x16{};o[1]=f32x16{};f32x16 negm=f32x16{};asm volatile("":"+v"(negm));
  #define CMASK(P0,P1,t) do{}while(0)
  bool resc=false;
  #define START(P0,P1) do{ const float rm=rowmax(P0,P1); resc=false; \
    { const float dl=rm; mhat=fadd_s(mhat,dl); \
      _Pragma("unroll") for(int r=0;r<16;++r){P0[r]=fsub_s(P0[r],dl);P1[r]=fsub_s(P1[r],dl);} \
      _Pragma("unroll") for(int r=0;r<16;++r)negm[r]=-mhat; asm volatile("":"+v"(negm)); } \
    _Pragma("unroll") for(int r=0;r<16;++r)P0[r]=__builtin_amdgcn_exp2f(P0[r]); }while(0)
  #define RESC() do{ if(resc){ asm volatile("s_waitcnt lgkmcnt(0)":::"memory"); \
      _Pragma("unroll") for(int d_=0;d_<2;++d_) _Pragma("unroll") for(int r=0;r<16;++r)o[d_][r]*=wsf[crow(r,hi)]; } }while(0)
  f32x16 pA0,pA1,pB0,pB1;
  int sl_prev=0,sl_cur=0,sl_next=SLOTB;
  #define ROT() do{sl_prev=sl_cur;sl_cur=sl_next;sl_next=(sl_next==(NSLOT-1)*SLOTB)?0:sl_next+SLOTB;}while(0)
  DMA_K(2,2*SLOTB);
  WAIT_BAR(3);
  qkt(pA0,pA1,Kbase,qr,negm,r32,hi);asm volatile("s_nop 15\n\ts_nop 7":"+v"(pA0),"+v"(pA1));CMASK(pA0,pA1,0);
  START(pA0,pA1);
  _Pragma("unroll") for(int r=0;r<16;++r)pA1[r]=__builtin_amdgcn_exp2f(pA1[r]);
  WAIT_BAR(0);
  DMA_K(3,0);DMA_V(1,SLOTB);
  ROT();
  kload8(kf,kp0+sl_cur);
  WAIT_BAR(2);
  s16x4 vlo[8],vhi[8]; u32x4 pw0,pw1,pw2,pw3;
  #define PKW(P,B) cvtpk_s(P[B],P[B+1])
  #define PAF(k) __builtin_bit_cast(bf16x8,pw##k)
  #define VFR(i) (bf16x8){vlo[i][0],vlo[i][1],vlo[i][2],vlo[i][3],vhi[i][0],vhi[i][1],vhi[i][2],vhi[i][3]}
  #define PIN(x) asm volatile("":"+v"(x))
  #define MX3(a,b,c) __builtin_fmaxf(__builtin_fmaxf((a),(b)),(c))
  #define GAPA(MF,A0,A1,A2,A3,W0,W1,PW) do{ MF; sacc+=A0; sacc+=A1; sacc+=A2; sacc+=A3; PIN(sacc); W0; W1; PIN(PW); SBAR(); }while(0)
  #define EX(v) __builtin_amdgcn_exp2f(v)
  #define GAPB(MF,X,B) do{ MF; X[B]=EX(X[B]); X[B+1]=EX(X[B+1]); X[B+2]=EX(X[B+2]); X[B+3]=EX(X[B+3]); PIN(X); SBAR(); }while(0)
  #define VRD(i) do{ vlo[i]=vtr(vp_+(((i)>>2)*4096+((i)&3)*1024)); vhi[i]=vtr(vp_+(((i)>>2)*4096+((i)&3)*1024+512)); }while(0)
  #define KRD(G,j) do{ if(G){ kload2(kf,kp0+sl_next,j); SBAR(); } }while(0)
  #define STEP(C0,C1,P0,P1,t,GK,GV,GL) do{ SBAR(); \
    const lds_cptr vp_=vp0+sl_prev; \
    VRD(0); SBAR(); float sacc=(P0[0]+P0[1]); \
    GAPA(C0=__builtin_amdgcn_mfma_f32_32x32x16_bf16(kf[0],qr[0],negm,0,0,0), P0[2],P0[3],P0[4],P0[5],     pw0[0]=PKW(P0,0), pw0[1]=PKW(P0,2), pw0); \
    VRD(4); SBAR(); GAPA(C1=__builtin_amdgcn_mfma_f32_32x32x16_bf16(kf[1],qr[0],negm,0,0,0), P0[6],P0[7],P0[8],P0[9],     pw0[2]=PKW(P0,4), pw0[3]=PKW(P0,6), pw0); \
    VRD(1); SBAR(); GAPA(C0=__builtin_amdgcn_mfma_f32_32x32x16_bf16(kf[2],qr[1],C0,0,0,0),   P0[10],P0[11],P0[12],P0[13], pw1[0]=PKW(P0,8), pw1[1]=PKW(P0,10), pw1); \
    VRD(5); SBAR(); GAPA(C1=__builtin_amdgcn_mfma_f32_32x32x16_bf16(kf[3],qr[1],C1,0,0,0),   P0[14],P0[15],P1[0],P1[1],   pw1[2]=PKW(P0,12),pw1[3]=PKW(P0,14), pw1); \
    VRD(2); SBAR(); GAPA(C0=__builtin_amdgcn_mfma_f32_32x32x16_bf16(kf[4],qr[2],C0,0,0,0),   P1[2],P1[3],P1[4],P1[5],     pw2[0]=PKW(P1,0), pw2[1]=PKW(P1,2), pw2); \
    VRD(6); SBAR(); GAPA(C1=__builtin_amdgcn_mfma_f32_32x32x16_bf16(kf[5],qr[2],C1,0,0,0),   P1[6],P1[7],P1[8],P1[9],     pw2[2]=PKW(P1,4), pw2[3]=PKW(P1,6), pw2); \
    VRD(3); SBAR(); GAPA(C0=__builtin_amdgcn_mfma_f32_32x32x16_bf16(kf[6],qr[3],C0,0,0,0),   P1[10],P1[11],P1[12],P1[13], pw3[0]=PKW(P1,8), pw3[1]=PKW(P1,10), pw3); \
    VRD(7); SBAR(); GAPA(C1=__builtin_amdgcn_mfma_f32_32x32x16_bf16(kf[7],qr[3],C1,0,0,0),   P1[14],P1[15],0.f,0.f,       pw3[2]=PKW(P1,12),pw3[3]=PKW(P1,14), pw3); \
    l_reg+=sacc; \
    if(GK){DMA_K((t)+3,sl_cur);} if(GV){DMA_V((t)+1,sl_next);} \
    CMASK(C0,C1,t); \
    { float a=MX3(C0[0],C0[1],C1[0]),b=MX3(C0[2],C0[3],C1[1]); a=MX3(a,C1[2],C1[3]); \
      _Pragma("unroll") for(int r=4;r<16;r+=4){a=MX3(a,C0[r],C0[r+1]);b=MX3(b,C0[r+2],C0[r+3]);a=MX3(a,C1[r],C1[r+1]);b=MX3(b,C1[r+2],C1[r+3]);} \
      float rm=__builtin_fmaxf(a,b); { auto rr=__builtin_amdgcn_permlane32_swap(__float_as_uint(rm),__float_as_uint(rm),false,false); rm=__builtin_fmaxf(__uint_as_float(rr[0]),__uint_as_float(rr[1])); } \
      resc=false; \
      if(__builtin_expect(__any(rm>(float)THRL),0)){ const float dl=__builtin_fmaxf(rm,0.f); mhat+=dl; \
        _Pragma("unroll") for(int r=0;r<16;++r){C0[r]-=dl;C1[r]-=dl;} \
        _Pragma("unroll") for(int r=0;r<16;++r)negm[r]=-mhat; asm volatile("":"+v"(negm)); \
        const float f=__builtin_amdgcn_exp2f(-dl); l_reg*=f; if(hi==0)wsf[r32]=f; resc=true; } } \
    SBAR(); \
    GAPB(o[0]=__builtin_amdgcn_mfma_f32_32x32x16_bf16(PAF(0),VFR(0),o[0],0,0,0), C0,0); \
    GAPB(o[1]=__builtin_amdgcn_mfma_f32_32x32x16_bf16(PAF(0),VFR(4),o[1],0,0,0), C0,4); \
    KRD(GL,0); GAPB(o[0]=__builtin_amdgcn_mfma_f32_32x32x16_bf16(PAF(1),VFR(1),o[0],0,0,0), C0,8); \
    KRD(GL,1); GAPB(o[1]=__builtin_amdgcn_mfma_f32_32x32x16_bf16(PAF(1),VFR(5),o[1],0,0,0), C0,12); \
    KRD(GL,2); GAPB(o[0]=__builtin_amdgcn_mfma_f32_32x32x16_bf16(PAF(2),VFR(2),o[0],0,0,0), C1,0); \
    KRD(GL,3); GAPB(o[1]=__builtin_amdgcn_mfma_f32_32x32x16_bf16(PAF(2),VFR(6),o[1],0,0,0), C1,4); \
    GAPB(o[0]=__builtin_amdgcn_mfma_f32_32x32x16_bf16(PAF(3),VFR(3),o[0],0,0,0), C1,8); \
    GAPB(o[1]=__builtin_amdgcn_mfma_f32_32x32x16_bf16(PAF(3),VFR(7),o[1],0,0,0), C1,12); \
    }while(0)
  int t=1;
  #undef CMASK
  #define CMASK(P0,P1,t) do{}while(0)
  for(;t+5<NT;t+=2){
    STEP(pB0,pB1,pA0,pA1,t,true,true,true);     WAIT_BAR(2); RESC(); ROT();
    STEP(pA0,pA1,pB0,pB1,t+1,true,true,true);   WAIT_BAR(2); RESC(); ROT();
  }
  #undef CMASK
  #define CMASK(P0,P1,t) do{}while(0)
  #define ENDW(tt) do{ if((tt)+3<NT){WAIT_BAR(2);} else if((tt)+2<NT){WAIT_BAR(1);} else {WAIT_BAR(0);} }while(0)
  for(;t+1<NT;t+=2){
    STEP(pB0,pB1,pA0,pA1,t,(t+3<NT),(t+1<NT),(t+1<NT));       ENDW(t);   RESC(); ROT();
    STEP(pA0,pA1,pB0,pB1,t+1,(t+4<NT),(t+2<NT),(t+2<NT));     ENDW(t+1); RESC(); ROT();
  }
  STEP(pB0,pB1,pA0,pA1,NT-1,false,false,false); RESC();
  { float sacc=pB0[0]+pB0[1]; _Pragma("unroll") for(int r=2;r<16;++r)sacc+=pB0[r]; _Pragma("unroll") for(int r=0;r<16;++r)sacc+=pB1[r]; l_reg+=sacc;
    pw0=(u32x4){PKW(pB0,0),PKW(pB0,2),PKW(pB0,4),PKW(pB0,6)};pw1=(u32x4){PKW(pB0,8),PKW(pB0,10),PKW(pB0,12),PKW(pB0,14)};pw2=(u32x4){PKW(pB1,0),PKW(pB1,2),PKW(pB1,4),PKW(pB1,6)};pw3=(u32x4){PKW(pB1,8),PKW(pB1,10),PKW(pB1,12),PKW(pB1,14)};
    SBAR(); pv(o,vb0+sl_cur,PAF(0),PAF(1),PAF(2),PAF(3)); }
  #undef PKW
  #undef PAF
  #undef VFR
  #undef PIN
  #undef MX3
  #undef GAPA
  #undef GAPB
  #undef EX
  #undef VRD
  #undef KRD
  #undef STEP
  #undef ENDW
  {auto rr=__builtin_amdgcn_permlane32_swap(__float_as_uint(l_reg),__float_as_uint(l_reg),false,false);l_reg=__uint_as_float(rr[0])+__uint_as_float(rr[1]);}
  if(hi==0)wsf[32+r32]=l_reg;asm volatile("s_waitcnt lgkmcnt(0)":::"memory");
  float rli[16];
  #pragma unroll
  for(int r=0;r<16;++r)rli[r]=__builtin_amdgcn_rcpf(wsf[32+crow(r,hi)]);
  bf16*Ow=Ou+(long)(wid*QBLK)*OP;
  { bf16*stg=(bf16*)(shm+LDS_OST)+wid*2048;
    #pragma unroll
    for(int r=0;r<16;++r){const int orow=crow(r,hi);
      #pragma unroll
      for(int d0=0;d0<2;++d0)stg[orow*64+d0*32+r32]=__float2bfloat16(o[d0][r]*rli[r]);}
    asm volatile("s_waitcnt lgkmcnt(0)":::"memory");
    #pragma unroll
    for(int i=0;i<4;++i){const int row=i*8+(lane>>3),ch=lane&7; const u32x4 v=*(const u32x4*)(stg+row*64+ch*8); ATTN_STORE16(Ow+(long)row*OP+ch*8,v);} }
  asm volatile("s_waitcnt lgkmcnt(0)\n\ts_barrier":::"memory");
  #undef DMA_K
  #undef DMA_V
  #undef CMASK
  #undef START
  #undef RESC
  #undef ROT
}
constexpr int ATTN_LDS_BYTES=LDS_BYTES;
#undef SBAR
#undef WAIT_BAR
}
#define GAS __attribute__((address_space(1)))
#define LAS __attribute__((address_space(3)))
typedef GAS unsigned gu32;
typedef GAS unsigned long long gu64;
#define RLX_AGENT __ATOMIC_RELAXED, __HIP_MEMORY_SCOPE_AGENT
#define LDS_WAIT() asm volatile("s_waitcnt lgkmcnt(0)" ::: "memory")
#define VM_WAIT() asm volatile("s_waitcnt vmcnt(0)" ::: "memory")
__device__ __forceinline__ unsigned long long rt() { return __builtin_amdgcn_s_memrealtime(); }
#define XB_TMO      128
#define XB_XCNT(j)  (256  + 64 * (j))
#define XB_XSUB(j)  (1280 + 64 * (j))
#define XB_XGEN(j)  (2304 + 64 * (j))
#define XB_TOP      3328
#define XB_TOPGEN   3392
#define XCD_BAR_WORDS 3456
#define XB_SPIN_CAP (1u << 18)

__device__ __forceinline__ unsigned xb_ld(unsigned* p)              { return __hip_atomic_load(p, __ATOMIC_RELAXED, __HIP_MEMORY_SCOPE_AGENT); }
__device__ __forceinline__ unsigned xb_add(unsigned* p, unsigned v) { return __hip_atomic_fetch_add(p, v, __ATOMIC_RELAXED, __HIP_MEMORY_SCOPE_AGENT); }
__device__ __forceinline__ unsigned xb_xcc_id() { return (unsigned)__builtin_amdgcn_s_getreg((3 << 11) | 20) & 0xFu; }
#define XB_SPIN(cond, bar) do { unsigned _sp = 0; while (cond) { __builtin_amdgcn_s_sleep(1); \
    if ((++_sp & 255u) == 0u) { if (xb_ld(&(bar)[XB_TMO])) break; if (_sp > XB_SPIN_CAP) { atomicAdd(&(bar)[XB_TMO], 1u); break; } } } } while (0)

struct XcdBarrier {
    unsigned* bar; unsigned x;
    volatile LAS unsigned* st;
};

__device__ __forceinline__ XcdBarrier xcd_barrier_post(unsigned* bar, volatile LAS unsigned* st) {
    XcdBarrier b; b.bar = bar; b.x = xb_xcc_id(); b.st = st;
    if (threadIdx.x == 0) (void)xb_add(&bar[XB_XCNT(b.x)], 1u);
    return b;
}
__device__ __forceinline__ void xcd_barrier_complete(unsigned* bar, unsigned x, unsigned& nloc, unsigned& nx) {
    const unsigned G = gridDim.x * gridDim.y * gridDim.z;
    unsigned sum, cnt, mine, sp = 0u;
    for (;;) {
        sum = 0u; cnt = 0u; mine = 0u;
#pragma unroll
        for (unsigned j = 0; j < 16; ++j) { const unsigned c = xb_ld(&bar[XB_XCNT(j)]); sum += c; cnt += (c > 0u) ? 1u : 0u; mine = (j == x) ? c : mine; }
        if (sum == G) break;
        __builtin_amdgcn_s_sleep(1);
        if ((++sp & 255u) == 0u) { if (xb_ld(&bar[XB_TMO])) break; if (sp > XB_SPIN_CAP) { atomicAdd(&bar[XB_TMO], 1u); break; } }
    }
    nloc = mine > 0u ? mine : 1u; nx = cnt > 0u ? cnt : 1u;
}

__device__ __forceinline__ void xcd_barrier(const XcdBarrier& b) {
    asm volatile("s_waitcnt vmcnt(0)" ::: "memory");
    __syncthreads();
    if (threadIdx.x == 0) {
        unsigned* bar = b.bar;
        __builtin_amdgcn_s_waitcnt(0);
        unsigned nloc = b.st[0], nx = b.st[1];
        if (nloc == 0u) { xcd_barrier_complete(bar, b.x, nloc, nx); b.st[0] = nloc; b.st[1] = nx; }
        const unsigned old = xb_add(&bar[XB_XSUB(b.x)], 1u);
        const unsigned gen = old / nloc;
        if (old + 1u == (gen + 1u) * nloc) {
            __builtin_amdgcn_fence(__ATOMIC_RELEASE, "agent");
            asm volatile("s_waitcnt vmcnt(0)" ::: "memory");
            const unsigned og = xb_add(&bar[XB_TOP], 1u);
            const unsigned tg = og / nx;
            if (og + 1u == (tg + 1u) * nx) xb_add(&bar[XB_TOPGEN], 1u);
            else XB_SPIN(xb_ld(&bar[XB_TOPGEN]) == tg, bar);
            __builtin_amdgcn_fence(__ATOMIC_ACQUIRE, "agent");
            xb_add(&bar[XB_XGEN(b.x)], 1u);
            asm volatile("s_waitcnt vmcnt(0)" ::: "memory");
        } else {
            XB_SPIN(xb_ld(&bar[XB_XGEN(b.x)]) == gen, bar);
            __builtin_amdgcn_fence(__ATOMIC_ACQUIRE, "agent");
            asm volatile("s_waitcnt vmcnt(0)" ::: "memory");
        }
    }
    __syncthreads();
}


constexpr int NB = 16, SEQ = 2048, CTXL = 256, DM = 1024, DEPTH = 4, DFF = 2816, DIN = 2320, NPROJ = 2304, NPROJP = 2560;
constexpr int ML = NB * SEQ, MC = NB * CTXL, MT = ML + MC;
constexpr int NCHUNK = 36;
constexpr float EPS = 1e-6f;
constexpr float QSCALE = 0.125f * 1.4426950408889634f;
constexpr int PC_Q = 0, PC_K = 512, PC_V = 640, PC_QM = 768, PC_KM = 1024, PC_VM = 1280, PC_OM = 1536, PC_UC = 1792, PC_VC = 2048;
constexpr size_t MiB = 1u << 20;
constexpr size_t WS_CTL = 0, CTL_ZERO_BYTES = 65536, WS_ROPE = 32768, WS_SHW1 = 65536, WS_ROWSS = 2816 * 1024, WS_SHW2 = 3328 * 1024;
constexpr size_t WS_MOD = 1 * MiB, WS_WIN = 6 * MiB, WS_WOUT = 26 * MiB, WS_WUP = 34 * MiB, WS_WDOWN = 78 * MiB;
constexpr size_t WS_XC = 100 * MiB, WS_H = 116 * MiB, WS_PROJ = 188 * MiB, WS_GATES = 350 * MiB, WS_MIX = 353 * MiB;
constexpr size_t WS_MSC = 425 * MiB, WS_MSN = 497 * MiB, WS_MSS = 499 * MiB, WS_END = 500 * MiB;
constexpr size_t WS_ACT = 188 * MiB, WS_EDGE = 386 * MiB;
static_assert(WS_ACT + (size_t)MT * DFF * 2 <= WS_EDGE && WS_EDGE + (size_t)(MT / 64) * 2 * 4 * DFF * 4 <= WS_MSN, "ffn overlay");
static_assert(WS_SHW1 + (size_t)4 * 17 * 2560 * 4 <= WS_MOD && WS_MOD + (size_t)4 * 17 * 6144 * 4 <= WS_ROWSS && WS_ROWSS + (size_t)2 * 36864 * 4 <= WS_SHW2 && WS_SHW2 + (size_t)4 * 17 * 5632 * 4 <= WS_WIN, "ws map lo");
static_assert(WS_PROJ + (size_t)MT * NPROJ * 2 <= WS_GATES && WS_MIX + (size_t)MT * DM * 2 <= WS_MSC && WS_MSC + (size_t)128 * NCHUNK * 4096 * 4 <= WS_MSN, "ws map");

constexpr int NWAVES = 8, NTHREADS = 512;
constexpr int RING_BYTES = 131072, LDS_BYTES = 147456;

typedef unsigned short bf16;
typedef float f32x4 __attribute__((ext_vector_type(4)));
typedef float f32x2 __attribute__((ext_vector_type(2)));
typedef short bf16x8 __attribute__((ext_vector_type(8)));
typedef unsigned u32x4 __attribute__((ext_vector_type(4)));
typedef unsigned u32x2 __attribute__((ext_vector_type(2)));

__device__ __forceinline__ unsigned f2bf(float f) { unsigned u = __builtin_bit_cast(unsigned, f); return (u + 0x7fffu + ((u >> 16) & 1u)) >> 16; }
__device__ __forceinline__ unsigned pk2(float lo, float hi) { return f2bf(lo) | (f2bf(hi) << 16); }
__device__ __forceinline__ float bf2f(unsigned u16) { return __uint_as_float(u16 << 16); }
__device__ __forceinline__ float bflo(unsigned w) { return __uint_as_float(w << 16); }
__device__ __forceinline__ float bfhi(unsigned w) { return __uint_as_float(w & 0xffff0000u); }
__device__ __forceinline__ float silu_f(float x) { return x / (1.f + __expf(-x)); }
__device__ __forceinline__ float sigmoid_f(float x) { return 1.f / (1.f + __expf(-x)); }
__device__ __forceinline__ float gelu_tanh(float x) { const float u = 0.7978845608028654f * (x + 0.044715f * x * x * x); const float e = __expf(2.f * u); const float t = 1.f - 2.f / (e + 1.f); return 0.5f * x * (1.f + t); }
__device__ __forceinline__ float logsig(float x) { return fminf(x, 0.f) - log1pf(__expf(-fabsf(x))); }
__device__ __forceinline__ float bperm(float v, int src) { return __builtin_bit_cast(float, __builtin_amdgcn_ds_bpermute(src << 2, __builtin_bit_cast(int, v))); }
__device__ __forceinline__ float wave_sum(float v, int lane) {
#pragma unroll
    for (int o = 1; o < 64; o <<= 1) v += bperm(v, lane ^ o);
    return v;
}
__device__ __forceinline__ float wave_max(float v, int lane) {
#pragma unroll
    for (int o = 1; o < 64; o <<= 1) v = fmaxf(v, bperm(v, lane ^ o));
    return v;
}
__device__ __forceinline__ float scan_add_fwd(float v, int lane) {
#pragma unroll
    for (int o = 1; o < 64; o <<= 1) { const float t = bperm(v, lane >= o ? lane - o : lane); if (lane >= o) v += t; }
    return v;
}
__device__ __forceinline__ float scan_add_bwd(float v, int lane) {
#pragma unroll
    for (int o = 1; o < 64; o <<= 1) { const float t = bperm(v, lane + o < 64 ? lane + o : lane); if (lane + o < 64) v += t; }
    return v;
}
__device__ __forceinline__ float scan_max_fwd(float v, int lane) {
#pragma unroll
    for (int o = 1; o < 64; o <<= 1) { const float t = bperm(v, lane >= o ? lane - o : lane); if (lane >= o) v = fmaxf(v, t); }
    return v;
}
__device__ __forceinline__ float scan_max_bwd(float v, int lane) {
#pragma unroll
    for (int o = 1; o < 64; o <<= 1) { const float t = bperm(v, lane + o < 64 ? lane + o : lane); if (lane + o < 64) v = fmaxf(v, t); }
    return v;
}
__device__ __forceinline__ f32x4 mma16(const bf16* A, int lda, const bf16* Bt, int ldb, int K, int mt, int nt, int lane, f32x4 acc) {
    const bf16* ap = A + (16 * mt + (lane & 15)) * lda + (lane >> 4) * 8;
    const bf16* bp = Bt + (16 * nt + (lane & 15)) * ldb + (lane >> 4) * 8;
    for (int k0 = 0; k0 < K; k0 += 32) {
        const bf16x8 a = *(const bf16x8*)(ap + k0), b = *(const bf16x8*)(bp + k0);
        acc = __builtin_amdgcn_mfma_f32_16x16x32_bf16(a, b, acc, 0, 0, 0);
    }
    return acc;
}

__device__ __forceinline__ int launder(int v) { asm volatile("" : "+v"(v)); return v; }
__device__ __forceinline__ int fresh_lane() { int l; asm volatile("v_mbcnt_lo_u32_b32 %0, -1, 0\n\tv_mbcnt_hi_u32_b32 %0, -1, %0" : "=v"(l)); return l; }
__device__ __forceinline__ int launder_s(int v) { asm volatile("" : "+s"(v)); return v; }
struct Args { const float* in[21]; float* out; unsigned char* ws; };
enum { I_X = 0, I_C, I_CTX, I_CCTX, I_WADA, I_BADA, I_GN1, I_WIN, I_BIN, I_GQ, I_GK, I_GMH, I_GV, I_WSP, I_BSP, I_WOUT, I_GN2, I_WUP, I_CONVW, I_CONVB, I_WDOWN };

__device__ __forceinline__ int win_src_col(int n) {
    if (n >= NPROJ) return n < NPROJ + 16 ? 1792 + (n - NPROJ) : -1;
    const int pn = n >> 8, c = n & 255, bj = c >> 7, wc = (c >> 5) & 3, j = c & 31;
    if (pn < 2 || (pn == 2 && wc < 2)) { const int hb = pn < 2 ? (4 * pn + wc) * 64 : 512 + wc * 64; return hb + 32 * bj + 16 * ((j >> 2) & 1) + 4 * (j >> 3) + (j & 3); }
    if (pn == 2) return 640 + 64 * (wc - 2) + 32 * bj + j;
    return n + (n >= 1792 ? 16 : 0);
}
__device__ __forceinline__ void p0_transpose_item(const float* W, int ldw, int K, bf16* WT, int k0, int src_col_lane, int dst_row0, float* scr, int lane) {
#pragma unroll 8
    for (int i = 0; i < 32; ++i) { const int kk = 2 * i + (lane >> 5); scr[kk * 33 + (lane & 31)] = W[(size_t)(k0 + kk) * ldw + src_col_lane]; }
    asm volatile("s_waitcnt lgkmcnt(0)" ::: "memory");
    const int c = lane & 7;
#pragma unroll
    for (int j = 0; j < 4; ++j) { const int n = (lane >> 3) + 8 * j; const float* s = scr + (8 * c) * 33 + n;
        u32x4 o; o.x = pk2(s[0 * 33], s[1 * 33]); o.y = pk2(s[2 * 33], s[3 * 33]); o.z = pk2(s[4 * 33], s[5 * 33]); o.w = pk2(s[6 * 33], s[7 * 33]);
        *(u32x4*)(WT + (size_t)(dst_row0 + n) * K + k0 + 8 * c) = o; }
    asm volatile("s_waitcnt lgkmcnt(0)" ::: "memory");
}

__device__ __forceinline__ void p0_prologue(const Args& a, unsigned char* lds, int tid, int lane, int wave, int G) {
    unsigned char* ws = a.ws;
    {
        float* scr = (float*)(lds + wave * 16384);
        const int gw = blockIdx.x * NWAVES + wave, NGW = G * NWAVES;
        constexpr int I_IN = 16 * 73, I_OUT = 16 * 32, I_UP = 16 * 176, I_DN = 44 * 32, I_L = I_IN + I_OUT + I_UP + I_DN;
        for (int it = gw; it < DEPTH * I_L; it += NGW) {
            const int l = it / I_L; int r = it % I_L;
            if (r < I_IN) { const int kb = r / 73, nb = r % 73, n0 = 32 * nb;
                p0_transpose_item(a.in[I_WIN] + (size_t)l * DM * DIN, DIN, DM, (bf16*)(ws + WS_WIN) + (size_t)l * NPROJP * DM, 64 * kb, max(win_src_col(n0 + (lane & 31)), 0), n0, scr, lane); continue; } r -= I_IN;
            if (r < I_OUT) { const int kb = r / 32, nb = r % 32;
                p0_transpose_item(a.in[I_WOUT] + (size_t)l * DM * DM, DM, DM, (bf16*)(ws + WS_WOUT) + (size_t)l * DM * DM, 64 * kb, 32 * nb + (lane & 31), 32 * nb, scr, lane); continue; } r -= I_OUT;
            if (r < I_UP) { const int kb = r / 176, nb = r % 176;
                const int n0 = 32 * nb, src = ((n0 >> 7) & 1) * DFF + (n0 >> 8) * 128 + (n0 & 127);
                p0_transpose_item(a.in[I_WUP] + (size_t)l * DM * 2 * DFF, 2 * DFF, DM, (bf16*)(ws + WS_WUP) + (size_t)l * 2 * DFF * DM, 64 * kb, src + (lane & 31), n0, scr, lane); continue; } r -= I_UP;
            { const int kb = r / 32, nb = r % 32;
                p0_transpose_item(a.in[I_WDOWN] + (size_t)l * DFF * DM, DM, DFF, (bf16*)(ws + WS_WDOWN) + (size_t)l * DM * DFF, 64 * kb, 32 * nb + (lane & 31), 32 * nb, scr, lane); }
        }
        for (int i = blockIdx.x * NTHREADS + tid; i < 1024; i += G * NTHREADS) { const int pos = i >> 4, f = i & 15; const float inv = powf(10000.f, -(float)f / 16.f); float sn_, cs_; sincosf((float)pos * inv, &sn_, &cs_);
            ((float*)(ws + WS_ROPE))[i] = cs_; ((float*)(ws + WS_ROPE))[1024 + i] = sn_; }
        for (int i = blockIdx.x * NTHREADS + tid; i < DEPTH * 224 * (DM / 8); i += G * NTHREADS) { const int l = i / (224 * 128), r2 = (i / 128) % 224, c8 = (i % 128) * 8;
            *(u32x4*)((bf16*)(ws + WS_WIN) + ((size_t)l * NPROJP + 2336 + r2) * DM + c8) = (u32x4){0u, 0u, 0u, 0u}; }
    }
    __syncthreads();
    {
        float* sc = (float*)lds;
        float* red = (float*)(lds + 73728);
        for (int i = tid; i < 17 * DM; i += NTHREADS) { const int bi = i >> 10, k = i & 1023; const float v = bi < 16 ? a.in[I_C][bi * DM + k] : a.in[I_CCTX][k]; sc[i] = silu_f(v); }
        __syncthreads();
        float* mod = (float*)(ws + WS_MOD);
        const int cl = tid & 31, kp = tid >> 5;
        for (int grp = blockIdx.x; grp < DEPTH * 192; grp += G) {
            const int l = grp / 192, col = (grp % 192) * 32 + cl;
            const float* w = a.in[I_WADA] + (size_t)l * DM * 6144 + col;
            float acc[17];
#pragma unroll
            for (int b = 0; b < 17; ++b) acc[b] = 0.f;
#pragma unroll 4
            for (int k = kp * 64; k < kp * 64 + 64; ++k) { const float wv = w[(size_t)k * 6144];
#pragma unroll
                for (int b = 0; b < 17; ++b) acc[b] += sc[b * DM + k] * wv; }
#pragma unroll
            for (int b = 0; b < 17; ++b) red[(kp * 17 + b) * 32 + cl] = acc[b];
            __syncthreads();
            for (int i = tid; i < 17 * 32; i += NTHREADS) { const int b = i >> 5, c2 = i & 31; float s = 0.f;
#pragma unroll
                for (int p = 0; p < 16; ++p) s += red[(p * 17 + b) * 32 + c2];
                const int cc = (grp % 192) * 32 + c2; mod[((size_t)l * 17 + b) * 6144 + cc] = s + a.in[I_BADA][l * 6144 + cc]; }
            __syncthreads();
        }
    }
}

template <bool GATES>
__device__ __forceinline__ void norm_phase(const float* xl, const float* xc, const float* gnorm, const float* modl, int sh_off, int s_off, bf16* H, int nrows,
                                           const float* w_in_l, const float* b_in_l, float* gates, unsigned char* lds, int tid, int lane, int wave, int G) {
    float* wg = (float*)lds;
    if (GATES) {
        for (int idx = tid; idx < 16384; idx += NTHREADS) { const int k = idx >> 4, g = idx & 15; const int slot = ((k & 255) >> 2) + 64 * (4 * (k >> 8) + (k & 3));
            wg[slot * 20 + g] = w_in_l[(size_t)k * DIN + 1792 + g]; }
        __syncthreads();
    }
    const int gw = blockIdx.x * NWAVES + wave, NGW = G * NWAVES;
    f32x4 gn[4];
#pragma unroll
    for (int j = 0; j < 4; ++j) gn[j] = *(const f32x4*)(gnorm + 4 * lane + 256 * j);
    for (int r = gw; r < nrows; r += NGW) {
        const bool isctx = r >= ML; const int bi = isctx ? 16 : (r >> 11);
        const float* xr = isctx ? xc + (size_t)(r - ML) * DM : xl + (size_t)r * DM;
        f32x4 v[4]; float ss = 0.f;
#pragma unroll
        for (int j = 0; j < 4; ++j) { v[j] = *(const f32x4*)(xr + 4 * lane + 256 * j); ss += (v[j].x * v[j].x + v[j].y * v[j].y) + (v[j].z * v[j].z + v[j].w * v[j].w); }
        const float rstd = rsqrtf(wave_sum(ss, lane) * (1.f / DM) + EPS);
        const float* mv = modl + bi * 6144;
        bf16* hr = H + (size_t)r * DM;
#pragma unroll
        for (int j = 0; j < 4; ++j) {
            const f32x4 sv = *(const f32x4*)(mv + s_off + 4 * lane + 256 * j), sh = *(const f32x4*)(mv + sh_off + 4 * lane + 256 * j);
            v[j] = v[j] * rstd * gn[j] * (1.f + sv) + sh;
            u32x2 o; o.x = pk2(v[j].x, v[j].y); o.y = pk2(v[j].z, v[j].w);
            *(u32x2*)(hr + 4 * lane + 256 * j) = o;
        }
        if (GATES) {
            f32x4 ga[4];
#pragma unroll
            for (int q = 0; q < 4; ++q) ga[q] = (f32x4){0.f, 0.f, 0.f, 0.f};
#pragma unroll
            for (int j = 0; j < 4; ++j)
#pragma unroll
                for (int e = 0; e < 4; ++e) { const float hv = v[j][e]; const float* wp = wg + (lane + 64 * (4 * j + e)) * 20;
#pragma unroll
                    for (int q = 0; q < 4; ++q) ga[q] += hv * *(const f32x4*)(wp + 4 * q);
                    if (e & 1) asm volatile("" ::: "memory"); }
#pragma unroll
            for (int q = 0; q < 4; ++q)
#pragma unroll
                for (int e = 0; e < 4; ++e) ga[q][e] = wave_sum(ga[q][e], lane);
            if (lane == 0) {
#pragma unroll
                for (int q = 0; q < 4; ++q) *(f32x4*)(gates + (size_t)r * 16 + 4 * q) = ga[q] + *(const f32x4*)(b_in_l + 1792 + 4 * q);
            }
        }
    }
}

__device__ __forceinline__ void shw_phase(const Args& a, unsigned char* lds, int tid, int G) {
    unsigned char* ws = a.ws;
    float* sc = (float*)lds;
    float* red = (float*)(lds + 73728);
    const float* mod = (const float*)(ws + WS_MOD);
    const int cl = tid & 31, kp = tid >> 5;
    for (int grp = blockIdx.x; grp < DEPTH * 256; grp += G) {
        const int l = grp >> 8, r = grp & 255, which = r >= 80 ? 1 : 0, n0 = (which ? r - 80 : r) * 32;
        for (int i = tid; i < 17 * DM; i += NTHREADS) sc[i] = mod[((size_t)l * 17 + (i >> 10)) * 6144 + (which ? 3072 : 0) + (i & 1023)];
        __syncthreads();
        const float* W; int ldw, src; bool live = true;
        if (which == 0) { W = a.in[I_WIN] + (size_t)l * DM * DIN; ldw = DIN; src = win_src_col(n0 + cl); live = src >= 0; }
        else { W = a.in[I_WUP] + (size_t)l * DM * 2 * DFF; ldw = 2 * DFF; src = ((n0 >> 7) & 1) * DFF + (n0 >> 8) * 128 + (n0 & 127) + cl; }
        float acc[17];
#pragma unroll
        for (int b = 0; b < 17; ++b) acc[b] = 0.f;
        if (live) {
            const float* w = W + src;
#pragma unroll 4
            for (int k = kp * 64; k < kp * 64 + 64; ++k) { const float wv = w[(size_t)k * ldw];
#pragma unroll
                for (int b = 0; b < 17; ++b) acc[b] += sc[b * DM + k] * wv; }
        }
#pragma unroll
        for (int b = 0; b < 17; ++b) red[(kp * 17 + b) * 32 + cl] = acc[b];
        __syncthreads();
        for (int i = tid; i < 17 * 32; i += NTHREADS) { const int b = i >> 5, c2 = i & 31; float sum = 0.f;
#pragma unroll
            for (int p = 0; p < 16; ++p) sum += red[(p * 17 + b) * 32 + c2];
            const int n = n0 + c2;
            if (which == 0) { const int sc_ = win_src_col(n); const float bias = sc_ >= 0 ? a.in[I_BIN][l * DIN + sc_] : 0.f;
                ((float*)(ws + WS_SHW1))[((size_t)l * 17 + b) * NPROJP + n] = sum + bias; }
            else ((float*)(ws + WS_SHW2))[((size_t)l * 17 + b) * 2 * DFF + n] = sum; }
        __syncthreads();
    }
}

__device__ __forceinline__ void norm0_phase(const float* xl, const float* xc, const float* gnorm, const float* modl, int s_off, bf16* H, float* rowss, int tid, int lane, int wave, int G) {
    const int gw = blockIdx.x * NWAVES + wave, NGW = G * NWAVES;
    f32x4 gn[4];
#pragma unroll
    for (int j = 0; j < 4; ++j) gn[j] = *(const f32x4*)(gnorm + 4 * lane + 256 * j);
    for (int r = gw; r < MT; r += NGW) {
        const bool isctx = r >= ML; const int bi = isctx ? 16 : (r >> 11);
        const float* xr = isctx ? xc + (size_t)(r - ML) * DM : xl + (size_t)r * DM;
        f32x4 v[4]; float ss = 0.f;
#pragma unroll
        for (int j = 0; j < 4; ++j) { v[j] = *(const f32x4*)(xr + 4 * lane + 256 * j); ss += (v[j].x * v[j].x + v[j].y * v[j].y) + (v[j].z * v[j].z + v[j].w * v[j].w); }
        ss = wave_sum(ss, lane);
        const float* mv = modl + bi * 6144;
        bf16* hr = H + (size_t)r * DM;
#pragma unroll
        for (int j = 0; j < 4; ++j) {
            const f32x4 sv = *(const f32x4*)(mv + s_off + 4 * lane + 256 * j);
            v[j] = v[j] * gn[j] * (1.f + sv);
            u32x2 o; o.x = pk2(v[j].x, v[j].y); o.y = pk2(v[j].z, v[j].w);
            *(u32x2*)(hr + 4 * lane + 256 * j) = o;
        }
        if (lane == 0) rowss[r] = ss;
    }
}

__device__ __forceinline__ void ctxfin_phase(const float* xbase, float* xc, const float* slab, const float* g2c, const float* gn1n, const float* s1cn, bf16* Hctx, float* rowss_ctx, int lane, int wave, int G) {
    const int gw = blockIdx.x * NWAVES + wave, NGW = G * NWAVES;
    for (int r = gw; r < MC; r += NGW) {
        float* xr = xc + (size_t)r * DM; const float* xb = xbase + (size_t)r * DM; f32x4 v[4]; float ss = 0.f;
#pragma unroll
        for (int j = 0; j < 4; ++j) { const int c = 4 * lane + 256 * j; const float* sp = slab + (size_t)r * DM + c;
            const f32x4 sum = (*(const f32x4*)sp + *(const f32x4*)(sp + (size_t)MC * DM)) + (*(const f32x4*)(sp + (size_t)2 * MC * DM) + *(const f32x4*)(sp + (size_t)3 * MC * DM));
            v[j] = *(const f32x4*)(xb + c) + *(const f32x4*)(g2c + c) * sum; *(f32x4*)(xr + c) = v[j];
            ss += (v[j].x * v[j].x + v[j].y * v[j].y) + (v[j].z * v[j].z + v[j].w * v[j].w); }
        ss = wave_sum(ss, lane);
#pragma unroll
        for (int j = 0; j < 4; ++j) { const int c = 4 * lane + 256 * j; const f32x4 a = v[j] * *(const f32x4*)(gn1n + c) * (1.f + *(const f32x4*)(s1cn + c));
            u32x2 o; o.x = pk2(a.x, a.y); o.y = pk2(a.z, a.w); *(u32x2*)(Hctx + (size_t)r * DM + c) = o; }
        if (lane == 0) rowss_ctx[r] = ss;
    }
}

__device__ __forceinline__ int chunk_row(int b, int cf, int t) { return cf < 4 ? ML + b * CTXL + cf * 64 + t : b * SEQ + (cf - 4) * 64 + t; }

__device__ __forceinline__ void postproj_phase(bf16* proj, const float* gq, const float* gk, unsigned char* lds, int tid, int G, bf16* dryb = nullptr) {
    float* cs = (float*)lds; float* sn = cs + 1024;
    for (int i = tid; i < 1024; i += NTHREADS) { const int pos = i >> 4, f = i & 15; const float inv = powf(10000.f, -(float)f / 16.f); float s, c; sincosf((float)pos * inv, &s, &c); cs[i] = c; sn[i] = s; }
    __syncthreads();
    const int nth = G * NTHREADS, lane = tid & 63;
    for (int idx = blockIdx.x * NTHREADS + tid; idx < MT * 40; idx += nth) {
        const int j = idx & 3, hh = (idx >> 2) % 10, row = (idx >> 2) / 10;
        const int axis = j >> 1, fh = j & 1;
        const bool isq = hh < 8;
        bf16* p = proj + (size_t)row * NPROJ + (isq ? PC_Q + hh * 64 : PC_K + (hh - 8) * 64) + axis * 32 + fh * 8;
        const u32x4 r1 = *(const u32x4*)p, r2 = *(const u32x4*)(p + 16);
        float x1[8], x2[8];
#pragma unroll
        for (int e = 0; e < 4; ++e) { x1[2 * e] = bflo(r1[e]); x1[2 * e + 1] = bfhi(r1[e]); x2[2 * e] = bflo(r2[e]); x2[2 * e + 1] = bfhi(r2[e]); }
        float ss = 0.f;
#pragma unroll
        for (int e = 0; e < 8; ++e) ss += x1[e] * x1[e] + x2[e] * x2[e];
        ss += bperm(ss, lane ^ 1); ss += bperm(ss, lane ^ 2);
        const float rstd = rsqrtf(ss * (1.f / 64.f) + EPS);
        const float* g = isq ? gq : gk;
        const bool lat = row < ML;
        const int pos = row & (SEQ - 1); const int pa = axis == 0 ? (pos >> 6) : (pos & 63);
        const float sc = isq ? QSCALE : 1.f;
        float o1[8], o2[8];
#pragma unroll
        for (int e = 0; e < 8; ++e) {
            const float y1 = x1[e] * rstd * g[axis * 32 + fh * 8 + e], y2 = x2[e] * rstd * g[axis * 32 + 16 + fh * 8 + e];
            float c = 1.f, s = 0.f; if (lat) { c = cs[pa * 16 + fh * 8 + e]; s = sn[pa * 16 + fh * 8 + e]; }
            o1[e] = (y1 * c - y2 * s) * sc; o2[e] = (y2 * c + y1 * s) * sc;
        }
        u32x4 w1, w2;
#pragma unroll
        for (int e = 0; e < 4; ++e) { w1[e] = pk2(o1[2 * e], o1[2 * e + 1]); w2[e] = pk2(o2[2 * e], o2[2 * e + 1]); }
        bf16* pd = dryb ? dryb + (((size_t)idx * 32) & ((32u << 20) - 1)) : p;
        *(u32x4*)pd = w1; *(u32x4*)(pd + 16) = w2;
    }
    __syncthreads();
}

__device__ __forceinline__ void mlstm_local_phase(const bf16* proj, const float* gates, float* msc, float* msn, float* mss, unsigned char* lds, int tid, int lane, int wave, int G) {
    bf16* VT = (bf16*)lds;
    bf16* KF = VT + 64 * 72;
    bf16* KB_ = KF + 64 * 72;
    float* wv = (float*)(lds + 3 * 64 * 72 * 2);
    u32x4 pkr, pvr; float pig = 0.f, pfg = 0.f;
#define M1_ISSUE(T) do { const int cf_ = (T) % NCHUNK, h_ = ((T) / NCHUNK) & 3, b_ = (T) / (NCHUNK * 4); \
        const bf16* rp_ = proj + (size_t)chunk_row(b_, cf_, tid >> 3) * NPROJ + h_ * 64 + (tid & 7) * 8; pkr = *(const u32x4*)(rp_ + PC_KM); pvr = *(const u32x4*)(rp_ + PC_VM); \
        if (wave < 2) { const int row_ = chunk_row(b_, cf_, lane); pig = gates[(size_t)row_ * 16 + wave * 8 + h_]; pfg = gates[(size_t)row_ * 16 + wave * 8 + 4 + h_]; } } while (0)
    if ((int)blockIdx.x < NB * 4 * NCHUNK) M1_ISSUE((int)blockIdx.x);
    for (int task = blockIdx.x; task < NB * 4 * NCHUNK; task += G) {
        const int cf = task % NCHUNK, h = (task / NCHUNK) & 3, b = task / (NCHUNK * 4);
        const int sid0 = (b * 4 + h) * 2;
        if (wave < 2) {
            const float ig = pig, fg = pfg;
            const float ls = logsig(fg);
            float g, tot;
            if (wave == 0) { const float inc = scan_add_fwd(ls, lane); tot = bperm(inc, 63); g = tot - inc + ig; }
            else { const float inc = scan_add_bwd(ls, lane); tot = bperm(inc, 0); g = tot - inc + ig; }
            const float ml = wave_max(g, lane);
            wv[wave * 64 + lane] = __expf(g - ml) * 0.125f;
            if (lane == 0) { const int c = wave == 0 ? cf : (cf < 4 ? 3 - cf : 39 - cf); const int si = (sid0 + wave) * NCHUNK + c; mss[si] = ml; mss[128 * NCHUNK + si] = tot; }
        }
        const int s = tid >> 3, d8 = (tid & 7) * 8;
        const u32x4 kr = pkr, vr = pvr;
        __syncthreads();
        if (task + G < NB * 4 * NCHUNK) M1_ISSUE(task + G);
        const float wf = wv[s], wb = wv[64 + s];
#pragma unroll
        for (int e = 0; e < 4; ++e) {
            const float k0 = bflo(kr[e]), k1 = bfhi(kr[e]);
            VT[(d8 + 2 * e) * 72 + s] = (bf16)(vr[e] & 0xffffu); VT[(d8 + 2 * e + 1) * 72 + s] = (bf16)(vr[e] >> 16);
            KF[(d8 + 2 * e) * 72 + s] = (bf16)f2bf(k0 * wf); KF[(d8 + 2 * e + 1) * 72 + s] = (bf16)f2bf(k1 * wf);
            KB_[(d8 + 2 * e) * 72 + s] = (bf16)f2bf(k0 * wb); KB_[(d8 + 2 * e + 1) * 72 + s] = (bf16)f2bf(k1 * wb);
        }
        __syncthreads();
        const int cb = cf < 4 ? 3 - cf : 39 - cf;
        if (tid < 128) { const int dk = tid & 63, dir = tid >> 6; const bf16* kp = (dir ? KB_ : KF) + dk * 72; float sum = 0.f;
#pragma unroll 8
            for (int ss = 0; ss < 64; ++ss) sum += bf2f(kp[ss]);
            msn[((size_t)(sid0 + dir) * NCHUNK + (dir ? cb : cf)) * 64 + dk] = sum; }
        const int mt = wave >> 1, nt0 = 2 * (wave & 1);
#pragma unroll
        for (int dir = 0; dir < 2; ++dir) {
            bf16* dst = (bf16*)msc + ((size_t)(sid0 + dir) * NCHUNK + (dir ? cb : cf)) * 4096;
#pragma unroll
            for (int j = 0; j < 2; ++j) {
                const f32x4 acc = mma16(dir ? KB_ : KF, 72, VT, 72, 64, mt, nt0 + j, lane, (f32x4){0.f, 0.f, 0.f, 0.f});
                u32x2 o; o.x = pk2(acc[0], acc[1]); o.y = pk2(acc[2], acc[3]);
                *(u32x2*)(dst + (16 * (nt0 + j) + (lane & 15)) * 64 + 16 * mt + 4 * (lane >> 4)) = o;
            }
        }
        __syncthreads();
    }
}

__device__ __forceinline__ void mlstm_scan_phase(float* msc, float* msn, float* mss, bf16* dstc, float* dstn, float* dstm, int tid, int G) {
    const float* mloc = mss; const float* Gd = mss + 128 * NCHUNK; float* mprev = dstm;
    for (int w = blockIdx.x * NTHREADS + tid; w < 128 * 1024; w += G * NTHREADS) {
        const int sid = w >> 10, e4 = w & 1023;
        const u32x2* cp = (const u32x2*)((const bf16*)msc + (size_t)sid * NCHUNK * 4096) + e4;
        f32x4* np = (f32x4*)(msn + (size_t)sid * NCHUNK * 64) + (e4 & 15);
        u32x2* cpd = (u32x2*)(dstc + (size_t)sid * NCHUNK * 4096) + e4; f32x4* npd = (f32x4*)(dstn + (size_t)sid * NCHUNK * 64) + (e4 & 15);
        const bool don = e4 < 16;
        float m = 0.f; f32x4 C = (f32x4){0.f, 0.f, 0.f, 0.f}, N = C;
#pragma unroll 12
        for (int c = 0; c < NCHUNK; ++c) {
            const u32x2 sw_ = cp[(size_t)c * 1024]; const f32x4 S = (f32x4){bflo(sw_.x), bfhi(sw_.x), bflo(sw_.y), bfhi(sw_.y)};
            f32x4 nl = (f32x4){0.f, 0.f, 0.f, 0.f}; if (don) nl = np[c * 16];
            const float gd = Gd[sid * NCHUNK + c], ml = mloc[sid * NCHUNK + c];
            { u32x2 cw_; cw_.x = pk2(C.x, C.y); cw_.y = pk2(C.z, C.w); cpd[(size_t)c * 1024] = cw_; }
            if (don) npd[c * 16] = N;
            if (e4 == 0) mprev[sid * NCHUNK + c] = m;
            const float mn = fmaxf(gd + m, ml); const float aa = __expf(gd + m - mn), bb = __expf(ml - mn);
            C = aa * C + bb * S; N = aa * N + bb * nl; m = mn;
        }
    }
}

__device__ __forceinline__ void mlstm_out_phase(const bf16* proj, const float* gates, const bf16* cpb, const float* msn, const float* mss, const float* gmh, bf16* mix, bool need_ctx,
                                                unsigned char* lds, int tid, int lane, int wave, int G) {
    bf16* QS = (bf16*)lds;
    bf16* KS = QS + 64 * 72;
    bf16* AX = (bf16*)(lds + 18432);
    bf16* BX = (bf16*)(lds + 44032);
    float* vec = (float*)(lds + 69632);
    float* HS = (float*)lds;
    float* bm = vec, *us = vec + 128, *wi = vec + 256, *emt = vec + 384, *qn = vec + 512, *dsum = vec + 640, *rr = vec + 768, *al = vec + 896, *nv = vec + 1024;
    const float* mprev = mss + 2 * 128 * NCHUNK;
    const int c0 = need_ctx ? 0 : 4, nper = NCHUNK - c0;
    u32x4 pq, pk, pv, po, pcf, pcb; float pig = 0.f, pfg = 0.f, pmp = 0.f, pn0 = 0.f, pn1 = 0.f;
#define M3_ISSUE(T) do { const int cf_ = c0 + (T) % nper, h_ = ((T) / nper) & 3, b_ = (T) / (nper * 4); const int cb2_ = cf_ < 4 ? 3 - cf_ : 39 - cf_; const int s_ = tid >> 3, d8_ = (tid & 7) * 8; \
        const bf16* rp_ = proj + (size_t)chunk_row(b_, cf_, s_) * NPROJ + h_ * 64 + d8_; pq = *(const u32x4*)(rp_ + PC_QM); pk = *(const u32x4*)(rp_ + PC_KM); pv = *(const u32x4*)(rp_ + PC_VM); po = *(const u32x4*)(rp_ + PC_OM); \
        { const size_t stf_ = (size_t)((b_ * 4 + h_) * 2) * NCHUNK + cf_, stb_ = (size_t)((b_ * 4 + h_) * 2 + 1) * NCHUNK + cb2_; \
          if (wave < 2) { const int row_ = chunk_row(b_, cf_, lane); pig = gates[(size_t)row_ * 16 + wave * 8 + h_]; pfg = gates[(size_t)row_ * 16 + wave * 8 + 4 + h_]; pmp = mprev[wave == 0 ? stf_ : stb_]; } \
          else if (wave == 3) { pn0 = msn[stf_ * 64 + lane]; pn1 = msn[stb_ * 64 + lane]; } } \
        pcf = *(const u32x4*)(cpb + ((size_t)((b_ * 4 + h_) * 2) * NCHUNK + cf_) * 4096 + s_ * 64 + d8_); pcb = *(const u32x4*)(cpb + ((size_t)((b_ * 4 + h_) * 2 + 1) * NCHUNK + cb2_) * 4096 + s_ * 64 + d8_); } while (0)
    if ((int)blockIdx.x < NB * 4 * nper) M3_ISSUE((int)blockIdx.x);
    for (int task = blockIdx.x; task < NB * 4 * nper; task += G) {
        const int cf = c0 + task % nper, h = (task / nper) & 3, b = task / (nper * 4);
        const int cb = cf < 4 ? 3 - cf : 39 - cf;
        const int sid0 = (b * 4 + h) * 2;
        const size_t stf = (size_t)sid0 * NCHUNK + cf, stb = (size_t)(sid0 + 1) * NCHUNK + cb;
        if (wave < 2) {
            const float ig = pig, fg = pfg;
            const float ls = logsig(fg);
            float inc, rmax; const float mp = pmp;
            if (wave == 0) { inc = scan_add_fwd(ls, lane); rmax = scan_max_fwd(ig - inc, lane); }
            else { inc = scan_add_bwd(ls, lane); rmax = scan_max_bwd(ig - inc, lane); }
            const float minter = inc + mp, mt_ = fmaxf(minter, inc + rmax);
            bm[wave * 64 + lane] = inc - mt_; us[wave * 64 + lane] = ig - inc; wi[wave * 64 + lane] = __expf(minter - mt_); emt[wave * 64 + lane] = __expf(-mt_);
        } else if (wave == 2) { dsum[lane] = 0.f; dsum[64 + lane] = 0.f; }
        else if (wave == 3) { nv[lane] = pn0; nv[64 + lane] = pn1; }
        const u32x4 ov = po;
        {
            const int s = tid >> 3, d8 = (tid & 7) * 8;
            const u32x4 qr = pq, kr = pk, vr = pv;
            *(u32x4*)(QS + s * 72 + d8) = qr; *(u32x4*)(KS + s * 72 + d8) = kr;
#pragma unroll
            for (int e = 0; e < 4; ++e) { BX[(d8 + 2 * e) * 200 + s] = (bf16)(vr[e] & 0xffffu); BX[(d8 + 2 * e + 1) * 200 + s] = (bf16)(vr[e] >> 16); }
            *(u32x4*)(BX + s * 200 + 64 + d8) = pcf; *(u32x4*)(BX + s * 200 + 128 + d8) = pcb;
        }
        __syncthreads();
        if (task + G < NB * 4 * nper) M3_ISSUE(task + G);
        if (tid < 128) { const int t = tid & 63, dir = tid >> 6; const bf16* qp = QS + t * 72; const float* np = nv + dir * 64; float sum = 0.f;
#pragma unroll 8
            for (int d = 0; d < 64; ++d) sum += bf2f(qp[d]) * np[d];
            qn[dir * 64 + t] = sum; }
        const int mt = wave >> 1, nt0 = 2 * (wave & 1);
        float Af[2][4], Ab[2][4];
#pragma unroll
        for (int j = 0; j < 2; ++j) {
            const f32x4 acc = mma16(QS, 72, KS, 72, 64, mt, nt0 + j, lane, (f32x4){0.f, 0.f, 0.f, 0.f});
            const int s = 16 * (nt0 + j) + (lane & 15);
            const float usf = us[s], usb = us[64 + s];
#pragma unroll
            for (int i = 0; i < 4; ++i) { const int t = 16 * mt + 4 * (lane >> 4) + i; const float sv = acc[i] * 0.125f;
                Af[j][i] = (s <= t) ? sv * __expf(bm[t] + usf) : 0.f;
                Ab[j][i] = (s >= t) ? sv * __expf(bm[64 + t] + usb) : 0.f; }
        }
#pragma unroll
        for (int i = 0; i < 4; ++i) {
            float pf = Af[0][i] + Af[1][i], pb = Ab[0][i] + Ab[1][i];
#pragma unroll
            for (int o = 1; o < 16; o <<= 1) { pf += bperm(pf, lane ^ o); pb += bperm(pb, lane ^ o); }
            if ((lane & 15) == 0) { const int t = 16 * mt + 4 * (lane >> 4) + i; atomicAdd(&dsum[t], pf); atomicAdd(&dsum[64 + t], pb); }
        }
        __syncthreads();
        if (tid < 128) { const float den = wi[tid] * qn[tid] + dsum[tid]; const float r = 1.f / fmaxf(fabsf(den), emt[tid]); rr[tid] = r; al[tid] = wi[tid] * r; }
        __syncthreads();
#pragma unroll
        for (int j = 0; j < 2; ++j) { const int s = 16 * (nt0 + j) + (lane & 15);
#pragma unroll
            for (int i = 0; i < 4; ++i) { const int t = 16 * mt + 4 * (lane >> 4) + i; AX[t * 200 + s] = (bf16)f2bf(Af[j][i] * rr[t] + Ab[j][i] * rr[64 + t]); } }
        {
            const int t = tid >> 3, d8 = (tid & 7) * 8; const u32x4 qv = *(const u32x4*)(QS + t * 72 + d8); const float af = al[t], ab = al[64 + t];
            u32x4 of, ob;
#pragma unroll
            for (int e = 0; e < 4; ++e) { const float lo = bflo(qv[e]), hi = bfhi(qv[e]); of[e] = pk2(lo * af, hi * af); ob[e] = pk2(lo * ab, hi * ab); }
            *(u32x4*)(AX + t * 200 + 64 + d8) = of; *(u32x4*)(AX + t * 200 + 128 + d8) = ob;
        }
        __syncthreads();
#pragma unroll
        for (int j = 0; j < 2; ++j) {
            const f32x4 acc = mma16(AX, 200, BX, 200, 192, mt, nt0 + j, lane, (f32x4){0.f, 0.f, 0.f, 0.f});
#pragma unroll
            for (int i = 0; i < 4; ++i) HS[(16 * mt + 4 * (lane >> 4) + i) * 68 + 16 * (nt0 + j) + (lane & 15)] = acc[i];
        }
        __syncthreads();
        {
            const int t = tid >> 3, c8 = (tid & 7) * 8; const int row = chunk_row(b, cf, t);
            const f32x4 v0 = *(const f32x4*)(HS + t * 68 + c8), v1 = *(const f32x4*)(HS + t * 68 + c8 + 4);
            float ss = (v0.x * v0.x + v0.y * v0.y) + (v0.z * v0.z + v0.w * v0.w) + (v1.x * v1.x + v1.y * v1.y) + (v1.z * v1.z + v1.w * v1.w);
            ss += bperm(ss, lane ^ 1); ss += bperm(ss, lane ^ 2); ss += bperm(ss, lane ^ 4);
            const float rstd = rsqrtf(ss * (1.f / 64.f) + EPS);
            const f32x4 g0 = *(const f32x4*)(gmh + h * 64 + c8), g1 = *(const f32x4*)(gmh + h * 64 + c8 + 4);
            u32x4 w;
            w.x = pk2(sigmoid_f(bflo(ov.x)) * v0.x * rstd * g0.x, sigmoid_f(bfhi(ov.x)) * v0.y * rstd * g0.y);
            w.y = pk2(sigmoid_f(bflo(ov.y)) * v0.z * rstd * g0.z, sigmoid_f(bfhi(ov.y)) * v0.w * rstd * g0.w);
            w.z = pk2(sigmoid_f(bflo(ov.z)) * v1.x * rstd * g1.x, sigmoid_f(bfhi(ov.z)) * v1.y * rstd * g1.y);
            w.w = pk2(sigmoid_f(bflo(ov.w)) * v1.z * rstd * g1.z, sigmoid_f(bfhi(ov.w)) * v1.w * rstd * g1.w);
            *(u32x4*)(mix + (size_t)row * DM + 512 + h * 64 + c8) = w;
        }
        __syncthreads();
    }
}

__device__ __forceinline__ void cmlp_phase(const bf16* proj, const float* wsp, const float* bsp, const float* gv, bf16* mix, bool need_ctx, unsigned char* lds, int tid, int lane, int wave, int G) {
    bf16* WS_ = (bf16*)lds;
    bf16* VT = WS_ + 128 * 136;
    float* ZS = (float*)(lds + 52224);
    const int nsc = NB * 16 + (need_ctx ? NB * 2 : 0);
    const int g = blockIdx.x & 3;
    {
        const float* wp = wsp + (size_t)g * 128 * 128;
#pragma unroll 4
        for (int i = 0; i < 8; ++i) { const int idx4 = tid + NTHREADS * i; const int p = idx4 >> 5, q4 = (idx4 & 31) * 4; const f32x4 wv = *(const f32x4*)(wp + p * 128 + q4);
            u32x2 o; o.x = pk2(wv.x, wv.y); o.y = pk2(wv.z, wv.w); *(u32x2*)(WS_ + p * 136 + q4) = o; }
    }
    u32x4 pr0, pr1, pu0, pu1;
#define CM_ISSUE(SC) do { const int row0_ = (SC) < NB * 16 ? (SC) * 128 : ML + ((SC) - NB * 16) * 128; const bf16* bp_ = proj + (size_t)(row0_ + (tid >> 2)) * NPROJ + g * 64 + (tid & 3) * 16; \
        pr0 = *(const u32x4*)(bp_ + PC_VC); pr1 = *(const u32x4*)(bp_ + PC_VC + 8); pu0 = *(const u32x4*)(bp_ + PC_UC); pu1 = *(const u32x4*)(bp_ + PC_UC + 8); } while (0)
    if ((int)(blockIdx.x >> 2) < nsc) CM_ISSUE((int)(blockIdx.x >> 2));
    for (int sc = blockIdx.x >> 2; sc < nsc; sc += G >> 2) {
        const int row0 = sc < NB * 16 ? sc * 128 : ML + (sc - NB * 16) * 128;
        const u32x4 u0 = pu0, u1 = pu1;
        {
            const int q = tid >> 2, part = tid & 3;
            const u32x4 r0 = pr0, r1 = pr1;
            float x[16];
#pragma unroll
            for (int e = 0; e < 4; ++e) { x[2 * e] = gelu_tanh(bflo(r0[e])); x[2 * e + 1] = gelu_tanh(bfhi(r0[e])); x[8 + 2 * e] = gelu_tanh(bflo(r1[e])); x[8 + 2 * e + 1] = gelu_tanh(bfhi(r1[e])); }
            float ss = 0.f;
#pragma unroll
            for (int e = 0; e < 16; ++e) ss += x[e] * x[e];
            ss += bperm(ss, lane ^ 1); ss += bperm(ss, lane ^ 2);
            const float rstd = rsqrtf(ss * (1.f / 64.f) + EPS);
#pragma unroll
            for (int e = 0; e < 16; ++e) VT[(part * 16 + e) * 136 + q] = (bf16)f2bf(x[e] * rstd * gv[g * 64 + part * 16 + e]);
        }
        __syncthreads();
        if (sc + (G >> 2) < nsc) CM_ISSUE(sc + (G >> 2));
#pragma unroll
        for (int nt = 0; nt < 4; ++nt) {
            const f32x4 acc = mma16(WS_, 136, VT, 136, 128, wave, nt, lane, (f32x4){0.f, 0.f, 0.f, 0.f});
            const int d = 16 * nt + (lane & 15);
#pragma unroll
            for (int i = 0; i < 4; ++i) { const int p = 16 * wave + 4 * (lane >> 4) + i; ZS[p * 68 + d] = acc[i] + bsp[g * 128 + p]; }
        }
        __syncthreads();
        {
            const int p = tid >> 2, part = tid & 3;
            const float* zp = ZS + p * 68 + part * 16;
            const f32x4 z0 = *(const f32x4*)zp, z1 = *(const f32x4*)(zp + 4), z2 = *(const f32x4*)(zp + 8), z3 = *(const f32x4*)(zp + 12);
            u32x4 o0, o1;
            o0.x = pk2(gelu_tanh(bflo(u0.x)) * z0.x, gelu_tanh(bfhi(u0.x)) * z0.y); o0.y = pk2(gelu_tanh(bflo(u0.y)) * z0.z, gelu_tanh(bfhi(u0.y)) * z0.w);
            o0.z = pk2(gelu_tanh(bflo(u0.z)) * z1.x, gelu_tanh(bfhi(u0.z)) * z1.y); o0.w = pk2(gelu_tanh(bflo(u0.w)) * z1.z, gelu_tanh(bfhi(u0.w)) * z1.w);
            o1.x = pk2(gelu_tanh(bflo(u1.x)) * z2.x, gelu_tanh(bfhi(u1.x)) * z2.y); o1.y = pk2(gelu_tanh(bflo(u1.y)) * z2.z, gelu_tanh(bfhi(u1.y)) * z2.w);
            o1.z = pk2(gelu_tanh(bflo(u1.z)) * z3.x, gelu_tanh(bfhi(u1.z)) * z3.y); o1.w = pk2(gelu_tanh(bflo(u1.w)) * z3.z, gelu_tanh(bfhi(u1.w)) * z3.w);
            bf16* op = mix + (size_t)(row0 + p) * DM + 768 + g * 64 + part * 16;
            *(u32x4*)op = o0; *(u32x4*)(op + 8) = o1;
        }
    }
    __syncthreads();
}

__device__ __forceinline__ void convfix_items(const float* edge, bf16* act, const float* cw, const float* cb, int i_begin, int i_end, int i_stride) {
    for (int idx = i_begin; idx < i_end; idx += i_stride) {
        const int ei = idx / 704, f = (idx % 704) * 4, side = ei & 1, row = (ei >> 1) * 64 + (side ? 63 : 0);
        const int pos = row < ML ? (row & (SEQ - 1)) : ((row - ML) & (CTXL - 1)), slen = row < ML ? SEQ : CTXL;
        const float* ep = edge + (size_t)ei * 3 * DFF + f;
        f32x4 g = *(const f32x4*)ep, v = *(const f32x4*)(ep + DFF);
        if (side == 0 && pos != 0) { const bf16* nb = (const bf16*)(edge + (size_t)(ei - 1) * 3 * DFF + 2 * DFF) + f;
            const u32x2 rg = *(const u32x2*)nb, rv = *(const u32x2*)(nb + DFF);
            g += *(const f32x4*)(cw + f) * (f32x4){bflo(rg.x), bfhi(rg.x), bflo(rg.y), bfhi(rg.y)}; v += *(const f32x4*)(cw + DFF + f) * (f32x4){bflo(rv.x), bfhi(rv.x), bflo(rv.y), bfhi(rv.y)}; }
        if (side == 1 && pos != slen - 1) { const bf16* nb = (const bf16*)(edge + (size_t)(ei + 1) * 3 * DFF + 2 * DFF) + f;
            const u32x2 rg = *(const u32x2*)nb, rv = *(const u32x2*)(nb + DFF);
            g += *(const f32x4*)(cw + 4 * DFF + f) * (f32x4){bflo(rg.x), bfhi(rg.x), bflo(rg.y), bfhi(rg.y)}; v += *(const f32x4*)(cw + 5 * DFF + f) * (f32x4){bflo(rv.x), bfhi(rv.x), bflo(rv.y), bfhi(rv.y)}; }
        u32x2 o; o.x = pk2(silu_f(g.x) * v.x, silu_f(g.y) * v.y); o.y = pk2(silu_f(g.z) * v.z, silu_f(g.w) * v.w);
        *(u32x2*)(act + (size_t)row * DFF + f) = o;
    }
}

typedef const Args __attribute__((address_space(4)))* KArgsP;
__device__ __forceinline__ KArgsP kargs() { KArgsP p = (KArgsP)__builtin_amdgcn_kernarg_segment_ptr(); asm volatile("" : "+s"(p)); return p; }
constexpr int MISC_OFF = RING_BYTES + 320;
#define GRID_BAR() do { XcdBarrier xb_; xb_.bar = (unsigned*)(kargs()->ws + WS_CTL) + 4096; xb_.x = xb_xcc_id(); xb_.st = (volatile LAS unsigned*)((PG8_LAS unsigned char*)lds + MISC_OFF) + 8; xcd_barrier(xb_); if (PROBE & 1024) xcd_barrier(xb_); } while (0)
#ifndef PROBE
#define PROBE 0
#endif
#define NDUP(bit) ((PROBE & (bit)) ? 2 : 1)
#define FRESH() const int lane = fresh_lane(), wave = launder_s(wave0), tid = (wave << 6) | lane, G = launder_s(G0); (void)lane; (void)wave; (void)tid; (void)G
#define ENV() KArgsP ap = kargs(); unsigned char* const ws = ap->ws; float* const out = ap->out; \
    float* const mod = (float*)(ws + WS_MOD); float* const xc = (float*)(ws + WS_XC); bf16* const Hb = (bf16*)(ws + WS_H); bf16* const proj = (bf16*)(ws + WS_PROJ); \
    float* const gates = (float*)(ws + WS_GATES); float* const rowss1 = (float*)(ws + WS_ROWSS); float* const rowss2 = rowss1 + MT; bf16* const mix = (bf16*)(ws + WS_MIX); \
    float* const msc = (float*)(ws + WS_MSC); float* const msn = (float*)(ws + WS_MSN); float* const mss = (float*)(ws + WS_MSS); bf16* const act = (bf16*)(ws + WS_ACT); float* const edge = (float*)(ws + WS_EDGE); \
    (void)out; (void)mod; (void)xc; (void)Hb; (void)proj; (void)gates; (void)rowss1; (void)rowss2; (void)mix; (void)msc; (void)msn; (void)mss; (void)act; (void)edge
#define IN(k) (ap->in[k])

__device__ __forceinline__ void layer_fwd(const int l, unsigned char* lds, PG8_LAS unsigned char* ldsl, const int wave0, const int G0) {
        const bool last = (l == DEPTH - 1);
        for (int rep_ = 0; rep_ < NDUP(2); ++rep_) {
            ENV();
            pg8::Gemm g{Hb, (const bf16*)(ws + WS_WIN) + (size_t)l * NPROJP * DM, MT, NPROJP, DM}; pg8::StaticOrder S; S.init(MT, NPROJP, launder_s(G0), (int)blockIdx.x);
            pg8::EpiProj E{proj, gates, (const float*)(ws + WS_SHW1) + (size_t)l * 17 * NPROJP, rowss1, IN(I_GQ) + l * 64, IN(I_GK) + l * 64, (const float*)(ws + WS_ROPE), QSCALE};
            { FRESH(); pg8::gemm_phase<pg8::EpiProj, pg8::StaticOrder, true, true>(ldsl, g, S, E, tid); }
        }
        GRID_BAR();
        { ENV(); FRESH(); for (int i = blockIdx.x * NTHREADS + tid; i < 2 * MT; i += G * NTHREADS) rowss1[i] = 0.f; }
        for (int rep_ = 0; rep_ < NDUP(4); ++rep_) { ENV(); FRESH(); mlstm_local_phase(proj, gates, msc, msn, mss, lds, tid, lane, wave, G); }
        GRID_BAR();
#if PROBE & 2048
        { ENV(); FRESH(); mlstm_scan_phase(msc, msn, mss, Hb, (float*)Hb + 16 * 1024 * 1024, (float*)Hb + 16 * 1024 * 1024, tid, G); }
#endif
        { ENV(); FRESH(); mlstm_scan_phase(msc, msn, mss, Hb, msn, mss + 2 * 128 * NCHUNK, tid, G); }
        for (int rep_ = 0; rep_ < NDUP(8); ++rep_) {
            ENV();
            FRESH();
            const int vcu = (G % 8 == 0) ? ((int)blockIdx.x % 8) * (G / 8) + (int)blockIdx.x / 8 : (int)blockIdx.x;
            const attn_body::bf16* P = (const attn_body::bf16*)proj; attn_body::bf16* O = (attn_body::bf16*)mix;
            for (int u = vcu; u < 1024; u += G) {
                const int b = u >> 6, hq = (u >> 3) & 7, qb = u & 7, kvh = hq >> 2;
                const size_t qrow = (size_t)b * SEQ + qb * 256, crow0 = (size_t)ML + b * CTXL, lrow0 = (size_t)b * SEQ;
                attn_body::attn_unit<8>(P + qrow * NPROJ + PC_Q + hq * 64, P + crow0 * NPROJ + PC_K + kvh * 64, P + crow0 * NPROJ + PC_V + kvh * 64,
                                        P + lrow0 * NPROJ + PC_K + kvh * 64, P + lrow0 * NPROJ + PC_V + kvh * 64, 36, O + qrow * DM + hq * 64, (char*)lds, tid);
            }
            if (!last) {
                for (int v = (G >= 128) ? (int)blockIdx.x - (G - 128) : (int)blockIdx.x; v < 128; v += G) {
                    if (v < 0) continue;
                    const int b = v >> 3, hq = v & 7, kvh = hq >> 2; const size_t crow0 = (size_t)ML + b * CTXL;
                    attn_body::attn_unit<8>(P + crow0 * NPROJ + PC_Q + hq * 64, P + crow0 * NPROJ + PC_K + kvh * 64, P + crow0 * NPROJ + PC_V + kvh * 64,
                                            P + crow0 * NPROJ + PC_K + kvh * 64, P + crow0 * NPROJ + PC_V + kvh * 64, 4, O + crow0 * DM + hq * 64, (char*)lds, tid);
                }
            }
            asm volatile("s_waitcnt vmcnt(0) lgkmcnt(0)" ::: "memory"); __syncthreads();
        }
        for (int rep_ = 0; rep_ < NDUP(16); ++rep_) { ENV(); FRESH(); cmlp_phase(proj, IN(I_WSP) + (size_t)l * 4 * 128 * 128, IN(I_BSP) + l * 4 * 128, IN(I_GV) + l * 256, mix, !last, lds, tid, lane, wave, G); }
        GRID_BAR();
        for (int rep_ = 0; rep_ < NDUP(32); ++rep_) { ENV(); FRESH(); mlstm_out_phase(proj, gates, Hb, msn, mss, IN(I_GMH) + l * 256, mix, !last, lds, tid, lane, wave, G); }
        GRID_BAR();
        {
            ENV();
            const float* modl = mod + (size_t)l * 17 * 6144;
            pg8::Gemm g{mix, (const bf16*)(ws + WS_WOUT) + (size_t)l * DM * DM, ML, DM, DM, 0}; pg8::StaticOrder S; S.init(ML, DM, launder_s(G0), (int)blockIdx.x);
            pg8::EpiRes2 E{l == 0 ? IN(I_X) : out, xc, out, xc, modl + 2048, Hb, IN(I_GN2) + l * DM, modl + 4096, rowss2};
            { FRESH(); pg8::gemm_phase<pg8::EpiRes2, pg8::StaticOrder, true, true>(ldsl, g, S, E, tid); }
#if PROBE & 1
            { pg8::EpiRes2 E2{out, xc, (float*)proj, (float*)proj + (size_t)ML * DM, modl + 2048, nullptr, nullptr, nullptr, nullptr}; FRESH(); pg8::gemm_phase<pg8::EpiRes2, pg8::StaticOrder, true, true>(ldsl, g, S, E2, tid); }
#endif
            if (!last) {
                FRESH();
                for (int v = blockIdx.x; v < 256; v += G) {
                    const int part = v >> 6, un = v & 63;
                    pg8::Gemm gc{mix + (size_t)ML * DM + part * 256, (const bf16*)(ws + WS_WOUT) + (size_t)l * DM * DM + part * 256, MC, DM, 256, DM};
                    pg8::SingleUnit Sc{un >> 2, un & 3};
                    pg8::EpiSlab Ec{(float*)proj + (size_t)part * MC * DM};
                    pg8::gemm_phase<pg8::EpiSlab, pg8::SingleUnit, true, true>(ldsl, gc, Sc, Ec, tid);
                }
            }
        }
        GRID_BAR();
        if (!last) {
            { ENV(); FRESH(); const float* modl = mod + (size_t)l * 17 * 6144;
              ctxfin_phase(l == 0 ? IN(I_CTX) : xc, xc, (const float*)proj, modl + 16 * 6144 + 2048, IN(I_GN2) + l * DM, modl + 16 * 6144 + 4096, Hb + (size_t)ML * DM, rowss2 + ML, lane, wave, G); }
            GRID_BAR();
        }
        for (int rep_ = 0; rep_ < NDUP(128); ++rep_) {
            ENV();
            const int Mo = last ? ML : MT;
            pg8::Gemm g{Hb, (const bf16*)(ws + WS_WUP) + (size_t)l * 2 * DFF * DM, Mo, 2 * DFF, DM}; pg8::StaticOrder S; S.init(Mo, 2 * DFF, launder_s(G0), (int)blockIdx.x);
            pg8::EpiConv E{act, edge, IN(I_CONVW) + (size_t)l * 3 * 2 * DFF, IN(I_CONVB) + (size_t)l * 2 * DFF, rowss2, (const float*)(ws + WS_SHW2) + (size_t)l * 17 * 2 * DFF};
            { FRESH(); pg8::gemm_phase<pg8::EpiConv, pg8::StaticOrder, true, true>(ldsl, g, S, E, tid); }
        }
        GRID_BAR();
        { ENV(); FRESH(); const int nit = ((last ? ML : MT) / 64) * 2 * 704; convfix_items(edge, act, IN(I_CONVW) + (size_t)l * 3 * 2 * DFF, IN(I_CONVB) + (size_t)l * 2 * DFF, blockIdx.x * NTHREADS + tid, nit, G * NTHREADS); }
        GRID_BAR();
        {
            ENV();
            const float* modl = mod + (size_t)l * 17 * 6144;
            pg8::Gemm g{act, (const bf16*)(ws + WS_WDOWN) + (size_t)l * DM * DFF, ML, DM, DFF, 0}; pg8::StaticOrder S; S.init(ML, DM, launder_s(G0), (int)blockIdx.x);
            pg8::EpiRes2 E{out, xc, out, xc, modl + 5120, last ? nullptr : Hb, IN(I_GN1) + (last ? 0 : (l + 1) * DM), modl + 17 * 6144 + 1024, rowss1};
            { FRESH(); pg8::gemm_phase<pg8::EpiRes2, pg8::StaticOrder, true, true>(ldsl, g, S, E, tid); }
#if PROBE & 64
            { pg8::EpiBf16<0> E2{(bf16*)(ws + WS_EDGE), 1024, nullptr, 0, 0, 1.f}; FRESH(); pg8::gemm_phase<pg8::EpiBf16<0>, pg8::StaticOrder, true, true>(ldsl, g, S, E2, tid); }
#endif
            if (!last) {
                FRESH();
                for (int v = blockIdx.x; v < 256; v += G) {
                    const int part = v >> 6, un = v & 63, kt0 = part == 0 ? 0 : (part == 1 ? 12 : (part == 2 ? 22 : 34)), ktn = (part & 1) ? 10 : 12;
                    pg8::Gemm gc{act + (size_t)ML * DFF + kt0 * 64, (const bf16*)(ws + WS_WDOWN) + (size_t)l * DM * DFF + kt0 * 64, MC, DM, ktn * 64, DFF};
                    pg8::SingleUnit Sc{un >> 2, un & 3};
                    pg8::EpiSlab Ec{(float*)(ws + WS_EDGE) + (size_t)part * MC * DM};
                    pg8::gemm_phase<pg8::EpiSlab, pg8::SingleUnit, true, true>(ldsl, gc, Sc, Ec, tid);
                }
            }
        }
        GRID_BAR();
        if (!last) {
            { ENV(); FRESH(); const float* modl = mod + (size_t)l * 17 * 6144;
              ctxfin_phase(xc, xc, (const float*)(ws + WS_EDGE), modl + 16 * 6144 + 5120, IN(I_GN1) + (l + 1) * DM, modl + 17 * 6144 + 16 * 6144 + 1024, Hb + (size_t)ML * DM, rowss1 + ML, lane, wave, G); }
            GRID_BAR();
        }
}

__global__ void __launch_bounds__(NTHREADS, 2) mega_fwd(Args args) {
    extern __shared__ __attribute__((aligned(16))) unsigned char lds[];
    cg::grid_group grid = cg::this_grid();
    int wave0_ = __builtin_amdgcn_readfirstlane((int)threadIdx.x >> 6); asm volatile("" : "+s"(wave0_)); const int wave0 = wave0_; const int G0 = gridDim.x;
    PG8_LAS unsigned char* ldsl = (PG8_LAS unsigned char*)lds;
    for (int u = threadIdx.x; u < 64; u += NTHREADS) ((LAS unsigned*)(ldsl + MISC_OFF))[u] = 0u;
    __syncthreads();
    (void)xcd_barrier_post((unsigned*)(args.ws + WS_CTL) + 4096, (volatile LAS unsigned*)(ldsl + MISC_OFF) + 8);

    { FRESH(); p0_prologue(args, lds, tid, lane, wave, G); }
#if PROBE & 256
    __syncthreads();
    { FRESH(); p0_prologue(args, lds, tid, lane, wave, G); }
#endif
    if (args.ws == nullptr) grid.sync();
    GRID_BAR();
    { FRESH(); shw_phase(args, lds, tid, G); }
#if PROBE & 512
    { FRESH(); shw_phase(args, lds, tid, G); }
#endif
    { ENV(); FRESH(); norm0_phase(IN(I_X), IN(I_CTX), IN(I_GN1), mod, 1024, Hb, rowss1, tid, lane, wave, G); }
    GRID_BAR();

#pragma nounroll
    for (int l = 0; l < DEPTH; ++l) layer_fwd(launder_s(l), lds, ldsl, wave0, G0);
}

extern "C" void kernel_launch(void* const* d_in, const int* in_sizes, int n_in, void* d_out, int out_size, void* d_ws, size_t ws_size, hipStream_t stream) {
    static int grid = 0;
    if (grid == 0) {
        if (n_in != 21 || out_size != ML * DM || ws_size < WS_END) { fprintf(stderr, "kernel_launch: unexpected problem (n_in %d out %d ws %zu)\n", n_in, out_size, ws_size); grid = -1; return; }
        int dev = 0, cus = 0, per_cu = 0;
        if (hipGetDevice(&dev) != hipSuccess || hipDeviceGetAttribute(&cus, hipDeviceAttributeMultiprocessorCount, dev) != hipSuccess) { grid = -1; return; }
        if (hipFuncSetAttribute((const void*)mega_fwd, hipFuncAttributeMaxDynamicSharedMemorySize, LDS_BYTES) != hipSuccess) { fprintf(stderr, "kernel_launch: hipFuncSetAttribute failed\n"); grid = -1; return; }
        if (hipOccupancyMaxActiveBlocksPerMultiprocessor(&per_cu, (const void*)mega_fwd, NTHREADS, LDS_BYTES) != hipSuccess || per_cu < 1) { fprintf(stderr, "kernel_launch: occupancy query says %d\n", per_cu); (void)hipGetLastError(); per_cu = 1; }
        grid = cus;
    }
    if (grid < 0) return;
    (void)hipMemsetAsync((char*)d_ws + WS_CTL, 0, CTL_ZERO_BYTES, stream);
    Args a{};
    for (int i = 0; i < 21; ++i) a.in[i] = (const float*)d_in[i];
    a.out = (float*)d_out; a.ws = (unsigned char*)d_ws;
    void* kargs[] = {&a};
    hipError_t e = hipLaunchCooperativeKernel((const void*)mega_fwd, dim3(grid), dim3(NTHREADS), kargs, LDS_BYTES, stream);
    if (e != hipSuccess) fprintf(stderr, "kernel_launch: cooperative launch failed: %s (grid %d)\n", hipGetErrorString(e), grid);
}
```
